# Optimizing an MI355X kernel written in HIP

```python
import math
import jax
import jax.numpy as jnp
from jax import lax
import numpy as np

D_MODEL = 2048
BATCH = 4
SEQ = 4096
DEPTH = 2

D_MIX = D_MODEL
GROUP_W = D_MIX // 4
LRU_W = GROUP_W
LRU_BLOCKS = 8
LRU_BLOCK_W = LRU_W // LRU_BLOCKS
LRU_CONV = 4
LRU_C = 8.0
ATT_HEADS = 8
ATT_KV_HEADS = 2
ATT_GROUP = ATT_HEADS // ATT_KV_HEADS
ATT_HEAD_DIM = GROUP_W // ATT_HEADS
ROPE_AXIS = ATT_HEAD_DIM // 2
ROPE_THETA = 10000.0
Q_BLOCK = 128
GRID_W = 64
HY_W = GROUP_W
HY_CONV = 3
HY_ORDER = 2
HY_BANDS = 8
HY_EMB = 2 * HY_BANDS + 1
HY_FFN = 64
HY_TARGET = 1e-2
HY_FAST_DECAY = 0.3
HY_SLOW_DECAY = 1.5
ML_HEADS = 4
ML_HEAD_DIM = GROUP_W // ML_HEADS
ML_CHUNK = 128
D_FF = -(-8 * D_MODEL // 768) * 256
EPS = 1e-6
IN_SIZES = (LRU_W, LRU_W, ATT_HEADS * ATT_HEAD_DIM, ATT_KV_HEADS * ATT_HEAD_DIM, ATT_KV_HEADS * ATT_HEAD_DIM, 3 * HY_W, GROUP_W, GROUP_W, GROUP_W, GROUP_W, 4 * ML_HEADS)
D_IN = sum(IN_SIZES)

kernel_name = 'hybrid_parallel_group_encoder'


def rmsnorm(x, g):
    xf = x.astype(jnp.float32)
    y = xf * lax.rsqrt(jnp.mean(xf * xf, axis=-1, keepdims=True) + EPS)
    return (y * g.astype(jnp.float32)).astype(x.dtype)


def dwconv_centred(x, w, b):
    K = w.shape[0]
    S = x.shape[1]
    left = K // 2
    xp = jnp.pad(x, ((0, 0), (left, K - 1 - left), (0, 0)))
    out = b
    for j in range(K):
        out = out + xp[:, j:j + S, :] * w[j]
    return out


def _linrec_combine(left, right):
    a1, u1 = left
    a2, u2 = right
    return a1 * a2, a2 * u1 + u2


def rglru_direction(xc, wa, ba, wx, bx, lam, reverse):
    Bn, S, W = xc.shape
    xb = xc.reshape(Bn, S, LRU_BLOCKS, LRU_BLOCK_W)
    r = jax.nn.sigmoid((jnp.einsum('bsnk,nkj->bsnj', xb, wa).reshape(Bn, S, W) + ba).astype(jnp.float32))
    i = jax.nn.sigmoid((jnp.einsum('bsnk,nkj->bsnj', xb, wx).reshape(Bn, S, W) + bx).astype(jnp.float32))
    log_a = -LRU_C * jax.nn.softplus(-lam.astype(jnp.float32)) * r
    a = jnp.exp(log_a)
    u = jnp.sqrt(-jnp.expm1(2.0 * log_a)) * (i * xc.astype(jnp.float32))
    _, h = lax.associative_scan(_linrec_combine, (a, u), reverse=reverse, axis=1)
    return h


def mixer_rglru(xa, ga, conv_w, conv_b, wa, ba, wx, bx, lam):
    xc = dwconv_centred(xa, conv_w, conv_b)
    h = (rglru_direction(xc, wa[0], ba[0], wx[0], bx[0], lam[0], False)
         + rglru_direction(xc, wa[1], ba[1], wx[1], bx[1], lam[1], True))
    return jax.nn.gelu(ga.astype(jnp.float32)) * h


def axial_angles(S):
    rows = S // GRID_W
    row = jnp.repeat(jnp.arange(rows, dtype=jnp.float32), GRID_W)
    col = jnp.tile(jnp.arange(GRID_W, dtype=jnp.float32), rows)
    inv = ROPE_THETA ** (-jnp.arange(0, ROPE_AXIS, 2, dtype=jnp.float32) / ROPE_AXIS)
    return row[:, None] * inv, col[:, None] * inv


def rotate_pairs(x, ang):
    m = x.shape[-1] // 2
    xf = x.astype(jnp.float32)
    cos = jnp.cos(ang)[None, :, None, :]
    sin = jnp.sin(ang)[None, :, None, :]
    x1, x2 = xf[..., :m], xf[..., m:]
    return jnp.concatenate([x1 * cos - x2 * sin, x2 * cos + x1 * sin], axis=-1).astype(x.dtype)


def axial_rope(x, ang_row, ang_col):
    return jnp.concatenate([rotate_pairs(x[..., :ROPE_AXIS], ang_row), rotate_pairs(x[..., ROPE_AXIS:], ang_col)], axis=-1)


def mixer_attention(q, k, v, q_g, k_g):
    Bn, S, _ = q.shape
    q = rmsnorm(q.reshape(Bn, S, ATT_HEADS, ATT_HEAD_DIM), q_g)
    k = rmsnorm(k.reshape(Bn, S, ATT_KV_HEADS, ATT_HEAD_DIM), k_g)
    v = v.reshape(Bn, S, ATT_KV_HEADS, ATT_HEAD_DIM)
    ang_row, ang_col = axial_angles(S)
    q = axial_rope(q, ang_row, ang_col) * (ATT_HEAD_DIM ** -0.5)
    k = axial_rope(k, ang_row, ang_col)
    qh = q.reshape(Bn, S, ATT_KV_HEADS, ATT_GROUP, ATT_HEAD_DIM).transpose(0, 2, 3, 1, 4)
    kh = k.transpose(0, 2, 1, 3)
    vh = v.transpose(0, 2, 1, 3)
    nb = S // Q_BLOCK
    qb = jnp.moveaxis(qh.reshape(Bn, ATT_KV_HEADS, ATT_GROUP, nb, Q_BLOCK, ATT_HEAD_DIM), 3, 0)

    def attend(qi):
        s = jnp.einsum('bhgqd,bhkd->bhgqk', qi, kh).astype(jnp.float32)
        p = jax.nn.softmax(s, axis=-1).astype(vh.dtype)
        return jnp.einsum('bhgqk,bhkd->bhgqd', p, vh)

    o = lax.map(attend, qb)
    return o.transpose(1, 0, 4, 2, 3, 5).reshape(Bn, S, ATT_HEADS * ATT_HEAD_DIM)


def hyena_filter_spectra(L, w1, b1, w2, b2, w3, sin_freq, decay):
    f32 = jnp.float32
    pos = jnp.arange(L, dtype=f32)
    t = pos / max(L - 1, 1)
    bands = jnp.linspace(1e-4, HY_BANDS - 1, HY_BANDS, dtype=f32)
    ang = (2.0 * math.pi * pos / L)[:, None] * bands
    feat = jnp.concatenate([t[:, None], jnp.cos(ang), -jnp.sin(ang)], axis=-1)
    sf = sin_freq.astype(f32)
    h = jnp.sin(sf * (feat @ w1.astype(f32) + b1.astype(f32)))
    h = jnp.sin(sf * (h @ w2.astype(f32) + b2.astype(f32)))
    h = h @ w3.astype(f32)
    h = h * jnp.exp(-t[:, None] * jnp.abs(decay.astype(f32)))
    h = h.reshape(L, HY_ORDER, 2, HY_W)
    h = h * lax.rsqrt(jnp.sum(h * h, axis=(0, 2), keepdims=True) + EPS)
    fwd, bwd = h[:, :, 0], h[:, :, 1]
    two_sided = jnp.concatenate([fwd, jnp.zeros((1, HY_ORDER, HY_W), f32), bwd[:0:-1]], axis=0)
    return jnp.moveaxis(jnp.fft.rfft(two_sided, axis=0), 1, 0)


def long_conv(u, h_spec, skip):
    S = u.shape[1]
    y = jnp.fft.irfft(jnp.fft.rfft(u, n=2 * S, axis=1) * h_spec[None], n=2 * S, axis=1)[:, :S]
    return y + u * skip


def mixer_hyena(u3, conv_w, conv_b, w1, b1, w2, b2, w3, sin_freq, decay, skip):
    z = dwconv_centred(u3, conv_w, conv_b).astype(jnp.float32)
    v, x1, x2 = jnp.split(z, 3, axis=-1)
    h_spec = hyena_filter_spectra(u3.shape[1], w1, b1, w2, b2, w3, sin_freq, decay)
    sk = skip.astype(jnp.float32)
    z = x1 * long_conv(v, h_spec[0], sk[0])
    z = x2 * long_conv(z, h_spec[1], sk[1])
    return z


def mlstm_chunkwise(q, k, v, log_i, log_f):
    Bn, H, S, Dh = q.shape
    nc = S // ML_CHUNK
    q = q.reshape(Bn, H, nc, ML_CHUNK, Dh)
    k = k.reshape(Bn, H, nc, ML_CHUNK, Dh)
    v = v.reshape(Bn, H, nc, ML_CHUNK, Dh)
    li = log_i.reshape(Bn, H, nc, ML_CHUNK)
    b = jnp.cumsum(log_f.reshape(Bn, H, nc, ML_CHUNK), axis=-1)
    b_tot = b[..., -1]
    causal = jnp.tril(jnp.ones((ML_CHUNK, ML_CHUNK), dtype=bool))
    d_intra = jnp.where(causal, b[..., :, None] - b[..., None, :] + li[..., None, :], -jnp.inf)
    w_end = b_tot[..., None] - b + li
    m_loc = jnp.max(w_end, axis=-1)
    e_end = jnp.exp(w_end - m_loc[..., None])
    dC = jnp.einsum('bhnl,bhnlk,bhnlv->bhnkv', e_end, k, v)
    dn = jnp.einsum('bhnl,bhnlk->bhnk', e_end, k)

    def step(carry, inp):
        C, n, m = carry
        dC_c, dn_c, mloc_c, bt_c = inp
        m_new = jnp.maximum(bt_c + m, mloc_c)
        decay = jnp.exp(bt_c + m - m_new)
        gain = jnp.exp(mloc_c - m_new)
        C_new = decay[..., None, None] * C + gain[..., None, None] * dC_c
        n_new = decay[..., None] * n + gain[..., None] * dn_c
        return (C_new, n_new, m_new), (C, n, m)

    init = (jnp.zeros((Bn, H, Dh, Dh), jnp.float32), jnp.zeros((Bn, H, Dh), jnp.float32), jnp.zeros((Bn, H), jnp.float32))
    xs = (jnp.moveaxis(dC, 2, 0), jnp.moveaxis(dn, 2, 0), jnp.moveaxis(m_loc, 2, 0), jnp.moveaxis(b_tot, 2, 0))
    _, (C_prev, n_prev, m_prev) = lax.scan(step, init, xs)
    C_prev = jnp.moveaxis(C_prev, 0, 2)
    n_prev = jnp.moveaxis(n_prev, 0, 2)
    m_prev = jnp.moveaxis(m_prev, 0, 2)
    m_inter = b + m_prev[..., None]
    m_t = jnp.maximum(m_inter, jnp.max(d_intra, axis=-1))
    e_inter = jnp.exp(m_inter - m_t)
    s = jnp.einsum('bhnlk,bhnsk->bhnls', q, k) * jnp.exp(d_intra - m_t[..., None])
    num = jnp.einsum('bhnls,bhnsv->bhnlv', s, v) + e_inter[..., None] * jnp.einsum('bhnlk,bhnkv->bhnlv', q, C_prev)
    den = jnp.sum(s, axis=-1) + e_inter * jnp.einsum('bhnlk,bhnk->bhnl', q, n_prev)
    h = num / jnp.maximum(jnp.abs(den), jnp.exp(-m_t))[..., None]
    return h.reshape(Bn, H, S, Dh)


def mixer_mlstm(q, k, v, o, gates, norm_g):
    Bn, S, _ = q.shape

    def heads(a):
        return a.astype(jnp.float32).reshape(Bn, S, ML_HEADS, ML_HEAD_DIM).transpose(0, 2, 1, 3)

    qh = heads(q) * (ML_HEAD_DIM ** -0.5)
    kh = heads(k)
    vh = heads(v)
    g = gates.astype(jnp.float32).transpose(0, 2, 1)
    i_f, f_f, i_b, f_b = jnp.split(g, 4, axis=1)
    h_f = mlstm_chunkwise(qh, kh, vh, i_f, jax.nn.log_sigmoid(f_f))
    fl = lambda a: jnp.flip(a, axis=2)
    h_b = fl(mlstm_chunkwise(fl(qh), fl(kh), fl(vh), fl(i_b), fl(jax.nn.log_sigmoid(f_b))))
    h = (h_f + h_b).transpose(0, 2, 1, 3)
    h = rmsnorm(h, norm_g.reshape(ML_HEADS, ML_HEAD_DIM))
    return jax.nn.sigmoid(o.astype(jnp.float32)) * h.reshape(Bn, S, GROUP_W)


def swiglu(h, w1, w3, w2):
    return (jax.nn.silu(h @ w1) * (h @ w3)) @ w2


def setup_inputs(seed: int = 0) -> dict:
    key = jax.random.key(seed)
    ks = jax.random.split(key, 40)
    f32 = jnp.float32

    def nrm(i, shape, s):
        return s * jax.random.normal(ks[i], shape, f32)

    x = nrm(0, (BATCH, SEQ, D_MODEL), 1.0)
    c = nrm(1, (BATCH, D_MODEL), 1.0)
    w_in = nrm(2, (DEPTH, D_MODEL, D_IN), D_MODEL ** -0.5)
    g0 = D_IN - 4 * ML_HEADS
    f_bias = jnp.linspace(3.0, 6.0, ML_HEADS, dtype=f32)
    b_in = nrm(3, (DEPTH, D_IN), 0.01)
    b_in = b_in.at[:, g0 + ML_HEADS:g0 + 2 * ML_HEADS].add(f_bias).at[:, g0 + 3 * ML_HEADS:].add(f_bias)
    w_out = nrm(4, (DEPTH, D_MIX, D_MODEL), D_MIX ** -0.5)
    norm_mix_g = 1.0 + nrm(5, (DEPTH, D_MODEL), 0.05)
    norm_ffn_g = 1.0 + nrm(6, (DEPTH, D_MODEL), 0.05)
    ada_w = nrm(7, (DEPTH, D_MODEL, 6 * D_MODEL), D_MODEL ** -0.5)
    ada_b = nrm(8, (DEPTH, 6 * D_MODEL), 0.01)
    lru_conv_w = nrm(9, (DEPTH, LRU_CONV, LRU_W), LRU_CONV ** -0.5)
    lru_conv_b = nrm(10, (DEPTH, LRU_W), 0.01)
    lru_wa = nrm(11, (DEPTH, 2, LRU_BLOCKS, LRU_BLOCK_W, LRU_BLOCK_W), LRU_BLOCK_W ** -0.5)
    lru_ba = nrm(12, (DEPTH, 2, LRU_W), 0.01)
    lru_wx = nrm(13, (DEPTH, 2, LRU_BLOCKS, LRU_BLOCK_W, LRU_BLOCK_W), LRU_BLOCK_W ** -0.5)
    lru_bx = nrm(14, (DEPTH, 2, LRU_W), 0.01)
    a_c = jax.random.uniform(ks[15], (DEPTH, 2, LRU_W), f32, minval=0.9, maxval=0.999)
    a0 = a_c ** (1.0 / LRU_C)
    lru_lambda = jnp.log(a0) - jnp.log1p(-a0)
    att_q_norm_g = 1.0 + nrm(16, (DEPTH, ATT_HEAD_DIM), 0.05)
    att_k_norm_g = 1.0 + nrm(17, (DEPTH, ATT_HEAD_DIM), 0.05)
    hy_conv_w = nrm(18, (DEPTH, HY_CONV, 3 * HY_W), HY_CONV ** -0.5)
    hy_conv_b = nrm(19, (DEPTH, 3 * HY_W), 0.01)
    hy_w1 = nrm(20, (DEPTH, HY_EMB, HY_FFN), HY_EMB ** -0.5)
    hy_b1 = nrm(21, (DEPTH, HY_FFN), 0.1)
    hy_w2 = nrm(22, (DEPTH, HY_FFN, HY_FFN), HY_FFN ** -0.5)
    hy_b2 = nrm(23, (DEPTH, HY_FFN), 0.1)
    hy_w3 = nrm(24, (DEPTH, HY_FFN, HY_ORDER * 2 * HY_W), HY_FFN ** -0.5)
    hy_sin_freq = 1.0 + nrm(25, (DEPTH, HY_FFN), 0.05)
    base_decay = jnp.abs(jnp.linspace(math.log(HY_TARGET) / HY_SLOW_DECAY, math.log(HY_TARGET) / HY_FAST_DECAY, HY_W, dtype=f32))
    hy_decay = jnp.tile(base_decay, HY_ORDER * 2)[None, :] * (1.0 + nrm(26, (DEPTH, HY_ORDER * 2 * HY_W), 0.05))
    hy_skip = nrm(27, (DEPTH, HY_ORDER, HY_W), 1.0)
    ml_norm_g = 1.0 + nrm(28, (DEPTH, GROUP_W), 0.05)
    ffn_w1 = nrm(29, (DEPTH, D_MODEL, D_FF), D_MODEL ** -0.5)
    ffn_w3 = nrm(30, (DEPTH, D_MODEL, D_FF), D_MODEL ** -0.5)
    ffn_w2 = nrm(31, (DEPTH, D_FF, D_MODEL), D_FF ** -0.5)
    final_g = 1.0 + nrm(32, (D_MODEL,), 0.05)
    return {'x': x, 'c': c, 'w_in': w_in, 'b_in': b_in, 'w_out': w_out,
            'norm_mix_g': norm_mix_g, 'norm_ffn_g': norm_ffn_g, 'ada_w': ada_w, 'ada_b': ada_b,
            'lru_conv_w': lru_conv_w, 'lru_conv_b': lru_conv_b, 'lru_wa': lru_wa, 'lru_ba': lru_ba,
            'lru_wx': lru_wx, 'lru_bx': lru_bx, 'lru_lambda': lru_lambda,
            'att_q_norm_g': att_q_norm_g, 'att_k_norm_g': att_k_norm_g,
            'hy_conv_w': hy_conv_w, 'hy_conv_b': hy_conv_b, 'hy_w1': hy_w1, 'hy_b1': hy_b1,
            'hy_w2': hy_w2, 'hy_b2': hy_b2, 'hy_w3': hy_w3, 'hy_sin_freq': hy_sin_freq,
            'hy_decay': hy_decay, 'hy_skip': hy_skip, 'ml_norm_g': ml_norm_g,
            'ffn_w1': ffn_w1, 'ffn_w3': ffn_w3, 'ffn_w2': ffn_w2, 'final_g': final_g}


def reference(x, c, w_in, b_in, w_out, norm_mix_g, norm_ffn_g, ada_w, ada_b,
              lru_conv_w, lru_conv_b, lru_wa, lru_ba, lru_wx, lru_bx, lru_lambda,
              att_q_norm_g, att_k_norm_g, hy_conv_w, hy_conv_b, hy_w1, hy_b1, hy_w2, hy_b2,
              hy_w3, hy_sin_freq, hy_decay, hy_skip, ml_norm_g, ffn_w1, ffn_w3, ffn_w2, final_g):
    split_points = np.cumsum(IN_SIZES)[:-1].tolist()
    c_act = jax.nn.silu(c)
    for l in range(DEPTH):
        mod = c_act @ ada_w[l] + ada_b[l]
        sh1, sc1, g1, sh2, sc2, g2 = [m[:, None, :] for m in jnp.split(mod, 6, axis=-1)]
        h = rmsnorm(x, norm_mix_g[l]) * (1.0 + sc1) + sh1
        proj = h @ w_in[l] + b_in[l]
        a_x, a_g, b_q, b_k, b_v, c_u, d_q, d_k, d_v, d_o, d_gates = jnp.split(proj, split_points, axis=-1)
        y_a = mixer_rglru(a_x, a_g, lru_conv_w[l], lru_conv_b[l], lru_wa[l], lru_ba[l], lru_wx[l], lru_bx[l], lru_lambda[l])
        y_b = mixer_attention(b_q, b_k, b_v, att_q_norm_g[l], att_k_norm_g[l])
        y_c = mixer_hyena(c_u, hy_conv_w[l], hy_conv_b[l], hy_w1[l], hy_b1[l], hy_w2[l], hy_b2[l], hy_w3[l], hy_sin_freq[l], hy_decay[l], hy_skip[l])
        y_d = mixer_mlstm(d_q, d_k, d_v, d_o, d_gates, ml_norm_g[l])
        y = jnp.concatenate([y_a.astype(x.dtype), y_b.astype(x.dtype), y_c.astype(x.dtype), y_d.astype(x.dtype)], axis=-1)
        x = x + g1 * (y @ w_out[l])
        h = rmsnorm(x, norm_ffn_g[l]) * (1.0 + sc2) + sh2
        x = x + g2 * swiglu(h, ffn_w1[l], ffn_w3[l], ffn_w2[l])
    return rmsnorm(x, final_g)
```

```cpp
#include <hip/hip_runtime.h>
#include <hip/hip_cooperative_groups.h>
#include <hip/hip_bf16.h>
#include <cstdio>
#include <cstdint>
#include <cmath>
namespace cg = cooperative_groups;

#define LAS __attribute__((address_space(3)))
typedef unsigned short bf16;
typedef short bf16x8 __attribute__((ext_vector_type(8)));
typedef float f32x2 __attribute__((ext_vector_type(2)));
typedef float f32x4 __attribute__((ext_vector_type(4)));
typedef float f32x16 __attribute__((ext_vector_type(16)));
typedef unsigned u32x4 __attribute__((ext_vector_type(4)));
typedef unsigned u32x2 __attribute__((ext_vector_type(2)));

constexpr int DM = 2048, NBATCH = 4, SEQ = 4096, MTOK = NBATCH * SEQ, DEPTH = 2, DIN = 5392, DINP = 5632, DFF = 5632;
constexpr int C_AX = 0, C_AG = 512, C_BQ = 1024, C_BK = 1536, C_BV = 1664, C_CU = 1792, C_DQ = 3328, C_DK = 3840, C_DV = 4352, C_DO = 4864, C_GT = 5376;
constexpr float EPS = 1e-6f;

constexpr size_t MiB = (size_t)1 << 20;
constexpr size_t WS_CTL = 0, CTL_BYTES = 1 * MiB;
constexpr size_t WS_MOD = 1 * MiB;
constexpr size_t WS_HYSC = 1 * MiB + 512 * 1024;
constexpr size_t WS_BINP = 1 * MiB + 576 * 1024;
constexpr size_t WS_LRUS = 2 * MiB;
constexpr size_t WS_HYPART = 4 * MiB;
constexpr size_t WS_WIN = 8 * MiB;
constexpr size_t WS_WOUT = 52 * MiB;
constexpr size_t WS_W13 = 68 * MiB;
constexpr size_t WS_W2 = 156 * MiB;
constexpr size_t WS_HYFT = 200 * MiB;
constexpr size_t WS_LRUW = 232 * MiB;
constexpr size_t WS_MLDN = 233 * MiB;
constexpr size_t WS_MLNP = 233 * MiB + 512 * 1024;
constexpr size_t WS_MLSC = 234 * MiB;
constexpr size_t WS_GATES = 235 * MiB;
constexpr size_t WS_XN = 240 * MiB;
constexpr size_t WS_MLDC = WS_XN;
constexpr size_t WS_PROJ = 304 * MiB;
constexpr size_t WS_Y = 480 * MiB;
constexpr size_t WS_QB = 544 * MiB;
constexpr size_t WS_KB = 560 * MiB;
constexpr size_t WS_VB = 564 * MiB;
constexpr size_t WS_HT = 568 * MiB;
constexpr size_t WS_Z1T = 616 * MiB;
constexpr size_t WS_MLCT = 632 * MiB;
constexpr size_t WS_END = 664 * MiB;

constexpr int LDS_BYTES = 147456;
constexpr int SLOT_OFF = LDS_BYTES - 64;

__device__ __forceinline__ unsigned f2bf(float f) { unsigned u = __builtin_bit_cast(unsigned, f); return (u + 0x7fffu + ((u >> 16) & 1u)) >> 16; }
__device__ __forceinline__ unsigned pk2(float lo, float hi) { return f2bf(lo) | (f2bf(hi) << 16); }
__device__ __forceinline__ float bf2f(unsigned h) { return __builtin_bit_cast(float, h << 16); }
__device__ __forceinline__ float bflo(unsigned w) { return __builtin_bit_cast(float, w << 16); }
__device__ __forceinline__ float bfhi(unsigned w) { return __builtin_bit_cast(float, w & 0xffff0000u); }
__device__ __forceinline__ int lt() { int t = threadIdx.x; asm volatile("" : "+v"(t)); return t; }
__device__ __forceinline__ float shx(float v, int m) { const int l = lt() & 63; return __builtin_bit_cast(float, __builtin_amdgcn_ds_bpermute((l ^ m) << 2, __builtin_bit_cast(int, v))); }
__device__ __forceinline__ float shl_(float v, int src) { return __builtin_bit_cast(float, __builtin_amdgcn_ds_bpermute(src << 2, __builtin_bit_cast(int, v))); }
__device__ __forceinline__ float wave_sum(float v) {
#pragma unroll
    for (int o = 1; o < 64; o <<= 1) v += shx(v, o);
    return v;
}
__device__ __forceinline__ float sigmoidf_(float x) { return __builtin_amdgcn_rcpf(1.0f + __expf(-x)); }
__device__ __forceinline__ float sin_rad(float x) { return __builtin_amdgcn_sinf(x * 0.15915494309189535f); }
__device__ __forceinline__ float cos_rad(float x) { return __builtin_amdgcn_cosf(x * 0.15915494309189535f); }
__device__ __forceinline__ float logsigmoidf_(float x) { return fminf(x, 0.f) - log1pf(__expf(-fabsf(x))); }
__device__ __forceinline__ int crow(int r, int hi) { return (r & 3) + 8 * (r >> 2) + 4 * hi; }
#define LDS_WAIT() asm volatile("s_waitcnt lgkmcnt(0)" ::: "memory")


#define XB_TMO      128
#define XB_XCNT(j)  (256  + 64 * (j))
#define XB_XSUB(j)  (1280 + 64 * (j))
#define XB_XGEN(j)  (2304 + 64 * (j))
#define XB_TOP      3328
#define XB_TOPGEN   3392
#define XCD_BAR_WORDS 3456
#define XB_SPIN_CAP (1u << 18)

__device__ __forceinline__ unsigned xb_ld(unsigned* p)              { return __hip_atomic_load(p, __ATOMIC_RELAXED, __HIP_MEMORY_SCOPE_AGENT); }
__device__ __forceinline__ unsigned xb_add(unsigned* p, unsigned v) { return __hip_atomic_fetch_add(p, v, __ATOMIC_RELAXED, __HIP_MEMORY_SCOPE_AGENT); }
__device__ __forceinline__ unsigned xb_xcc_id() { return (unsigned)__builtin_amdgcn_s_getreg((3 << 11) | 20) & 0xFu; }
#define XB_SPIN(cond, bar) do { unsigned _sp = 0; while (cond) { __builtin_amdgcn_s_sleep(1); \
    if ((++_sp & 255u) == 0u) { if (xb_ld(&(bar)[XB_TMO])) break; if (_sp > XB_SPIN_CAP) { atomicAdd(&(bar)[XB_TMO], 1u); break; } } } } while (0)

struct XcdBarrier {
    unsigned* bar; unsigned x;
    volatile LAS unsigned* st;
};

__device__ __forceinline__ XcdBarrier xcd_barrier_post(unsigned* bar, volatile LAS unsigned* st) {
    XcdBarrier b; b.bar = bar; b.x = xb_xcc_id(); b.st = st;
    if (threadIdx.x == 0) (void)xb_add(&bar[XB_XCNT(b.x)], 1u);
    return b;
}
__device__ __forceinline__ void xcd_barrier_complete(unsigned* bar, unsigned x, unsigned& nloc, unsigned& nx) {
    const unsigned G = gridDim.x * gridDim.y * gridDim.z;
    unsigned sum, cnt, mine, sp = 0u;
    for (;;) {
        sum = 0u; cnt = 0u; mine = 0u;
#pragma unroll 1
        for (unsigned j = 0; j < 16; ++j) { const unsigned c = xb_ld(&bar[XB_XCNT(j)]); sum += c; cnt += (c > 0u) ? 1u : 0u; mine = (j == x) ? c : mine; }
        if (sum == G) break;
        __builtin_amdgcn_s_sleep(1);
        if ((++sp & 255u) == 0u) { if (xb_ld(&bar[XB_TMO])) break; if (sp > XB_SPIN_CAP) { atomicAdd(&bar[XB_TMO], 1u); break; } }
    }
    nloc = mine > 0u ? mine : 1u; nx = cnt > 0u ? cnt : 1u;
}

__device__ __forceinline__ void xcd_barrier(const XcdBarrier& b) {
    asm volatile("s_waitcnt vmcnt(0)" ::: "memory");
    __syncthreads();
    if (threadIdx.x == 0) {
        unsigned zo_ = 0u; asm volatile("" : "+s"(zo_));
        unsigned* bar = b.bar + zo_;
        __builtin_amdgcn_s_waitcnt(0);
        unsigned nloc = b.st[0], nx = b.st[1];
        if (nloc == 0u) { xcd_barrier_complete(bar, b.x, nloc, nx); b.st[0] = nloc; b.st[1] = nx; }
        const unsigned old = xb_add(&bar[XB_XSUB(b.x)], 1u);
        const unsigned gen = old / nloc;
        if (old + 1u == (gen + 1u) * nloc) {
            __builtin_amdgcn_fence(__ATOMIC_RELEASE, "agent");
            asm volatile("s_waitcnt vmcnt(0)" ::: "memory");
            const unsigned og = xb_add(&bar[XB_TOP], 1u);
            const unsigned tg = og / nx;
            if (og + 1u == (tg + 1u) * nx) xb_add(&bar[XB_TOPGEN], 1u);
            else XB_SPIN(xb_ld(&bar[XB_TOPGEN]) == tg, bar);
            __builtin_amdgcn_fence(__ATOMIC_ACQUIRE, "agent");
            xb_add(&bar[XB_XGEN(b.x)], 1u);
            asm volatile("s_waitcnt vmcnt(0)" ::: "memory");
        } else {
            XB_SPIN(xb_ld(&bar[XB_XGEN(b.x)]) == gen, bar);
            __builtin_amdgcn_fence(__ATOMIC_ACQUIRE, "agent");
            asm volatile("s_waitcnt vmcnt(0)" ::: "memory");
        }
    }
    __syncthreads();
}
namespace pg8 {
#define PG8_LAS __attribute__((address_space(3)))
typedef unsigned short bf16_t;
typedef short bf16x8 __attribute__((ext_vector_type(8)));
typedef float f32x4 __attribute__((ext_vector_type(4)));
typedef unsigned u32x4 __attribute__((ext_vector_type(4)));
constexpr int BM = 256, BK = 64, HALF = 128, HTB = HALF * BK * 2  , STAGE_BYTES = 8 * HTB, NXCD = 8, WGM = 8;

__host__ __device__ __forceinline__ int lds_byte(int r, int c) { const int st = (r >> 4) * 2 + (c >> 5), rr = r & 15, cc = c & 31, ob = rr * 64 + cc * 2; return st * 1024 + (ob ^ (((ob >> 9) & 1) << 5)); }
__host__ __device__ __forceinline__ void stage_rc(int b, int& R, int& C) { const int st = b / 1024, sb = b % 1024, swz = sb ^ (((sb >> 9) & 1) << 5); R = (st >> 1) * 16 + swz / 64; C = (st & 1) * 32 + (swz % 64) / 2; }
__host__ __device__ __forceinline__ int perm32(int rho) { const int n = rho >> 4, i = rho & 15; return 8 * (i >> 2) + 4 * n + (i & 3); }

struct Unit { int pm, pn; };
struct Gemm { const bf16_t* A; const bf16_t* Bt; int M, N, K; };

struct StaticOrder {
    int nM, nN, nwg, G, c;
    __host__ __device__ void init(int M, int N, int G_, int c_) { nM = M / BM; nN = N / BM; nwg = nM * nN; G = G_; c = c_; }
    __host__ __device__ bool next(int i, Unit& u) const {
        const long L = (long)i * G + c; if (L >= nwg) return false;
        int wgid = (int)L; { const int q = nwg / NXCD, r = nwg % NXCD, xcd = wgid % NXCD, off = wgid / NXCD; wgid = (xcd < r ? xcd * (q + 1) : r * (q + 1) + (xcd - r) * q) + off; }
        const int nig = WGM * nN, gid = wgid / nig, fm = gid * WGM, gsz = (nM - fm) < WGM ? (nM - fm) : WGM;
        u.pm = fm + ((wgid % nig) % gsz); u.pn = (wgid % nig) / gsz; return true;
    }
    __device__ __forceinline__ void a_ready(const Unit&) const {}
    __device__ __forceinline__ void done(const Unit&) const {}
};

__device__ __forceinline__ unsigned cvt_pk_bf16(float lo, float hi) { unsigned r; asm volatile("v_cvt_pk_bf16_f32 %0, %1, %2" : "=v"(r) : "v"(lo), "v"(hi)); return r; }

struct EpiInProj {
    static constexpr bool PERM = true, AFTER_DRAIN = false;
    bf16_t* O; int ldc; const float* bias; float* gates;
    __device__ __forceinline__ void operator()(const f32x4 (&acc)[2][2][4][2], const Unit& u, int wr, int wc, int fr, int fq) const {
        const int row0 = u.pm * BM + wr * 64 + fr; const int col0 = u.pn * BM + wc * 32 + 8 * fq;
        f32x4 bv[2][2];
#pragma unroll
        for (int bj = 0; bj < 2; ++bj)
#pragma unroll
            for (int n = 0; n < 2; ++n) bv[bj][n] = *(const f32x4*)(bias + col0 + bj * HALF + 4 * n);
        const bool gate_lane = (u.pn == 21) && (wc == 0) && (fq < 2);
#pragma unroll
        for (int ai = 0; ai < 2; ++ai)
#pragma unroll
            for (int m = 0; m < 4; ++m) { const int row = row0 + ai * HALF + m * 16; bf16_t* rowp = O + (size_t)row * ldc + col0;
#pragma unroll
                for (int bj = 0; bj < 2; ++bj) { const f32x4 v0 = acc[ai][bj][m][0] + bv[bj][0], v1 = acc[ai][bj][m][1] + bv[bj][1];
                    u32x4 w; w.x = cvt_pk_bf16(v0[0], v0[1]); w.y = cvt_pk_bf16(v0[2], v0[3]); w.z = cvt_pk_bf16(v1[0], v1[1]); w.w = cvt_pk_bf16(v1[2], v1[3]);
                    *(u32x4*)(rowp + bj * HALF) = w;
                    if (bj == 0 && gate_lane) { float* gp = gates + (size_t)row * 16 + 8 * fq; *(f32x4*)gp = v0; *(f32x4*)(gp + 4) = v1; } } }
    }
};
struct EpiResGate {
    static constexpr bool PERM = false, AFTER_DRAIN = false;
    const float* base; float* out; int ldc; const float* g; int ldg;
    __device__ __forceinline__ void operator()(const f32x4 (&acc)[2][2][4][2], const Unit& u, int wr, int wc, int fr, int fq) const {
        const int col0 = u.pn * BM + wc * 32 + 4 * fq; const int b = (u.pm * BM) >> 12;
        f32x4 gv[2][2];
#pragma unroll
        for (int bj = 0; bj < 2; ++bj)
#pragma unroll
            for (int n = 0; n < 2; ++n) gv[bj][n] = *(const f32x4*)(g + (size_t)b * ldg + col0 + bj * HALF + n * 16);
#pragma unroll
        for (int ai = 0; ai < 2; ++ai)
#pragma unroll
            for (int m = 0; m < 4; ++m) { const int r = u.pm * BM + ai * HALF + wr * 64 + m * 16 + fr; const size_t off = (size_t)r * ldc + col0;
#pragma unroll
                for (int bj = 0; bj < 2; ++bj)
#pragma unroll
                    for (int n = 0; n < 2; ++n) { const f32x4 bs = *(const f32x4*)(base + off + bj * HALF + n * 16);
                        *(f32x4*)(out + off + bj * HALF + n * 16) = bs + gv[bj][n] * acc[ai][bj][m][n]; } }
    }
};
struct EpiSwiGLU {
    static constexpr bool PERM = true, AFTER_DRAIN = false;
    bf16_t* O; int ldc;
    __device__ __forceinline__ float silu(float x) const { return x * __builtin_amdgcn_rcpf(1.0f + __expf(-x)); }
    __device__ __forceinline__ void operator()(const f32x4 (&acc)[2][2][4][2], const Unit& u, int wr, int wc, int fr, int fq) const {
        const int row0 = u.pm * BM + wr * 64 + fr; const int col0 = u.pn * HALF + wc * 32 + 8 * fq;
#pragma unroll
        for (int ai = 0; ai < 2; ++ai)
#pragma unroll
            for (int m = 0; m < 4; ++m) { const int row = row0 + ai * HALF + m * 16;
                const f32x4 a0 = acc[ai][0][m][0], a1 = acc[ai][0][m][1], b0 = acc[ai][1][m][0], b1 = acc[ai][1][m][1];
                u32x4 w;
                w.x = cvt_pk_bf16(silu(a0[0]) * b0[0], silu(a0[1]) * b0[1]); w.y = cvt_pk_bf16(silu(a0[2]) * b0[2], silu(a0[3]) * b0[3]);
                w.z = cvt_pk_bf16(silu(a1[0]) * b1[0], silu(a1[1]) * b1[1]); w.w = cvt_pk_bf16(silu(a1[2]) * b1[2], silu(a1[3]) * b1[3]);
                *(u32x4*)(O + (size_t)row * ldc + col0) = w; }
    }
};

template <class Epi, class Sched, bool ALIGN_EPI = false, bool SP2 = false>
__device__ __forceinline__ void gemm_phase(PG8_LAS unsigned char* lds, const Gemm g, const Sched& S, const Epi& E) {
    const int tid = lt(), wid = __builtin_amdgcn_readfirstlane(tid >> 6), lane = tid & 63, wr = wid >> 2, wc = wid & 3, fr = lane & 15, fq = lane >> 4;
    const int K = g.K, nt = K / BK;
    unsigned voffA[2], voffB[2];
#pragma unroll
    for (int i = 0; i < 2; ++i) { int R, C; stage_rc(tid * 16 + i * 8192, R, C); const int Rb = Epi::PERM ? ((R & ~31) + perm32(R & 31)) : R;
        voffA[i] = (unsigned)(R * K + C) * 2u; voffB[i] = (unsigned)(Rb * K + C) * 2u; }
    const size_t kstep = (size_t)(BK * 2);
    const size_t hstep = (size_t)HALF * K * 2;
    const size_t tstep = 2 * hstep;
    const unsigned ldsw = (unsigned)wid * 1024u;
    const int aoff = lds_byte(wr * 64 + fr, fq * 8), boff = lds_byte(wc * 32 + fr, fq * 8);
#define PG8_SA(b, h) (((b) * 2 + (h)) * HTB)
#define PG8_SB(b, h) ((4 + (b) * 2 + (h)) * HTB)
#define PG8_STAGE(bufoff, gbase, voff) do { _Pragma("unroll") for (int _i = 0; _i < 2; ++_i) \
        __builtin_amdgcn_global_load_lds((const unsigned*)((const char*)(gbase) + (voff)[_i]), (PG8_LAS unsigned*)(lds + (bufoff) + ldsw + _i * 8192), 16, 0, 0); } while (0)
#define PG8_LDA(dst, b, h) do { _Pragma("unroll") for (int m = 0; m < 4; ++m) _Pragma("unroll") for (int k = 0; k < 2; ++k) dst[m][k] = *(const PG8_LAS bf16x8*)(lds + PG8_SA(b, h) + aoff + m * 2048 + k * 1024); } while (0)
#define PG8_LDB(dst, b, h) do { _Pragma("unroll") for (int n = 0; n < 2; ++n) _Pragma("unroll") for (int k = 0; k < 2; ++k) dst[n][k] = *(const PG8_LAS bf16x8*)(lds + PG8_SB(b, h) + boff + n * 2048 + k * 1024); } while (0)
#define PG8_MMA(ai, bj, At, Bt) do { __builtin_amdgcn_s_setprio(1); _Pragma("unroll") for (int m = 0; m < 4; ++m) _Pragma("unroll") for (int n = 0; n < 2; ++n) _Pragma("unroll") for (int k = 0; k < 2; ++k) \
        acc[ai][bj][m][n] = __builtin_amdgcn_mfma_f32_16x16x32_bf16(Bt[n][k], At[m][k], acc[ai][bj][m][n], 0, 0, 0); __builtin_amdgcn_s_setprio(0); } while (0)
#define PG8_WAIT_V(n) asm volatile("s_waitcnt vmcnt(" #n ")" ::: "memory")
#define PG8_WAIT_L(n) asm volatile("s_waitcnt lgkmcnt(" #n ")" ::: "memory")
#define PG8_BAR __builtin_amdgcn_s_barrier()
#define PG8_SCHED __builtin_amdgcn_sched_barrier(0)
    Unit cur, nxt; int ui = 0;
    if (!S.next(0, cur)) return;
    f32x4 acc[2][2][4][2];
#pragma unroll
    for (int a = 0; a < 2; ++a)
#pragma unroll
        for (int b = 0; b < 2; ++b)
#pragma unroll
            for (int m = 0; m < 4; ++m)
#pragma unroll
                for (int n = 0; n < 2; ++n) acc[a][b][m][n] = (f32x4){0.f, 0.f, 0.f, 0.f};
    bf16x8 At[4][2], B0[2][2], B1[2][2];
    const char* cA = (const char*)g.A + (size_t)cur.pm * tstep; const char* cB = (const char*)g.Bt + (size_t)cur.pn * tstep;
    S.a_ready(cur);
    if constexpr (SP2) {
        PG8_STAGE(PG8_SB(0, 0), cB, voffB); PG8_STAGE(PG8_SB(0, 1), cB + hstep, voffB); PG8_STAGE(PG8_SA(0, 0), cA, voffA); PG8_STAGE(PG8_SA(0, 1), cA + hstep, voffA);
        if (wr == 1) PG8_BAR;
        PG8_WAIT_V(2); PG8_BAR;
        PG8_STAGE(PG8_SB(1, 0), cB + kstep, voffB); PG8_STAGE(PG8_SA(1, 0), cA + kstep, voffA); PG8_STAGE(PG8_SB(1, 1), cB + hstep + kstep, voffB);
        PG8_WAIT_V(6); PG8_BAR;
    } else {
        PG8_STAGE(PG8_SB(0, 0), cB, voffB); PG8_STAGE(PG8_SA(0, 0), cA, voffA); PG8_STAGE(PG8_SB(0, 1), cB + hstep, voffB); PG8_STAGE(PG8_SA(0, 1), cA + hstep, voffA);
        if (wr == 1) PG8_BAR;
        PG8_WAIT_V(4); PG8_BAR;
        PG8_STAGE(PG8_SB(1, 0), cB + kstep, voffB); PG8_STAGE(PG8_SA(1, 0), cA + kstep, voffA); PG8_STAGE(PG8_SB(1, 1), cB + hstep + kstep, voffB);
        PG8_WAIT_V(6); PG8_BAR;
    }
    for (;;) {
        const bool has_next = S.next(ui + 1, nxt);
        const char* nA = has_next ? (const char*)g.A + (size_t)nxt.pm * tstep : cA; const char* nB = has_next ? (const char*)g.Bt + (size_t)nxt.pn * tstep : cB;
        for (int t = 0; t < nt; t += 2) {
            const bool last = (t == nt - 2);
            const char* a1 = cA + (size_t)(t + 1) * kstep;
            const char* a2 = last ? nA : cA + (size_t)(t + 2) * kstep; const char* b2 = last ? nB : cB + (size_t)(t + 2) * kstep;
            const char* a3 = a2 + kstep; const char* b3 = b2 + kstep;
            if (last && has_next) S.a_ready(nxt);
            if constexpr (SP2) {
            PG8_LDB(B0, 0, 0); PG8_LDB(B1, 0, 1); PG8_SCHED; PG8_LDA(At, 0, 0); PG8_STAGE(PG8_SA(1, 1), a1 + hstep, voffA);
            PG8_WAIT_V(8); PG8_WAIT_L(0); PG8_BAR; PG8_MMA(0, 0, At, B0); PG8_MMA(0, 1, At, B1); PG8_BAR; PG8_SCHED;
            PG8_LDA(At, 0, 1); PG8_STAGE(PG8_SB(0, 0), b2, voffB); PG8_STAGE(PG8_SB(0, 1), b2 + hstep, voffB); PG8_STAGE(PG8_SA(0, 0), a2, voffA);
            PG8_WAIT_V(8); PG8_WAIT_L(0); PG8_BAR; PG8_MMA(1, 0, At, B0); PG8_MMA(1, 1, At, B1); PG8_BAR; PG8_SCHED;
            PG8_LDB(B0, 1, 0); PG8_LDB(B1, 1, 1); PG8_SCHED; PG8_LDA(At, 1, 0); PG8_STAGE(PG8_SA(0, 1), a2 + hstep, voffA);
            PG8_WAIT_V(8); PG8_WAIT_L(0); PG8_BAR; PG8_MMA(0, 0, At, B0); PG8_MMA(0, 1, At, B1); PG8_BAR; PG8_SCHED;
            PG8_LDA(At, 1, 1); PG8_STAGE(PG8_SB(1, 0), b3, voffB); PG8_STAGE(PG8_SB(1, 1), b3 + hstep, voffB); PG8_STAGE(PG8_SA(1, 0), a3, voffA);
            PG8_WAIT_V(8); PG8_WAIT_L(0); PG8_BAR; PG8_MMA(1, 0, At, B0); PG8_MMA(1, 1, At, B1); PG8_BAR; PG8_SCHED;
            } else {
            PG8_LDB(B0, 0, 0); PG8_SCHED; PG8_LDA(At, 0, 0); PG8_STAGE(PG8_SA(1, 1), a1 + hstep, voffA);
            PG8_WAIT_L(8); PG8_BAR; PG8_WAIT_L(0); PG8_MMA(0, 0, At, B0); PG8_BAR; PG8_SCHED;
            PG8_LDB(B1, 0, 1); PG8_STAGE(PG8_SB(0, 0), b2, voffB);
            PG8_BAR; PG8_WAIT_L(0); PG8_MMA(0, 1, At, B1); PG8_BAR;
            PG8_LDA(At, 0, 1); PG8_STAGE(PG8_SA(0, 0), a2, voffA);
            PG8_BAR; PG8_WAIT_L(0); PG8_MMA(1, 0, At, B0); PG8_BAR; PG8_SCHED;
            PG8_STAGE(PG8_SB(0, 1), b2 + hstep, voffB);
            PG8_WAIT_V(6); PG8_BAR; PG8_MMA(1, 1, At, B1); PG8_BAR;
            PG8_LDB(B0, 1, 0); PG8_SCHED; PG8_LDA(At, 1, 0); PG8_STAGE(PG8_SA(0, 1), a2 + hstep, voffA);
            PG8_WAIT_L(8); PG8_BAR; PG8_WAIT_L(0); PG8_MMA(0, 0, At, B0); PG8_BAR; PG8_SCHED;
            PG8_LDB(B1, 1, 1); PG8_STAGE(PG8_SB(1, 0), b3, voffB);
            PG8_BAR; PG8_WAIT_L(0); PG8_MMA(0, 1, At, B1); PG8_BAR;
            PG8_LDA(At, 1, 1); PG8_STAGE(PG8_SA(1, 0), a3, voffA);
            PG8_BAR; PG8_WAIT_L(0); PG8_MMA(1, 0, At, B0); PG8_BAR; PG8_SCHED;
            PG8_STAGE(PG8_SB(1, 1), b3 + hstep, voffB);
            PG8_WAIT_V(6); PG8_BAR; PG8_MMA(1, 1, At, B1); PG8_BAR;
            }
        }
        if constexpr (ALIGN_EPI) { if (wr == 0) PG8_BAR; }
        if constexpr (!Epi::AFTER_DRAIN) { E(acc, cur, wr, wc, fr, fq); S.done(cur); }
        if (!has_next) break;
#pragma unroll
        for (int a = 0; a < 2; ++a)
#pragma unroll
            for (int b = 0; b < 2; ++b)
#pragma unroll
                for (int m = 0; m < 4; ++m)
#pragma unroll
                    for (int n = 0; n < 2; ++n) acc[a][b][m][n] = (f32x4){0.f, 0.f, 0.f, 0.f};
        cur = nxt; cA = nA; cB = nB; ++ui;
        if constexpr (ALIGN_EPI) { if (wr == 1) PG8_BAR; }
    }
    PG8_WAIT_V(0);
    if constexpr (!ALIGN_EPI) { if (wr == 0) PG8_BAR; }
    PG8_BAR;
    if constexpr (Epi::AFTER_DRAIN) { E.fused(acc, cur, wr, wc, fr, fq, lds, wid, lane); S.done(cur); }
#undef PG8_SA
#undef PG8_SB
#undef PG8_STAGE
#undef PG8_LDA
#undef PG8_LDB
#undef PG8_MMA
#undef PG8_WAIT_V
#undef PG8_WAIT_L
#undef PG8_BAR
#undef PG8_SCHED
}
}
namespace attn_body {
using bf16=__hip_bfloat16;
using bf16x8=__attribute__((ext_vector_type(8)))short;
using s16x4=__attribute__((ext_vector_type(4)))short;
using f32x16=__attribute__((ext_vector_type(16)))float;
using u32x4=__attribute__((ext_vector_type(4)))unsigned;
constexpr int BATCH=4,NHEAD=8,SEQ=4096,D=64,QP=512,KP=128,VP=128,OP=2048,GQ=4;
constexpr int NW=8,QBLK=32,QB=QBLK*NW,KVBLK=64,NQB=SEQ/QB;
constexpr int ATTN_UNIT_ROWS=QB;
__device__ __forceinline__ int crow(int r,int hi){return (r&3)+8*(r>>2)+4*hi;}
#define SBAR() __builtin_amdgcn_sched_barrier(0)
__device__ __forceinline__ void cmask(f32x16&p0,f32x16&p1,int jb,int qrel,int hi){
  const float NEG=-INFINITY; int kb=64*jb+4*hi;
  #pragma unroll
  for(int r=0;r<16;++r){int kv=kb+(r&3)+8*(r>>2); if(kv>qrel)p0[r]=NEG; if(kv+32>qrel)p1[r]=NEG;}
}

constexpr int NSLOT=3, SLOTB=8192;
constexpr int LDS_K=0, LDS_V=NSLOT*SLOTB, LDS_WS=2*NSLOT*SLOTB, LDS_OST=LDS_WS+NW*64*4, LDS_BYTES=LDS_OST+NW*4096;
constexpr float C2=0.125f*1.4426950408889634f;
__device__ __forceinline__ void glds16(const void*gsrc,unsigned lds_dst){unsigned keep;
  asm volatile("s_mov_b32 %0, m0\n\ts_mov_b32 m0, %2\n\ts_nop 0\n\tglobal_load_lds_dwordx4 %1, off\n\ts_mov_b32 m0, %0":"=&s"(keep):"v"(gsrc),"s"(lds_dst):"memory");}
__device__ __forceinline__ float max3f(float a,float b,float c){float r;asm("v_max3_f32 %0, %1, %2, %3":"=v"(r):"v"(a),"v"(b),"v"(c));return r;}
__device__ __forceinline__ float max2f(float a,float b){float r;asm("v_max_f32_e32 %0, %1, %2":"=v"(r):"v"(a),"v"(b));return r;}
__device__ __forceinline__ float fadd_s(float a,float b){float r;asm("v_add_f32_e32 %0, %1, %2":"=v"(r):"v"(a),"v"(b));return r;}
__device__ __forceinline__ float fsub_s(float a,float b){float r;asm("v_sub_f32_e32 %0, %1, %2":"=v"(r):"v"(a),"v"(b));return r;}
typedef float f32x2_t __attribute__((ext_vector_type(2))); typedef __bf16 bf16x2_t __attribute__((ext_vector_type(2)));
__device__ __forceinline__ unsigned cvtpk_s(float lo,float hi){f32x2_t v={lo,hi};bf16x2_t b=__builtin_convertvector(v,bf16x2_t);return __builtin_bit_cast(unsigned,b);}
#define WAIT_BAR(N) asm volatile("s_waitcnt vmcnt(" #N ") lgkmcnt(0)\n\ts_barrier":::"memory")

__device__ __forceinline__ void qkt(f32x16&p0,f32x16&p1,const char*Kslot,const bf16x8*qr,const f32x16&negm,int r32,int hi){
  const char*kb=Kslot+hi*1024+r32*16;
  #pragma unroll
  for(int d0=0;d0<4;++d0){
    const bf16x8 b0=*reinterpret_cast<const bf16x8*>(kb+d0*2048);
    const bf16x8 b1=*reinterpret_cast<const bf16x8*>(kb+d0*2048+512);
    if(d0==0){p0=__builtin_amdgcn_mfma_f32_32x32x16_bf16(b0,qr[0],negm,0,0,0);p1=__builtin_amdgcn_mfma_f32_32x32x16_bf16(b1,qr[0],negm,0,0,0);}
    else{p0=__builtin_amdgcn_mfma_f32_32x32x16_bf16(b0,qr[d0],p0,0,0,0);p1=__builtin_amdgcn_mfma_f32_32x32x16_bf16(b1,qr[d0],p1,0,0,0);}}
}
typedef __attribute__((address_space(3))) const char* lds_cptr;
typedef short v4i16_t __attribute__((ext_vector_type(4)));
__device__ __forceinline__ void kload8(bf16x8*kf,lds_cptr kp){
  kf[0]=*(const __attribute__((address_space(3))) bf16x8*)(kp);      kf[1]=*(const __attribute__((address_space(3))) bf16x8*)(kp+512);
  kf[2]=*(const __attribute__((address_space(3))) bf16x8*)(kp+2048); kf[3]=*(const __attribute__((address_space(3))) bf16x8*)(kp+2560);
  kf[4]=*(const __attribute__((address_space(3))) bf16x8*)(kp+4096); kf[5]=*(const __attribute__((address_space(3))) bf16x8*)(kp+4608);
  kf[6]=*(const __attribute__((address_space(3))) bf16x8*)(kp+6144); kf[7]=*(const __attribute__((address_space(3))) bf16x8*)(kp+6656);
}
__device__ __forceinline__ void kload2(bf16x8*kf,lds_cptr kp,int j){ kf[2*j]=*(const __attribute__((address_space(3))) bf16x8*)(kp+j*2048); kf[2*j+1]=*(const __attribute__((address_space(3))) bf16x8*)(kp+j*2048+512); }
__device__ __forceinline__ s16x4 vtr(lds_cptr p){ return __builtin_bit_cast(s16x4,__builtin_amdgcn_ds_read_tr16_b64_v4i16((__attribute__((address_space(3))) v4i16_t*)p)); }
__device__ __forceinline__ float rowmax(const f32x16&p0,const f32x16&p1){
  float a=max3f(p0[0],p0[1],p1[0]),b=max3f(p0[2],p0[3],p1[1]);a=max3f(a,p1[2],p1[3]);
  #pragma unroll
  for(int r=4;r<16;r+=4){a=max3f(a,p0[r],p0[r+1]);b=max3f(b,p0[r+2],p0[r+3]);a=max3f(a,p1[r],p1[r+1]);b=max3f(b,p1[r+2],p1[r+3]);}
  const float m=max2f(a,b);
  auto rr=__builtin_amdgcn_permlane32_swap(__float_as_uint(m),__float_as_uint(m),false,false);
  return max2f(__uint_as_float(rr[0]),__uint_as_float(rr[1]));
}
__device__ __forceinline__ void pv(f32x16*o,int vb,bf16x8 pa0,bf16x8 pa1,bf16x8 pa2,bf16x8 pa3){
  #pragma unroll
  for(int d0=0;d0<2;++d0){s16x4 lo[4],hi[4];
    #pragma unroll
    for(int ks=0;ks<4;++ks){
      asm volatile("ds_read_b64_tr_b16 %0,%1 offset:%c2":"=&v"(lo[ks]):"v"(vb),"i"(d0*4096+ks*1024):"memory");
      asm volatile("ds_read_b64_tr_b16 %0,%1 offset:%c2":"=&v"(hi[ks]):"v"(vb),"i"(d0*4096+ks*1024+512):"memory");}
    asm volatile("s_waitcnt lgkmcnt(0)":::"memory");SBAR();
    #define PK(k) (bf16x8){lo[k][0],lo[k][1],lo[k][2],lo[k][3],hi[k][0],hi[k][1],hi[k][2],hi[k][3]}
    o[d0]=__builtin_amdgcn_mfma_f32_32x32x16_bf16(pa0,PK(0),o[d0],0,0,0);
    o[d0]=__builtin_amdgcn_mfma_f32_32x32x16_bf16(pa1,PK(1),o[d0],0,0,0);
    o[d0]=__builtin_amdgcn_mfma_f32_32x32x16_bf16(pa2,PK(2),o[d0],0,0,0);
    o[d0]=__builtin_amdgcn_mfma_f32_32x32x16_bf16(pa3,PK(3),o[d0],0,0,0);
    #undef PK
  }
}

#ifndef ATTN_STORE16
#define ATTN_STORE16(p,v) (*(u32x4*)(p)=(v))
#endif
template<int THRL> __device__ __forceinline__ void attn_unit(int b,int h,int qb,const bf16*Q,const bf16*__restrict__ K,const bf16*__restrict__ V,bf16*O,char*shm){
  const int tid=lt(),lane=tid&63,r32=lane&31,hi=lane>>5; const int wid=__builtin_amdgcn_readfirstlane(tid>>6);
  const long rowbase=(long)b*SEQ; const int q0=qb*QB;
  const bf16*Qw=Q+(rowbase+q0+wid*QBLK)*QP+h*D;
  const bf16*Kh=K+rowbase*KP+(h/GQ)*D,*Vh=V+rowbase*VP+(h/GQ)*D;
  const unsigned lds0=(unsigned)(uintptr_t)shm;
  float*wsf=(float*)(shm+LDS_WS)+wid*64;
  const bf16*ksrc=Kh+(long)lane*KP+wid*8;
  const bf16*vsrc=Vh+(long)(16*(wid&3)+(lane>>2))*VP+(wid>>2)*32+(lane&3)*8;
  const unsigned kdst=lds0+LDS_K+wid*1024, vdst=lds0+LDS_V+wid*1024;
  #define DMA_K(t,slot) glds16(ksrc+(long)(t)*KVBLK*KP,(unsigned)__builtin_amdgcn_readfirstlane(kdst+(slot)))
  #define DMA_V(t,slot) glds16(vsrc+(long)(t)*KVBLK*VP,(unsigned)__builtin_amdgcn_readfirstlane(vdst+(slot)))
  const int vb0=(int)(lds0+LDS_V)+((lane>>4)&1)*32+(lane&3)*8+(4*hi+((lane&15)>>2))*64;
  const char*Kbase=shm+LDS_K; bf16x8 kf[8];
  const lds_cptr shm3=(lds_cptr)shm; const lds_cptr kp0=shm3+LDS_K+hi*1024+r32*16; const lds_cptr vp0=shm3+LDS_V+((lane>>4)&1)*32+(lane&3)*8+(4*hi+((lane&15)>>2))*64;
  const int NT=SEQ/KVBLK;
  DMA_K(0,0);DMA_V(0,0);DMA_K(1,SLOTB);
  bf16x8 qr[4];
  #pragma unroll
  for(int d0=0;d0<4;++d0)qr[d0]=*reinterpret_cast<const bf16x8*>(&Qw[(long)r32*QP+d0*16+hi*8]);
  float mhat=0.f,l_reg=0.f;f32x16 o[2];o[0]=f32x16{};o[1]=f32x16{};f32x16 negm=f32x16{};asm volatile("":"+v"(negm));
  const int qrel=wid*QBLK+r32;
  #define CMASK(P0,P1,t) do{}while(0)
  bool resc=false;
  #define START(P0,P1) do{ const float rm=rowmax(P0,P1); resc=false; \
    { const float dl=rm; mhat=fadd_s(mhat,dl); \
      _Pragma("unroll") for(int r=0;r<16;++r){P0[r]=fsub_s(P0[r],dl);P1[r]=fsub_s(P1[r],dl);} \
      _Pragma("unroll") for(int r=0;r<16;++r)negm[r]=-mhat; asm volatile("":"+v"(negm)); } \
    _Pragma("unroll") for(int r=0;r<16;++r)P0[r]=__builtin_amdgcn_exp2f(P0[r]); }while(0)
  #define RESC() do{ if(resc){ asm volatile("s_waitcnt lgkmcnt(0)":::"memory"); \
      _Pragma("unroll") for(int d_=0;d_<2;++d_) _Pragma("unroll") for(int r=0;r<16;++r)o[d_][r]*=wsf[crow(r,hi)]; } }while(0)
  f32x16 pA0,pA1,pB0,pB1;
  int sl_prev=0,sl_cur=0,sl_next=SLOTB;
  #define ROT() do{sl_prev=sl_cur;sl_cur=sl_next;sl_next=(sl_next==(NSLOT-1)*SLOTB)?0:sl_next+SLOTB;}while(0)
  DMA_K(2,2*SLOTB);
  WAIT_BAR(3);
  qkt(pA0,pA1,Kbase,qr,negm,r32,hi);asm volatile("s_nop 15\n\ts_nop 7":"+v"(pA0),"+v"(pA1));CMASK(pA0,pA1,0);
  START(pA0,pA1);
  _Pragma("unroll") for(int r=0;r<16;++r)pA1[r]=__builtin_amdgcn_exp2f(pA1[r]);
  WAIT_BAR(0);
  DMA_K(3,0);DMA_V(1,SLOTB);
  ROT();
  kload8(kf,kp0+sl_cur);
  WAIT_BAR(2);
  s16x4 vlo[8],vhi[8]; u32x4 pw0,pw1,pw2,pw3;
  #define PKW(P,B) cvtpk_s(P[B],P[B+1])
  #define PAF(k) __builtin_bit_cast(bf16x8,pw##k)
  #define VFR(i) (bf16x8){vlo[i][0],vlo[i][1],vlo[i][2],vlo[i][3],vhi[i][0],vhi[i][1],vhi[i][2],vhi[i][3]}
  #define PIN(x) asm volatile("":"+v"(x))
  #define MX3(a,b,c) __builtin_fmaxf(__builtin_fmaxf((a),(b)),(c))
  #define GAPA(MF,A0,A1,A2,A3,W0,W1,PW) do{ MF; sacc+=A0; sacc+=A1; sacc+=A2; sacc+=A3; PIN(sacc); W0; W1; PIN(PW); SBAR(); }while(0)
  #define EX(v) __builtin_amdgcn_exp2f(v)
  #define GAPB(MF,X,B) do{ MF; X[B]=EX(X[B]); X[B+1]=EX(X[B+1]); X[B+2]=EX(X[B+2]); X[B+3]=EX(X[B+3]); PIN(X); SBAR(); }while(0)
  #define VRD(i) do{ vlo[i]=vtr(vp_+(((i)>>2)*4096+((i)&3)*1024)); vhi[i]=vtr(vp_+(((i)>>2)*4096+((i)&3)*1024+512)); }while(0)
  #define KRD(G,j) do{ if(G){ kload2(kf,kp0+sl_next,j); SBAR(); } }while(0)
  #define STEP(C0,C1,P0,P1,t,GK,GV,GL) do{ SBAR(); \
    const lds_cptr vp_=vp0+sl_prev; \
    VRD(0); SBAR(); float sacc=(P0[0]+P0[1]); \
    GAPA(C0=__builtin_amdgcn_mfma_f32_32x32x16_bf16(kf[0],qr[0],negm,0,0,0), P0[2],P0[3],P0[4],P0[5],     pw0[0]=PKW(P0,0), pw0[1]=PKW(P0,2), pw0); \
    VRD(4); SBAR(); GAPA(C1=__builtin_amdgcn_mfma_f32_32x32x16_bf16(kf[1],qr[0],negm,0,0,0), P0[6],P0[7],P0[8],P0[9],     pw0[2]=PKW(P0,4), pw0[3]=PKW(P0,6), pw0); \
    VRD(1); SBAR(); GAPA(C0=__builtin_amdgcn_mfma_f32_32x32x16_bf16(kf[2],qr[1],C0,0,0,0),   P0[10],P0[11],P0[12],P0[13], pw1[0]=PKW(P0,8), pw1[1]=PKW(P0,10), pw1); \
    VRD(5); SBAR(); GAPA(C1=__builtin_amdgcn_mfma_f32_32x32x16_bf16(kf[3],qr[1],C1,0,0,0),   P0[14],P0[15],P1[0],P1[1],   pw1[2]=PKW(P0,12),pw1[3]=PKW(P0,14), pw1); \
    VRD(2); SBAR(); GAPA(C0=__builtin_amdgcn_mfma_f32_32x32x16_bf16(kf[4],qr[2],C0,0,0,0),   P1[2],P1[3],P1[4],P1[5],     pw2[0]=PKW(P1,0), pw2[1]=PKW(P1,2), pw2); \
    VRD(6); SBAR(); GAPA(C1=__builtin_amdgcn_mfma_f32_32x32x16_bf16(kf[5],qr[2],C1,0,0,0),   P1[6],P1[7],P1[8],P1[9],     pw2[2]=PKW(P1,4), pw2[3]=PKW(P1,6), pw2); \
    VRD(3); SBAR(); GAPA(C0=__builtin_amdgcn_mfma_f32_32x32x16_bf16(kf[6],qr[3],C0,0,0,0),   P1[10],P1[11],P1[12],P1[13], pw3[0]=PKW(P1,8), pw3[1]=PKW(P1,10), pw3); \
    VRD(7); SBAR(); GAPA(C1=__builtin_amdgcn_mfma_f32_32x32x16_bf16(kf[7],qr[3],C1,0,0,0),   P1[14],P1[15],0.f,0.f,       pw3[2]=PKW(P1,12),pw3[3]=PKW(P1,14), pw3); \
    l_reg+=sacc; \
    if(GK){DMA_K((t)+3,sl_cur);} if(GV){DMA_V((t)+1,sl_next);} \
    CMASK(C0,C1,t); \
    { float a=MX3(C0[0],C0[1],C1[0]),b=MX3(C0[2],C0[3],C1[1]); a=MX3(a,C1[2],C1[3]); \
      _Pragma("unroll") for(int r=4;r<16;r+=4){a=MX3(a,C0[r],C0[r+1]);b=MX3(b,C0[r+2],C0[r+3]);a=MX3(a,C1[r],C1[r+1]);b=MX3(b,C1[r+2],C1[r+3]);} \
      float rm=__builtin_fmaxf(a,b); { auto rr=__builtin_amdgcn_permlane32_swap(__float_as_uint(rm),__float_as_uint(rm),false,false); rm=__builtin_fmaxf(__uint_as_float(rr[0]),__uint_as_float(rr[1])); } \
      resc=false; \
      if(__builtin_expect(__any(rm>(float)THRL),0)){ const float dl=__builtin_fmaxf(rm,0.f); mhat+=dl; \
        _Pragma("unroll") for(int r=0;r<16;++r){C0[r]-=dl;C1[r]-=dl;} \
        _Pragma("unroll") for(int r=0;r<16;++r)negm[r]=-mhat; asm volatile("":"+v"(negm)); \
        const float f=__builtin_amdgcn_exp2f(-dl); l_reg*=f; if(hi==0)wsf[r32]=f; resc=true; } } \
    SBAR(); \
    GAPB(o[0]=__builtin_amdgcn_mfma_f32_32x32x16_bf16(PAF(0),VFR(0),o[0],0,0,0), C0,0); \
    GAPB(o[1]=__builtin_amdgcn_mfma_f32_32x32x16_bf16(PAF(0),VFR(4),o[1],0,0,0), C0,4); \
    KRD(GL,0); GAPB(o[0]=__builtin_amdgcn_mfma_f32_32x32x16_bf16(PAF(1),VFR(1),o[0],0,0,0), C0,8); \
    KRD(GL,1); GAPB(o[1]=__builtin_amdgcn_mfma_f32_32x32x16_bf16(PAF(1),VFR(5),o[1],0,0,0), C0,12); \
    KRD(GL,2); GAPB(o[0]=__builtin_amdgcn_mfma_f32_32x32x16_bf16(PAF(2),VFR(2),o[0],0,0,0), C1,0); \
    KRD(GL,3); GAPB(o[1]=__builtin_amdgcn_mfma_f32_32x32x16_bf16(PAF(2),VFR(6),o[1],0,0,0), C1,4); \
    GAPB(o[0]=__builtin_amdgcn_mfma_f32_32x32x16_bf16(PAF(3),VFR(3),o[0],0,0,0), C1,8); \
    GAPB(o[1]=__builtin_amdgcn_mfma_f32_32x32x16_bf16(PAF(3),VFR(7),o[1],0,0,0), C1,12); \
    }while(0)
  int t=1;
  #undef CMASK
  #define CMASK(P0,P1,t) do{}while(0)
  for(;t+5<NT;t+=2){
    STEP(pB0,pB1,pA0,pA1,t,true,true,true);     WAIT_BAR(2); RESC(); ROT();
    STEP(pA0,pA1,pB0,pB1,t+1,true,true,true);   WAIT_BAR(2); RESC(); ROT();
  }
  #undef CMASK
  #define CMASK(P0,P1,t) do{}while(0)
  #define ENDW(tt) do{ if((tt)+3<NT){WAIT_BAR(2);} else if((tt)+2<NT){WAIT_BAR(1);} else {WAIT_BAR(0);} }while(0)
  for(;t+1<NT;t+=2){
    STEP(pB0,pB1,pA0,pA1,t,(t+3<NT),(t+1<NT),(t+1<NT));       ENDW(t);   RESC(); ROT();
    STEP(pA0,pA1,pB0,pB1,t+1,(t+4<NT),(t+2<NT),(t+2<NT));     ENDW(t+1); RESC(); ROT();
  }
  STEP(pB0,pB1,pA0,pA1,NT-1,false,false,false); RESC();
  { float sacc=pB0[0]+pB0[1]; _Pragma("unroll") for(int r=2;r<16;++r)sacc+=pB0[r]; _Pragma("unroll") for(int r=0;r<16;++r)sacc+=pB1[r]; l_reg+=sacc;
    pw0=(u32x4){PKW(pB0,0),PKW(pB0,2),PKW(pB0,4),PKW(pB0,6)};pw1=(u32x4){PKW(pB0,8),PKW(pB0,10),PKW(pB0,12),PKW(pB0,14)};pw2=(u32x4){PKW(pB1,0),PKW(pB1,2),PKW(pB1,4),PKW(pB1,6)};pw3=(u32x4){PKW(pB1,8),PKW(pB1,10),PKW(pB1,12),PKW(pB1,14)};
    SBAR(); pv(o,vb0+sl_cur,PAF(0),PAF(1),PAF(2),PAF(3)); }
  #undef PKW
  #undef PAF
  #undef VFR
  #undef PIN
  #undef MX3
  #undef GAPA
  #undef GAPB
  #undef EX
  #undef VRD
  #undef KRD
  #undef STEP
  #undef ENDW
  {auto rr=__builtin_amdgcn_permlane32_swap(__float_as_uint(l_reg),__float_as_uint(l_reg),false,false);l_reg=__uint_as_float(rr[0])+__uint_as_float(rr[1]);}
  if(hi==0)wsf[32+r32]=l_reg;asm volatile("s_waitcnt lgkmcnt(0)":::"memory");
  float rli[16];
  #pragma unroll
  for(int r=0;r<16;++r)rli[r]=__builtin_amdgcn_rcpf(wsf[32+crow(r,hi)]);
  bf16*Ow=O+(rowbase+q0+wid*QBLK)*OP+h*D;
  { bf16*stg=(bf16*)(shm+LDS_OST)+wid*2048;
    #pragma unroll
    for(int r=0;r<16;++r){const int orow=crow(r,hi);
      #pragma unroll
      for(int d0=0;d0<2;++d0)stg[orow*64+d0*32+r32]=__float2bfloat16(o[d0][r]*rli[r]);}
    asm volatile("s_waitcnt lgkmcnt(0)":::"memory");
    #pragma unroll
    for(int i=0;i<4;++i){const int row=i*8+(lane>>3),ch=lane&7; const u32x4 v=*(const u32x4*)(stg+row*64+ch*8); ATTN_STORE16(Ow+(long)row*OP+ch*8,v);} }
  asm volatile("s_waitcnt lgkmcnt(0)\n\ts_barrier":::"memory");
  #undef DMA_K
  #undef DMA_V
  #undef CMASK
  #undef START
  #undef RESC
  #undef ROT
}
#undef SBAR
#undef WAIT_BAR
}
#ifndef MK_PROBE
#define MK_PROBE 0
#endif
#ifndef MK_PTYPE
#define MK_PTYPE 0xff
#endif

struct Args { const float* in[33]; float* out; unsigned char* ws; int ph_lo, ph_hi; };
enum { I_X = 0, I_C, I_WIN, I_BIN, I_WOUT, I_NMG, I_NFG, I_ADAW, I_ADAB, I_LCW, I_LCB, I_LWA, I_LBA, I_LWX, I_LBX, I_LLAM, I_QG, I_KG,
       I_HCW, I_HCB, I_HW1, I_HB1, I_HW2, I_HB2, I_HW3, I_HSF, I_HDEC, I_HSKIP, I_MLG, I_F1, I_F3, I_F2, I_FG };

struct Frame {
    unsigned char* lds; unsigned char* ws; const float* const* in; float* out;
    int tid, lane, wave, G;
};
#define MFMA32(a, b, c) __builtin_amdgcn_mfma_f32_32x32x16_bf16((a), (b), (c), 0, 0, 0)
#define MFMA16(a, b, c) __builtin_amdgcn_mfma_f32_16x16x32_bf16((a), (b), (c), 0, 0, 0)

__device__ __forceinline__ int next_item(unsigned* ctr, unsigned char* lds) {
    volatile unsigned* slot = (volatile unsigned*)(lds + SLOT_OFF);
    __syncthreads();
    if (threadIdx.x == 0) *slot = atomicAdd(ctr, 1u);
    __syncthreads();
    return (int)*slot;
}

__device__ __forceinline__ void transpose_item(const float* W, int K, int N, bf16* WT, int mode, float* scr, int item, int lane) {
    const int nblk = (N + 63) / 64, kb = item / nblk, nb = item % nblk, k0 = 64 * kb, n0 = 64 * nb;
    const int nl0 = 4 * (lane & 15); const bool nok = (n0 + nl0) < N;
    f32x4 v[16];
#pragma unroll
    for (int i = 0; i < 16; ++i) { const int kk = 4 * i + (lane >> 4); v[i] = nok ? *(const f32x4*)(W + (size_t)(k0 + kk) * N + n0 + nl0) : (f32x4){0.f, 0.f, 0.f, 0.f}; }
#pragma unroll
    for (int i = 0; i < 16; ++i) { const int kk = 4 * i + (lane >> 4); float* d = scr + kk * 65 + nl0; d[0] = v[i].x; d[1] = v[i].y; d[2] = v[i].z; d[3] = v[i].w; }
    LDS_WAIT();
    const int c = lane & 7;
#pragma unroll
    for (int j = 0; j < 8; ++j) { const int nl = (lane >> 3) + 8 * j; const int n = n0 + nl; const float* sp = scr + (8 * c) * 65 + nl;
        u32x4 o; o.x = pk2(sp[0 * 65], sp[1 * 65]); o.y = pk2(sp[2 * 65], sp[3 * 65]); o.z = pk2(sp[4 * 65], sp[5 * 65]); o.w = pk2(sp[6 * 65], sp[7 * 65]);
        const int dr = (mode == 0) ? n : ((n >> 7) * 256 + (n & 127) + (mode == 2 ? 128 : 0));
        if (n < N) *(u32x4*)(WT + (size_t)dr * K + k0 + 8 * c) = o; }
    LDS_WAIT();
}

__device__ __forceinline__ void p0_prologue(Frame& F) {
    const int tid = F.tid, lane = F.lane, wave = F.wave;
    const long gt = (long)blockIdx.x * 512 + tid, GT = (long)F.G * 512;
    {
        float* ca = (float*)F.lds;
        float* part = (float*)(F.lds + 32768);
        bool have = false;
        for (int it = blockIdx.x; it < 192; it += F.G) {
            if (!have) { for (int i = tid; i < 8192; i += 512) { const float c = F.in[I_C][i]; ca[i] = c * sigmoidf_(c); } have = true; }
            __syncthreads();
            const int layer = it / 96, col0 = (it % 96) * 128;
            const float* W = F.in[I_ADAW] + (size_t)layer * 2048 * 12288 + col0 + 2 * lane;
            float a00 = 0, a01 = 0, a10 = 0, a11 = 0, a20 = 0, a21 = 0, a30 = 0, a31 = 0;
            const int kb = wave * 256;
#pragma unroll 16
            for (int k = kb; k < kb + 256; ++k) { const f32x2 w = *(const f32x2*)(W + (size_t)k * 12288);
                const float c0 = ca[k], c1 = ca[2048 + k], c2 = ca[4096 + k], c3 = ca[6144 + k];
                a00 += c0 * w.x; a01 += c0 * w.y; a10 += c1 * w.x; a11 += c1 * w.y; a20 += c2 * w.x; a21 += c2 * w.y; a30 += c3 * w.x; a31 += c3 * w.y; }
            float* pp = part + (wave * 4) * 128 + 2 * lane;
            pp[0] = a00; pp[1] = a01; pp[128] = a10; pp[129] = a11; pp[256] = a20; pp[257] = a21; pp[384] = a30; pp[385] = a31;
            __syncthreads();
            { const int b = tid >> 7, col = tid & 127; float s = F.in[I_ADAB][layer * 12288 + col0 + col];
#pragma unroll
              for (int w = 0; w < 8; ++w) s += part[(w * 4 + b) * 128 + col];
              ((float*)(F.ws + WS_MOD))[(layer * 4 + b) * 12288 + col0 + col] = s; }
        }
        __syncthreads();
    }
    {
        bf16* lw = (bf16*)(F.ws + WS_LRUW);
        for (long e = gt; e < 262144; e += GT) { const int k = e & 63, j = (e >> 6) & 63, gate = (e >> 12) & 1, blk = (e >> 13) & 7, dir = (e >> 16) & 1, l = (int)(e >> 17);
            const float* src = gate ? F.in[I_LWX] : F.in[I_LWA];
            lw[e] = (bf16)f2bf(src[((((size_t)(l * 2 + dir) * 8 + blk) * 64 + k) * 64) + j]); }
        float* bp = (float*)(F.ws + WS_BINP);
        for (long e = gt; e < 2 * DINP; e += GT) { const int l = (int)(e / DINP), n = (int)(e % DINP); bp[e] = n < DIN ? F.in[I_BIN][l * DIN + n] : 0.f; }
        for (long e = gt; e < 2L * 240 * 256; e += GT) { const int l = (int)(e / (240 * 256)); const long r = e % (240 * 256);
            *(u32x4*)(F.ws + WS_WIN + (size_t)l * DINP * DM * 2 + (size_t)DIN * DM * 2 + r * 16) = (u32x4){0u, 0u, 0u, 0u}; }
    }
    {
        float* feat = (float*)F.lds; float* h1 = (float*)(F.lds + 2048); float* h2 = (float*)(F.lds + 6144); float* w1s = (float*)(F.lds + 10240); float* w2s = (float*)(F.lds + 14848);
        for (int it = blockIdx.x; it < 512; it += F.G) {
            const int l = it >> 8, pb = it & 255;
            __syncthreads();
            for (int i = tid; i < 17 * 64; i += 512) w1s[i] = F.in[I_HW1][l * 17 * 64 + i];
#pragma unroll
            for (int i = 0; i < 8; ++i) w2s[tid + 512 * i] = F.in[I_HW2][l * 4096 + tid + 512 * i];
            if (tid < 272) { const int p = tid / 17, f = tid % 17; const float pos = (float)(16 * pb + p); float val;
                if (f == 0) val = pos / 4095.0f;
                else { const int bi = (f - 1) & 7; const float band = 1e-4f + (float)bi * ((7.0f - 1e-4f) / 7.0f); const float ang = (6.283185307179586f * pos / 4096.0f) * band;
                       val = (f <= 8) ? cos_rad(ang) : -sin_rad(ang); }
                feat[p * 17 + f] = val; }
            __syncthreads();
            for (int idx = tid; idx < 1024; idx += 512) { const int p = idx >> 6, j = idx & 63; float s = F.in[I_HB1][l * 64 + j];
#pragma unroll
                for (int f = 0; f < 17; ++f) s += feat[p * 17 + f] * w1s[f * 64 + j];
                h1[idx] = sin_rad(F.in[I_HSF][l * 64 + j] * s); }
            __syncthreads();
            for (int idx = tid; idx < 1024; idx += 512) { const int p = idx >> 6, j = idx & 63; float s = F.in[I_HB2][l * 64 + j];
#pragma unroll 16
                for (int i = 0; i < 64; ++i) s += h1[p * 64 + i] * w2s[i * 64 + j];
                h2[idx] = sin_rad(F.in[I_HSF][l * 64 + j] * s); }
            __syncthreads();
            float acc[4][16];
#pragma unroll
            for (int q = 0; q < 4; ++q)
#pragma unroll
                for (int p = 0; p < 16; ++p) acc[q][p] = 0.f;
            const float* w3 = F.in[I_HW3] + (size_t)l * 64 * 2048 + tid;
#pragma unroll 8
            for (int i = 0; i < 64; ++i) { const float w0 = w3[i * 2048], w1 = w3[i * 2048 + 512], w2 = w3[i * 2048 + 1024], w3v = w3[i * 2048 + 1536];
#pragma unroll
                for (int p = 0; p < 16; ++p) { const float hv = h2[p * 64 + i]; acc[0][p] += hv * w0; acc[1][p] += hv * w1; acc[2][p] += hv * w2; acc[3][p] += hv * w3v; } }
#pragma unroll
            for (int q = 0; q < 4; ++q) { const int j = tid + 512 * q; const int o = j >> 10, dir = (j >> 9) & 1, wch = j & 511;
                const float dec = fabsf(F.in[I_HDEC][l * 2048 + j]);
                bf16* base = (bf16*)(F.ws + WS_HYFT) + ((size_t)((l * 2 + o) * 512 + wch)) * 8192;
                float ss = 0.f; float vv[16];
#pragma unroll
                for (int p = 0; p < 16; ++p) { const int pos = 16 * pb + p; const float t = (float)pos / 4095.0f; vv[p] = acc[q][p] * __expf(-t * dec); ss += vv[p] * vv[p]; }
                if (dir == 0) { bf16* fp = base + 4080 - 16 * pb;
                    *(u32x4*)fp = (u32x4){pk2(vv[15], vv[14]), pk2(vv[13], vv[12]), pk2(vv[11], vv[10]), pk2(vv[9], vv[8])};
                    *(u32x4*)(fp + 8) = (u32x4){pk2(vv[7], vv[6]), pk2(vv[5], vv[4]), pk2(vv[3], vv[2]), pk2(vv[1], vv[0])}; }
                else { bf16* bp = base + 4095 + 16 * pb;
                    if (pb > 0) bp[0] = (bf16)f2bf(vv[0]);
                    *(u32x4*)(bp + 1) = (u32x4){pk2(vv[1], vv[2]), pk2(vv[3], vv[4]), pk2(vv[5], vv[6]), pk2(vv[7], vv[8])};
                    *(u32x2*)(bp + 9) = (u32x2){pk2(vv[9], vv[10]), pk2(vv[11], vv[12])};
                    *(unsigned*)(bp + 13) = pk2(vv[13], vv[14]);
                    bp[15] = (bf16)f2bf(vv[15]);
                    if (pb == 0) base[8191] = 0; }
                ((float*)(F.ws + WS_HYPART))[(size_t)(l * 256 + pb) * 2048 + j] = ss; }
        }
        __syncthreads();
    }
    {
        float* scr = (float*)(F.lds + wave * 16640);
        unsigned* tctr = (unsigned*)(F.ws + WS_CTL) + 64 * 30;
        constexpr int I_IN = 32 * 85, I_OUT = 32 * 32, I_W1 = 32 * 88, I_W2 = 88 * 32, PER_L = I_IN + I_OUT + 2 * I_W1 + I_W2;
        for (;;) {
            unsigned base = 0u; if (lane == 0) base = atomicAdd(tctr, 4u);
            base = (unsigned)__builtin_amdgcn_readfirstlane((int)base);
            if (base >= (unsigned)(2 * PER_L)) break;
#pragma unroll 1
            for (int q = 0; q < 4; ++q) { const int it = (int)base + q; if (it >= 2 * PER_L) break;
                const int l = it / PER_L; int r = it % PER_L;
                if (r < I_IN) { transpose_item(F.in[I_WIN] + (size_t)l * DM * DIN, DM, DIN, (bf16*)(F.ws + WS_WIN) + (size_t)l * DINP * DM, 0, scr, r, lane); continue; } r -= I_IN;
                if (r < I_OUT) { transpose_item(F.in[I_WOUT] + (size_t)l * DM * DM, DM, DM, (bf16*)(F.ws + WS_WOUT) + (size_t)l * DM * DM, 0, scr, r, lane); continue; } r -= I_OUT;
                if (r < I_W1) { transpose_item(F.in[I_F1] + (size_t)l * DM * DFF, DM, DFF, (bf16*)(F.ws + WS_W13) + (size_t)l * 2 * DFF * DM, 1, scr, r, lane); continue; } r -= I_W1;
                if (r < I_W1) { transpose_item(F.in[I_F3] + (size_t)l * DM * DFF, DM, DFF, (bf16*)(F.ws + WS_W13) + (size_t)l * 2 * DFF * DM, 2, scr, r, lane); continue; } r -= I_W1;
                transpose_item(F.in[I_F2] + (size_t)l * DFF * DM, DFF, DM, (bf16*)(F.ws + WS_W2) + (size_t)l * DM * DFF, 0, scr, r, lane); }
        }
    }
}

__device__ __forceinline__ void norm_phase(Frame& F, const float* xin, const float* g, const float* sh, const float* sc, bf16* xn) {
    const int gw = blockIdx.x * 8 + F.wave, NGW = F.G * 8, lane = F.lane;
    for (int m = gw; m < MTOK; m += NGW) {
        const int b = m >> 12;
        const f32x4* xr = (const f32x4*)(xin + (size_t)m * DM) + lane;
        f32x4 v[8]; float ss = 0.f;
#pragma unroll
        for (int j = 0; j < 8; ++j) { v[j] = xr[64 * j]; ss += (v[j].x * v[j].x + v[j].y * v[j].y) + (v[j].z * v[j].z + v[j].w * v[j].w); }
        const float rstd = rsqrtf(wave_sum(ss) * (1.0f / DM) + EPS);
#pragma unroll
        for (int j = 0; j < 8; ++j) { const int col = 4 * (lane + 64 * j);
            const f32x4 gv = *(const f32x4*)(g + col), scv = *(const f32x4*)(sc + (size_t)b * 12288 + col), shv = *(const f32x4*)(sh + (size_t)b * 12288 + col);
            const f32x4 o = (v[j] * rstd) * gv * (scv + 1.0f) + shv;
            u32x2 w; w.x = pk2(o.x, o.y); w.y = pk2(o.z, o.w);
            *(u32x2*)(xn + (size_t)m * DM + col) = w; }
    }
}
__device__ __forceinline__ void final_norm_phase(Frame& F, float* x, const float* g) {
    const int gw = blockIdx.x * 8 + F.wave, NGW = F.G * 8, lane = F.lane;
    for (int m = gw; m < MTOK; m += NGW) {
        f32x4* xr = (f32x4*)(x + (size_t)m * DM) + lane;
        f32x4 v[8]; float ss = 0.f;
#pragma unroll
        for (int j = 0; j < 8; ++j) { v[j] = xr[64 * j]; ss += (v[j].x * v[j].x + v[j].y * v[j].y) + (v[j].z * v[j].z + v[j].w * v[j].w); }
        const float rstd = rsqrtf(wave_sum(ss) * (1.0f / DM) + EPS);
#pragma unroll
        for (int j = 0; j < 8; ++j) { const f32x4 gv = *(const f32x4*)(g + 4 * (lane + 64 * j)); xr[64 * j] = (v[j] * rstd) * gv; }
    }
}
__device__ __forceinline__ void hy_scale_reduce(Frame& F) {
    const long gt = (long)blockIdx.x * 512 + F.tid;
    if (gt < 2048) { const int l = (int)(gt >> 10), o = (int)(gt >> 9) & 1, w = (int)gt & 511; const float* pp = (const float*)(F.ws + WS_HYPART) + (size_t)l * 256 * 2048 + o * 1024 + w;
        float s = 0.f; for (int pb = 0; pb < 256; ++pb) s += pp[(size_t)pb * 2048] + pp[(size_t)pb * 2048 + 512];
        ((float*)(F.ws + WS_HYSC))[gt] = rsqrtf(s + EPS); }
}

__device__ __forceinline__ void attn_prep_item(Frame& F, int l, int it) {
    const bf16* proj = (const bf16*)(F.ws + WS_PROJ); bf16* qb = (bf16*)(F.ws + WS_QB); bf16* kb = (bf16*)(F.ws + WS_KB);
#pragma unroll 1
    for (int pi = F.tid; pi < 768; pi += 512) {
        const int tok = pi / 12, hd = pi % 12; const int row = it * 64 + tok; const int pos = row & 4095;
        const bf16* src = proj + (size_t)row * DINP + (hd < 8 ? C_BQ + hd * 64 : (hd < 10 ? C_BK + (hd - 8) * 64 : C_BV + (hd - 10) * 64));
        u32x4 raw[8];
#pragma unroll
        for (int i = 0; i < 8; ++i) raw[i] = *(const u32x4*)(src + 8 * i);
        if (hd >= 10) {
            bf16* vd = (bf16*)(F.ws + WS_VB) + (size_t)row * 128 + (hd - 10) * 64;
#pragma unroll
            for (int i = 0; i < 8; ++i) *(u32x4*)(vd + 8 * i) = raw[i];
            continue; }
        float x[64]; float ss = 0.f;
#pragma unroll
        for (int i = 0; i < 8; ++i) { const unsigned w4[4] = {raw[i].x, raw[i].y, raw[i].z, raw[i].w};
#pragma unroll
            for (int e = 0; e < 4; ++e) { x[8 * i + 2 * e] = bflo(w4[e]); x[8 * i + 2 * e + 1] = bfhi(w4[e]); } }
#pragma unroll
        for (int i = 0; i < 64; ++i) ss += x[i] * x[i];
        const float r = rsqrtf(ss * (1.0f / 64.0f) + EPS);
        const float* g = (hd < 8 ? F.in[I_QG] : F.in[I_KG]) + l * 64;
        const float osc = (hd < 8) ? (0.125f * 1.4426950408889634f) : 1.0f;
#pragma unroll
        for (int i = 0; i < 64; ++i) x[i] = x[i] * r * g[i];
        float o[64];
#pragma unroll
        for (int seg = 0; seg < 2; ++seg) { const float p = seg ? (float)(pos & 63) : (float)(pos >> 6);
#pragma unroll
            for (int i = 0; i < 16; ++i) { const float inv = exp2f(-(float)i * (13.287712379549449f / 16.0f)); const float ang = p * inv; const float cs = cos_rad(ang), sn = sin_rad(ang);
                const float x1 = x[32 * seg + i], x2 = x[32 * seg + 16 + i];
                o[32 * seg + i] = (x1 * cs - x2 * sn) * osc; o[32 * seg + 16 + i] = (x2 * cs + x1 * sn) * osc; } }
        bf16* dst = (hd < 8) ? qb + (size_t)row * 512 + hd * 64 : kb + (size_t)row * 128 + (hd - 8) * 64;
#pragma unroll
        for (int i = 0; i < 8; ++i) *(u32x4*)(dst + 8 * i) = (u32x4){pk2(o[8 * i], o[8 * i + 1]), pk2(o[8 * i + 2], o[8 * i + 3]), pk2(o[8 * i + 4], o[8 * i + 5]), pk2(o[8 * i + 6], o[8 * i + 7])};
    }
}

__device__ __forceinline__ void hy_prep_item(Frame& F, int l, int it) {
    const bf16* proj = (const bf16*)(F.ws + WS_PROJ); bf16* ht = (bf16*)(F.ws + WS_HT);
    const int b = it / 192, rem = it % 192, tt = rem / 24, ct = rem % 24, t0 = tt * 512, c0 = ct * 64, tid = F.tid;
    float* raw = (float*)F.lds;
    u32x4 v[9];
#pragma unroll
    for (int j = 0; j < 9; ++j) { const int idx = tid + 512 * j; const int t = t0 - 1 + (idx >> 3);
        v[j] = (u32x4){0u, 0u, 0u, 0u};
        if (idx < 4112 && t >= 0 && t < SEQ) v[j] = *(const u32x4*)(proj + (size_t)(b * SEQ + t) * DINP + C_CU + c0 + (idx & 7) * 8); }
#pragma unroll
    for (int j = 0; j < 9; ++j) { const int idx = tid + 512 * j; if (idx < 4112) { float* d = raw + (idx >> 3) * 65 + (idx & 7) * 8; const unsigned w4[4] = {v[j].x, v[j].y, v[j].z, v[j].w};
#pragma unroll
        for (int e = 0; e < 4; ++e) { d[2 * e] = bflo(w4[e]); d[2 * e + 1] = bfhi(w4[e]); } } }
    __syncthreads();
    { const int ch = tid >> 3, seg = tid & 7; const int c = c0 + ch;
      const float w0 = F.in[I_HCW][(l * 3 + 0) * 1536 + c], w1 = F.in[I_HCW][(l * 3 + 1) * 1536 + c], w2 = F.in[I_HCW][(l * 3 + 2) * 1536 + c], cb = F.in[I_HCB][l * 1536 + c];
#pragma unroll
      for (int sb = 0; sb < 4; ++sb) { const int ts = 16 * (8 * sb + seg);
          unsigned pk[8];
#pragma unroll
          for (int e = 0; e < 16; e += 2) { const int tr = ts + e + 1;
              const float o0 = cb + w0 * raw[(tr - 1) * 65 + ch] + w1 * raw[tr * 65 + ch] + w2 * raw[(tr + 1) * 65 + ch];
              const float o1 = cb + w0 * raw[tr * 65 + ch] + w1 * raw[(tr + 1) * 65 + ch] + w2 * raw[(tr + 2) * 65 + ch];
              pk[e >> 1] = pk2(o0, o1); }
          u32x4* dst = (u32x4*)(ht + ((size_t)(b * 1536 + c)) * SEQ + t0 + ts);
          dst[0] = (u32x4){pk[0], pk[1], pk[2], pk[3]}; dst[1] = (u32x4){pk[4], pk[5], pk[6], pk[7]}; } }
}

__device__ __forceinline__ void hy_conv_item(Frame& F, int l, int order, int cp) {
    const int tid = F.tid, lane = F.lane, w = F.wave, r32 = lane & 31, hi = lane >> 5;
    unsigned* RVc = (unsigned*)F.lds;
    bf16* U = (bf16*)(F.lds + 65536);
    const int c0 = 2 * cp;
    { const unsigned* src = (const unsigned*)((const bf16*)(F.ws + WS_HYFT) + ((size_t)((l * 2 + order) * 512 + c0)) * 8192);
#pragma unroll
      for (int i0 = 0; i0 < 2048; i0 += 512) { const int i = tid + i0; const int cc = i >> 10, j4 = (i & 1023) * 4;
          const u32x4 a = *(const u32x4*)(src + cc * 4096 + j4); const unsigned nx = (j4 + 4 < 4096) ? src[cc * 4096 + j4 + 4] : 0u;
          *(u32x4*)(RVc + (cc * 2 + 0) * 4096 + j4) = a;
          *(u32x4*)(RVc + (cc * 2 + 1) * 4096 + j4) = (u32x4){__builtin_amdgcn_alignbit(a.y, a.x, 16), __builtin_amdgcn_alignbit(a.z, a.y, 16), __builtin_amdgcn_alignbit(a.w, a.z, 16), __builtin_amdgcn_alignbit(nx, a.w, 16)}; }
      u32x4 uv[8];
#pragma unroll
      for (int q = 0; q < 8; ++q) { const int i = tid + 512 * q; const int cc = i >> 11, b = (i >> 9) & 3, off = i & 511;
          const bf16* sp = (order == 0) ? (const bf16*)(F.ws + WS_HT) + ((size_t)(b * 1536 + c0 + cc)) * SEQ : (const bf16*)(F.ws + WS_Z1T) + ((size_t)(b * 512 + c0 + cc)) * SEQ;
          uv[q] = ((const u32x4*)sp)[off]; }
#pragma unroll
      for (int q = 0; q < 8; ++q) { const int i = tid + 512 * q; const int rowi = i >> 9, off = i & 511;
          *(u32x4*)(U + rowi * 4608 + 8 * off + (off >> 3) * 8) = uv[q]; } }
    if (tid < 32) ((unsigned*)(F.lds + 65536 + 73728))[tid] = 0u;
    __syncthreads();
    const int cc = w >> 2, b = w & 3, c = c0 + cc;
    bf16* Uc = U + (cc * 4 + b) * 4608;
    f32x16 acc[2][2];
#pragma unroll
    for (int a = 0; a < 2; ++a)
#pragma unroll
        for (int q = 0; q < 2; ++q)
#pragma unroll
            for (int r = 0; r < 16; ++r) acc[a][q][r] = 0.f;
    const unsigned lds_rv = (unsigned)(uintptr_t)(RVc + cc * 2 * 4096);
#define HY_RD(DST, ADDR, O) do { asm volatile("ds_read2_b32 %0, %1 offset0:%2 offset1:%3" : "=v"((DST)[0]) : "v"(ADDR), "i"(O), "i"((O) + 1)); \
                                 asm volatile("ds_read2_b32 %0, %1 offset0:%2 offset1:%3" : "=v"((DST)[1]) : "v"(ADDR), "i"((O) + 2), "i"((O) + 3)); } while (0)
#define HY_LDB(DST, DD) do { const int ip0_ = r32 - (DD), ip1_ = 32 + r32 - (DD); const bool ok0_ = (ip0_ >= 0) && (ip0_ < 64), ok1_ = (ip1_ >= 0) && (ip1_ < 64); \
        const bf16* p0_ = ok0_ ? (Uc + 72 * ip0_ + 8 * hi) : ZR; const bf16* p1_ = ok1_ ? (Uc + 72 * ip1_ + 8 * hi) : ZR;        \
        _Pragma("unroll") for (int ks = 0; ks < 4; ++ks) { (DST)[ks][0] = *(const bf16x8*)(p0_ + 16 * ks); (DST)[ks][1] = *(const bf16x8*)(p1_ + 16 * ks); } } while (0)
    u32x2 W[6][2], nW[4][2]; bf16x8 B[4][2], nB[4][2];
    const bf16* ZR = (const bf16*)(F.lds + 65536 + 73728);
    unsigned aaddr;
    { const int s1 = 4095 - (64 * (-63) + 32 + r32 - 8 * hi); aaddr = lds_rv + (unsigned)(s1 & 1) * 16384u + (unsigned)(s1 >> 1) * 4u; }
    HY_RD(W[0], aaddr, 40); HY_RD(W[1], aaddr, 32); HY_RD(W[2], aaddr, 24); HY_RD(W[3], aaddr, 16); HY_RD(W[4], aaddr, 8); HY_RD(W[5], aaddr, 0);
    HY_LDB(B, -63);
#pragma unroll
    for (int i = 0; i < 4; ++i) { nW[i][0] = (u32x2){0u, 0u}; nW[i][1] = (u32x2){0u, 0u}; }
#pragma unroll
    for (int ks = 0; ks < 4; ++ks) { nB[ks][0] = (bf16x8){0, 0, 0, 0, 0, 0, 0, 0}; nB[ks][1] = (bf16x8){0, 0, 0, 0, 0, 0, 0, 0}; }
    asm volatile("s_waitcnt lgkmcnt(0)" : "+v"(W[0][0]), "+v"(W[0][1]), "+v"(W[1][0]), "+v"(W[1][1]), "+v"(W[2][0]), "+v"(W[2][1]), "+v"(W[3][0]), "+v"(W[3][1]), "+v"(W[4][0]), "+v"(W[4][1]), "+v"(W[5][0]), "+v"(W[5][1]),
                                            "+v"(B[0][0]), "+v"(B[0][1]), "+v"(B[1][0]), "+v"(B[1][1]), "+v"(B[2][0]), "+v"(B[2][1]), "+v"(B[3][0]), "+v"(B[3][1]) :: "memory");
#pragma unroll 1
    for (int D = -63; D <= 63; ++D) {
        const bool v0 = (D <= 31), v1 = (D >= -31);
        const unsigned an = aaddr - 128u;
        if (D < 63) { HY_RD(nW[0], an, 24); HY_RD(nW[1], an, 16); HY_RD(nW[2], an, 8); HY_RD(nW[3], an, 0); HY_LDB(nB, D + 1); }
        __builtin_amdgcn_sched_barrier(0);
#pragma unroll
        for (int ks = 0; ks < 4; ++ks) {
            const bf16x8 a0 = __builtin_bit_cast(bf16x8, (u32x4){W[3 - ks][0].x, W[3 - ks][0].y, W[3 - ks][1].x, W[3 - ks][1].y});
            const bf16x8 a1 = __builtin_bit_cast(bf16x8, (u32x4){W[5 - ks][0].x, W[5 - ks][0].y, W[5 - ks][1].x, W[5 - ks][1].y});
            if (v0) { acc[0][0] = MFMA32(a0, B[ks][0], acc[0][0]); acc[1][0] = MFMA32(a1, B[ks][0], acc[1][0]); }
            if (v1) { acc[0][1] = MFMA32(a0, B[ks][1], acc[0][1]); acc[1][1] = MFMA32(a1, B[ks][1], acc[1][1]); } }
        __builtin_amdgcn_sched_barrier(0);
        asm volatile("s_waitcnt lgkmcnt(0)" : "+v"(nW[0][0]), "+v"(nW[0][1]), "+v"(nW[1][0]), "+v"(nW[1][1]), "+v"(nW[2][0]), "+v"(nW[2][1]), "+v"(nW[3][0]), "+v"(nW[3][1]),
                                                "+v"(nB[0][0]), "+v"(nB[0][1]), "+v"(nB[1][0]), "+v"(nB[1][1]), "+v"(nB[2][0]), "+v"(nB[2][1]), "+v"(nB[3][0]), "+v"(nB[3][1]) :: "memory");
        W[0][0] = W[4][0]; W[0][1] = W[4][1]; W[1][0] = W[5][0]; W[1][1] = W[5][1];
#pragma unroll
        for (int i = 0; i < 4; ++i) { W[2 + i][0] = nW[i][0]; W[2 + i][1] = nW[i][1]; }
#pragma unroll
        for (int ks = 0; ks < 4; ++ks) { B[ks][0] = nB[ks][0]; B[ks][1] = nB[ks][1]; }
        aaddr = an;
    }
#undef HY_RD
#undef HY_LDB
    const float scale = ((const float*)(F.ws + WS_HYSC))[(l * 2 + order) * 512 + c], sk = F.in[I_HSKIP][(l * 2 + order) * 512 + c];
#pragma unroll
    for (int jt = 0; jt < 2; ++jt)
#pragma unroll
        for (int itl = 0; itl < 2; ++itl)
#pragma unroll
            for (int r = 0; r < 16; ++r) { const int t = 72 * (32 * itl + r32) + 32 * jt + crow(r, hi);
                const float u = bf2f(Uc[t]); Uc[t] = (bf16)f2bf(acc[jt][itl][r] * scale + sk * u); }
    LDS_WAIT();
    const bf16* gate = (const bf16*)(F.ws + WS_HT) + ((size_t)(b * 1536 + (order == 0 ? 512 : 1024) + c)) * SEQ;
    bf16* zdst = (bf16*)(F.ws + WS_Z1T) + ((size_t)(b * 512 + c)) * SEQ;
#pragma unroll
    for (int q = 0; q < 8; ++q) { const int t = 8 * lane + 512 * q;
        const u32x4 uv = *(const u32x4*)(Uc + t + (t >> 6) * 8); const u32x4 gv = *(const u32x4*)(gate + t);
        *(u32x4*)(zdst + t) = (u32x4){pk2(bflo(uv.x) * bflo(gv.x), bfhi(uv.x) * bfhi(gv.x)), pk2(bflo(uv.y) * bflo(gv.y), bfhi(uv.y) * bfhi(gv.y)),
                                      pk2(bflo(uv.z) * bflo(gv.z), bfhi(uv.z) * bfhi(gv.z)), pk2(bflo(uv.w) * bflo(gv.w), bfhi(uv.w) * bfhi(gv.w))}; }
}
__device__ __forceinline__ void hy_out_phase(Frame& F) {
    bf16* tile = (bf16*)F.lds;
    const int tid = F.tid;
    for (int it = blockIdx.x; it < 1024; it += F.G) {
        const int b = it >> 8, cb = (it >> 5) & 7, tb = it & 31;
        __syncthreads();
#pragma unroll
        for (int j = 0; j < 2; ++j) { const int idx = tid + 512 * j; const int ch = idx >> 4, t8 = (idx & 15) * 8;
            *(u32x4*)(tile + ch * 136 + t8) = *(const u32x4*)((const bf16*)(F.ws + WS_Z1T) + ((size_t)(b * 512 + 64 * cb + ch)) * SEQ + 128 * tb + t8); }
        __syncthreads();
#pragma unroll
        for (int j = 0; j < 2; ++j) { const int idx = tid + 512 * j; const int t = idx >> 3, c8 = (idx & 7) * 8; unsigned pk[4];
#pragma unroll
            for (int e = 0; e < 4; ++e) pk[e] = (unsigned)tile[(c8 + 2 * e) * 136 + t] | ((unsigned)tile[(c8 + 2 * e + 1) * 136 + t] << 16);
            *(u32x4*)((bf16*)(F.ws + WS_Y) + ((size_t)(b * SEQ + 128 * tb + t)) * DM + 1024 + 64 * cb + c8) = (u32x4){pk[0], pk[1], pk[2], pk[3]}; }
    }
    __syncthreads();
}

__device__ __forceinline__ float gelu_tanh(float x) { const float z = 0.7978845608028654f * (x + 0.044715f * x * x * x); const float t = 1.0f - 2.0f * __builtin_amdgcn_rcpf(__expf(2.0f * z) + 1.0f); return 0.5f * x * (1.0f + t); }
template <int STAGE> __device__ __forceinline__ void lru_item(Frame& F, int l, int it) {
    const bf16* proj = (const bf16*)(F.ws + WS_PROJ); bf16* Y = (bf16*)(F.ws + WS_Y);
    const int tid = F.tid, lane = F.lane, w = F.wave, r16 = lane & 15, q = lane >> 4;
    const int b = it >> 6, chunk = it & 63, t0 = chunk * 64;
    bf16* XC = (bf16*)F.lds;
    bf16* HFL = (bf16*)(F.lds + 66560);
    { const int c8 = (tid & 63) * 8, run = tid >> 6;
      u32x4 rw[11];
#pragma unroll
      for (int j = 0; j < 11; ++j) { const int tt = t0 + 8 * run - 2 + j; rw[j] = (u32x4){0u, 0u, 0u, 0u};
          if (tt >= 0 && tt < SEQ) rw[j] = *(const u32x4*)(proj + (size_t)(b * SEQ + tt) * DINP + C_AX + c8); }
      float wv[4][8], bv8[8];
#pragma unroll
      for (int e = 0; e < 8; ++e) { bv8[e] = F.in[I_LCB][l * 512 + c8 + e];
#pragma unroll
          for (int jj = 0; jj < 4; ++jj) wv[jj][e] = F.in[I_LCW][(l * 4 + jj) * 512 + c8 + e]; }
#pragma unroll
      for (int tk = 0; tk < 8; ++tk) { float o[8];
#pragma unroll
          for (int e = 0; e < 8; ++e) o[e] = bv8[e];
#pragma unroll
          for (int jj = 0; jj < 4; ++jj) { const u32x4 r4 = rw[tk + jj]; const unsigned w4[4] = {r4.x, r4.y, r4.z, r4.w};
#pragma unroll
              for (int e = 0; e < 4; ++e) { o[2 * e] += wv[jj][2 * e] * bflo(w4[e]); o[2 * e + 1] += wv[jj][2 * e + 1] * bfhi(w4[e]); } }
          *(u32x4*)(XC + (8 * run + tk) * 520 + c8) = (u32x4){pk2(o[0], o[1]), pk2(o[2], o[3]), pk2(o[4], o[5]), pk2(o[6], o[7])}; } }
    __syncthreads();
    const int blk = w;
    f32x2* sums = (f32x2*)(F.ws + WS_LRUS);
#pragma unroll 1
    for (int dir = 0; dir < 2; ++dir) {
        bf16x8 Bw[2][4][2]; float bav[4], bxv[4], lamc[4], hc[4], Ap[4];
#pragma unroll
        for (int nt = 0; nt < 4; ++nt) { const int ch = 64 * blk + 16 * nt + r16;
            bav[nt] = F.in[I_LBA][(l * 2 + dir) * 512 + ch]; bxv[nt] = F.in[I_LBX][(l * 2 + dir) * 512 + ch];
            lamc[nt] = -8.0f * log1pf(__expf(-F.in[I_LLAM][(l * 2 + dir) * 512 + ch])); hc[nt] = 0.f; Ap[nt] = 1.f;
#pragma unroll
            for (int gate = 0; gate < 2; ++gate)
#pragma unroll
                for (int ks = 0; ks < 2; ++ks)
                    Bw[gate][nt][ks] = *(const bf16x8*)((const bf16*)(F.ws + WS_LRUW) + ((((size_t)(l * 2 + dir) * 8 + blk) * 2 + gate) * 64 + 16 * nt + r16) * 64 + 32 * ks + 8 * q); }
        if (STAGE == 2) {
            const int cbeg = dir ? chunk + 1 : 0, cend = dir ? 64 : chunk;
#pragma unroll 1
            for (int ci = cbeg; ci < cend; ci += 8) { f32x2 sv[8][4];
#pragma unroll
                for (int u = 0; u < 8; ++u) { const int cu = ci + u; const int cj = dir ? (cend - 1 - (cu - cbeg)) : cu;
#pragma unroll
                    for (int nt = 0; nt < 4; ++nt) sv[u][nt] = (cu < cend) ? sums[((size_t)(b * 64 + cj) * 2 + dir) * 512 + 64 * blk + 16 * nt + r16] : (f32x2){1.f, 0.f}; }
#pragma unroll
                for (int u = 0; u < 8; ++u)
#pragma unroll
                    for (int nt = 0; nt < 4; ++nt) hc[nt] = sv[u][nt].x * hc[nt] + sv[u][nt].y; }
        }
        const int myi = dir ? 3 - q : q;
#pragma unroll 1
        for (int mi = 0; mi < 4; ++mi) { const int mt = dir ? 3 - mi : mi;
            bf16x8 af[2];
#pragma unroll
            for (int ks = 0; ks < 2; ++ks) af[ks] = *(const bf16x8*)(XC + (16 * mt + r16) * 520 + 64 * blk + 32 * ks + 8 * q);
            unsigned short gaw[4][4];
            if (STAGE == 2 && dir == 1) {
#pragma unroll
                for (int nt = 0; nt < 4; ++nt)
#pragma unroll
                    for (int r = 0; r < 4; ++r) gaw[nt][r] = proj[((size_t)b * SEQ + t0 + 16 * mt + 4 * q + r) * DINP + C_AG + 64 * blk + 16 * nt + r16]; }
#pragma unroll
            for (int nt = 0; nt < 4; ++nt) {
                f32x4 ga = (f32x4){0.f, 0.f, 0.f, 0.f}, gx = (f32x4){0.f, 0.f, 0.f, 0.f};
                ga = MFMA16(af[0], Bw[0][nt][0], ga); ga = MFMA16(af[1], Bw[0][nt][1], ga);
                gx = MFMA16(af[0], Bw[1][nt][0], gx); gx = MFMA16(af[1], Bw[1][nt][1], gx);
                float a_[4], u_[4];
#pragma unroll
                for (int r = 0; r < 4; ++r) { const int tok = 16 * mt + 4 * q + r;
                    const float rg = sigmoidf_(ga[r] + bav[nt]), ig = sigmoidf_(gx[r] + bxv[nt]);
                    const float la = lamc[nt] * rg; a_[r] = __expf(la); const float mult = __builtin_amdgcn_sqrtf(fmaxf(1.0f - a_[r] * a_[r], 0.f));
                    u_[r] = mult * ig * bf2f(XC[tok * 520 + 64 * blk + 16 * nt + r16]); }
                float ap[4], up[4];
#pragma unroll
                for (int i = 0; i < 4; ++i) { ap[i] = dir ? a_[3 - i] : a_[i]; up[i] = dir ? u_[3 - i] : u_[i]; }
                const float A = (ap[0] * ap[1]) * (ap[2] * ap[3]); const float U = ((up[0] * ap[1] + up[1]) * ap[2] + up[2]) * ap[3] + up[3];
                float h = hc[nt], hin = 0.f, aprod = 1.f;
#pragma unroll
                for (int i = 0; i < 4; ++i) { const int qs = dir ? 3 - i : i; const float Aq = shl_(A, r16 + 16 * qs), Uq = shl_(U, r16 + 16 * qs);
                    hin = (myi == i) ? h : hin; h = Aq * h + Uq; aprod *= Aq; }
                hc[nt] = h; Ap[nt] *= aprod;
                if (STAGE == 2) {
                    float hh = hin;
#pragma unroll
                    for (int i = 0; i < 4; ++i) { hh = ap[i] * hh + up[i];
                        const int r = dir ? 3 - i : i; const int tok = 16 * mt + 4 * q + r; const int ch = 64 * blk + 16 * nt + r16;
                        if (dir == 0) HFL[tok * 512 + ch] = (bf16)f2bf(hh);
                        else { const size_t row = (size_t)b * SEQ + t0 + tok; const float gav = bf2f(dir ? (i == 0 ? gaw[nt][3] : i == 1 ? gaw[nt][2] : i == 2 ? gaw[nt][1] : gaw[nt][0]) : 0);
                               Y[row * DM + ch] = (bf16)f2bf(gelu_tanh(gav) * (bf2f(HFL[tok * 512 + ch]) + hh)); } }
                }
            }
        }
        if (STAGE == 1) { if (q == 0) {
#pragma unroll
            for (int nt = 0; nt < 4; ++nt) sums[((size_t)(b * 64 + chunk) * 2 + dir) * 512 + 64 * blk + 16 * nt + r16] = (f32x2){Ap[nt], hc[nt]}; } }
        LDS_WAIT();
    }
}

__device__ __forceinline__ void ml_gates(Frame& F, float* G, int b, int h, int n) {
    const int tid = F.tid;
    __syncthreads();
    if (tid < 128) { const float* g = (const float*)(F.ws + WS_GATES) + ((size_t)b * SEQ + 128 * n + tid) * 16;
        G[tid] = g[h]; G[128 + tid] = logsigmoidf_(g[4 + h]); G[256 + tid] = g[8 + h]; G[384 + tid] = logsigmoidf_(g[12 + h]); }
    __syncthreads();
    if (tid < 256) { const int p0 = tid & 127; const bool sfx = tid >= 128; const float* src = G + (sfx ? 384 : 128); float s = 0.f;
#pragma unroll 16
        for (int p = 0; p < 128; ++p) { const float v = src[p]; s += (sfx ? (p >= p0) : (p <= p0)) ? v : 0.f; }
        G[(sfx ? 640 : 512) + p0] = s; }
    __syncthreads();
}
template <bool WITH_K> __device__ __forceinline__ void ml_load_T(Frame& F, bf16* VT, bf16* KTf, bf16* KTb, const float* Ef, const float* Eb, int b, int h, int n) {
    const bf16* proj = (const bf16*)(F.ws + WS_PROJ);
#pragma unroll
    for (int qq = 0; qq < 4; ++qq) { const int chunk = F.tid + 512 * qq; const int p = chunk & 127, cc = chunk >> 7; const size_t row = (size_t)b * SEQ + 128 * n + p;
        const u32x4 vv = *(const u32x4*)(proj + row * DINP + C_DV + 128 * h + 8 * cc);
        const unsigned vw[4] = {vv.x, vv.y, vv.z, vv.w};
#pragma unroll
        for (int e = 0; e < 4; ++e) { VT[(8 * cc + 2 * e) * 136 + p] = (bf16)(vw[e] & 0xffffu); VT[(8 * cc + 2 * e + 1) * 136 + p] = (bf16)(vw[e] >> 16); }
        if (WITH_K) { const u32x4 kv = *(const u32x4*)(proj + row * DINP + C_DK + 128 * h + 8 * cc); const unsigned kw[4] = {kv.x, kv.y, kv.z, kv.w}; const float ef = Ef[p], eb = Eb[p];
#pragma unroll
            for (int e = 0; e < 4; ++e) { const float k0 = bflo(kw[e]), k1 = bfhi(kw[e]);
                KTf[(8 * cc + 2 * e) * 136 + p] = (bf16)f2bf(k0 * ef); KTf[(8 * cc + 2 * e + 1) * 136 + p] = (bf16)f2bf(k1 * ef);
                KTb[(8 * cc + 2 * e) * 136 + p] = (bf16)f2bf(k0 * eb); KTb[(8 * cc + 2 * e + 1) * 136 + p] = (bf16)f2bf(k1 * eb); } } }
}
__device__ __forceinline__ void ml1_item(Frame& F, int it) {
    const int tid = F.tid, lane = F.lane, w = F.wave, r32 = lane & 31, hi = lane >> 5;
    const int b = it >> 7, h = (it >> 5) & 3, n = it & 31;
    bf16* VT = (bf16*)F.lds; bf16* KTf = (bf16*)(F.lds + 34816); bf16* KTb = (bf16*)(F.lds + 69632); float* G = (float*)(F.lds + 104448);
    ml_gates(F, G, b, h, n);
    float* Wd = G + 768; float* Ed = G + 1024; float* MX = G + 1280;
    if (tid < 256) { const int d = tid >> 7, p = tid & 127; Wd[tid] = d == 0 ? (G[512 + 127] - G[512 + p] + G[p]) : (G[640] - G[640 + p] + G[256 + p]); }
    __syncthreads();
    if (tid < 256) { const int d = tid >> 7, p = tid & 127; float mx = -INFINITY;
#pragma unroll 16
        for (int pp = 0; pp < 128; ++pp) mx = fmaxf(mx, Wd[d * 128 + pp]); Ed[tid] = __expf(Wd[tid] - mx); if (p == 0) MX[d] = mx; }
    __syncthreads();
    ml_load_T<true>(F, VT, KTf, KTb, Ed, Ed + 128, b, h, n);
    __syncthreads();
    const int d = w >> 2, vb = w & 3; const bf16* KT = d ? KTb : KTf;
    f32x16 acc[4];
#pragma unroll
    for (int kt = 0; kt < 4; ++kt)
#pragma unroll
        for (int r = 0; r < 16; ++r) acc[kt][r] = 0.f;
#pragma unroll
    for (int ps = 0; ps < 8; ++ps) { const bf16x8 a = *(const bf16x8*)(VT + (32 * vb + r32) * 136 + 16 * ps + 8 * hi);
#pragma unroll
        for (int kt = 0; kt < 4; ++kt) { const bf16x8 bb = *(const bf16x8*)(KT + (32 * kt + r32) * 136 + 16 * ps + 8 * hi); acc[kt] = MFMA32(a, bb, acc[kt]); } }
    const int idx = ((b * 4 + h) * 2 + d) * 32 + (d ? 31 - n : n);
    float* dst = (float*)(F.ws + WS_MLDC) + (size_t)idx * 16384;
#pragma unroll
    for (int kt = 0; kt < 4; ++kt)
#pragma unroll
        for (int r = 0; r < 16; ++r) dst[(32 * vb + crow(r, hi)) * 128 + 32 * kt + r32] = acc[kt][r];
    if (tid < 256) { const int dd = tid >> 7, k = tid & 127; const bf16* K2 = dd ? KTb : KTf; float s = 0.f; for (int p = 0; p < 128; ++p) s += bf2f(K2[k * 136 + p]);
        const int idx2 = ((b * 4 + h) * 2 + dd) * 32 + (dd ? 31 - n : n);
        ((float*)(F.ws + WS_MLDN))[(size_t)idx2 * 128 + k] = s;
        if (k == 0) { float* sc = (float*)(F.ws + WS_MLSC) + (size_t)idx2 * 4; sc[0] = MX[dd]; sc[1] = dd ? G[640] : G[512 + 127]; } }
}
__device__ __forceinline__ void ml2_item(Frame& F, int it) {
    const int tid = F.tid, bhd = it >> 3, part = it & 7, e0 = part * 2048 + tid * 4;
    const float* sc = (const float*)(F.ws + WS_MLSC); float* scw = (float*)(F.ws + WS_MLSC);
    const bool nthr = (part == 0) && (tid < 32);
    float m = 0.f; f32x4 C = (f32x4){0.f, 0.f, 0.f, 0.f}, nv = (f32x4){0.f, 0.f, 0.f, 0.f};
#pragma unroll 8
    for (int cn = 0; cn < 32; ++cn) { const size_t idx = (size_t)bhd * 32 + cn; const float mloc = sc[idx * 4], bt = sc[idx * 4 + 1];
        const float mnew = fmaxf(bt + m, mloc), dec = __expf(bt + m - mnew), gn = __expf(mloc - mnew);
        *(u32x2*)((bf16*)(F.ws + WS_MLCT) + idx * 16384 + e0) = (u32x2){pk2(C.x, C.y), pk2(C.z, C.w)};
        if (nthr) *(f32x4*)((float*)(F.ws + WS_MLNP) + idx * 128 + 4 * tid) = nv;
        if (part == 0 && tid == 0) scw[idx * 4 + 2] = m;
        const f32x4 dc = *(const f32x4*)((const float*)(F.ws + WS_MLDC) + idx * 16384 + e0); C = C * dec + dc * gn;
        if (nthr) { const f32x4 dn = *(const f32x4*)((const float*)(F.ws + WS_MLDN) + idx * 128 + 4 * tid); nv = nv * dec + dn * gn; }
        m = mnew; }
}
__device__ __forceinline__ void ml3_item(Frame& F, int l, int it) {
    const bf16* proj = (const bf16*)(F.ws + WS_PROJ);
    const int tid = F.tid, lane = F.lane, w = F.wave, r32 = lane & 31, hi = lane >> 5;
    const int b = it >> 7, h = (it >> 5) & 3, n = it & 31;
    bf16* VT = (bf16*)F.lds; bf16* KN = (bf16*)(F.lds + 34816); float* HF = (float*)(F.lds + 69632); float* G = (float*)(F.lds + 135680); float* INV = (float*)(F.lds + 143872);
    ml_gates(F, G, b, h, n);
    const int idx_f = ((b * 4 + h) * 2 + 0) * 32 + n, idx_b = ((b * 4 + h) * 2 + 1) * 32 + (31 - n);
    const float mpf = ((const float*)(F.ws + WS_MLSC))[(size_t)idx_f * 4 + 2], mpb = ((const float*)(F.ws + WS_MLSC))[(size_t)idx_b * 4 + 2];
    if (tid < 128) { G[7 * 128 + tid] = G[tid] - G[512 + tid]; G[11 * 128 + tid] = G[256 + tid] - G[640 + tid]; }
    __syncthreads();
    if (tid < 128) { const int p = tid; float pm = -INFINITY;
#pragma unroll 16
        for (int s = 0; s < 128; ++s) { const float v = G[7 * 128 + s]; pm = fmaxf(pm, (s <= p) ? v : -INFINITY); }
        const float bl = G[512 + p], mint = bl + mpf, mt = fmaxf(mint, bl + pm); G[8 * 128 + p] = __expf(mint - mt); G[6 * 128 + p] = bl - mt; G[9 * 128 + p] = mt; }
    else if (tid < 256) { const int p = tid - 128; float pm = -INFINITY;
#pragma unroll 16
        for (int s = 0; s < 128; ++s) { const float v = G[11 * 128 + s]; pm = fmaxf(pm, (s >= p) ? v : -INFINITY); }
        const float bl = G[640 + p], mint = bl + mpb, mt = fmaxf(mint, bl + pm); G[12 * 128 + p] = __expf(mint - mt); G[10 * 128 + p] = bl - mt; G[13 * 128 + p] = mt; }
    else if (tid < 384) { const int k = tid - 256; G[14 * 128 + k] = ((const float*)(F.ws + WS_MLNP))[(size_t)idx_f * 128 + k]; }
    else { const int k = tid - 384; G[15 * 128 + k] = ((const float*)(F.ws + WS_MLNP))[(size_t)idx_b * 128 + k]; }
    ml_load_T<false>(F, VT, nullptr, nullptr, nullptr, nullptr, b, h, n);
    { u32x4 kv[4];
#pragma unroll
      for (int qq = 0; qq < 4; ++qq) { const int chunk = tid + 512 * qq; const int p = chunk >> 4, cc = chunk & 15; kv[qq] = *(const u32x4*)(proj + ((size_t)b * SEQ + 128 * n + p) * DINP + C_DK + 128 * h + 8 * cc); }
#pragma unroll
      for (int qq = 0; qq < 4; ++qq) { const int chunk = tid + 512 * qq; const int p = chunk >> 4, cc = chunk & 15; *(u32x4*)(KN + p * 136 + 8 * cc) = kv[qq]; } }
    __syncthreads();
    const int lb = w & 3, vh = w >> 2, ll = 32 * lb + r32;
    const float SCALE = 0.08838834764831845f;
    bf16x8 qf[8];
    { const bf16* qp = proj + ((size_t)b * SEQ + 128 * n + ll) * DINP + C_DQ + 128 * h + 8 * hi;
#pragma unroll
      for (int ks = 0; ks < 8; ++ks) qf[ks] = *(const bf16x8*)(qp + 16 * ks); }
#pragma unroll 1
    for (int d = 0; d < 2; ++d) {
        const int idx = d ? idx_b : idx_f;
        const float* RT = G + (d ? 10 : 6) * 128; const float* CF = G + (d ? 11 : 7) * 128; const float* EI = G + (d ? 12 : 8) * 128; const float* MT = G + (d ? 13 : 9) * 128; const float* NP = G + (d ? 15 : 14) * 128;
        const float rt = RT[ll], ei = EI[ll], mt = MT[ll];
        f32x16 O[2];
#pragma unroll
        for (int vt = 0; vt < 2; ++vt)
#pragma unroll
            for (int r = 0; r < 16; ++r) O[vt][r] = 0.f;
        float dsum = 0.f;
        const int st_lo = d ? lb : 0, st_hi = d ? 3 : lb;
#pragma unroll 1
        for (int st = st_lo; st <= st_hi; ++st) {
            f32x16 sacc;
#pragma unroll
            for (int r = 0; r < 16; ++r) sacc[r] = 0.f;
            const bf16* kp = KN + (32 * st + r32) * 136 + 8 * hi;
#pragma unroll
            for (int ks = 0; ks < 8; ++ks) { const bf16x8 kf = *(const bf16x8*)(kp + 16 * ks); sacc = MFMA32(kf, qf[ks], sacc); }
            float P[16];
#pragma unroll
            for (int r = 0; r < 16; ++r) { const int s_ = 32 * st + crow(r, hi); const bool ok = d ? (s_ >= ll) : (s_ <= ll);
                const float pv = ok ? sacc[r] * SCALE * __expf(rt + CF[s_]) : 0.f; P[r] = pv; dsum += pv; }
#pragma unroll
            for (int half = 0; half < 2; ++half) {
                const u32x4 pw = (u32x4){pk2(P[8 * half + 0], P[8 * half + 1]), pk2(P[8 * half + 2], P[8 * half + 3]), pk2(P[8 * half + 4], P[8 * half + 5]), pk2(P[8 * half + 6], P[8 * half + 7])};
                const bf16x8 pa = __builtin_bit_cast(bf16x8, pw);
#pragma unroll
                for (int vt = 0; vt < 2; ++vt) { const bf16* vp = VT + (32 * (2 * vh + vt) + r32) * 136 + 32 * st + 16 * half + 4 * hi;
                    const u32x2 lo = *(const u32x2*)vp, hi2 = *(const u32x2*)(vp + 8);
                    const bf16x8 bv = __builtin_bit_cast(bf16x8, (u32x4){lo.x, lo.y, hi2.x, hi2.y});
                    O[vt] = MFMA32(pa, bv, O[vt]); } } }
        const float qs = ei * SCALE; float dq = 0.f;
#pragma unroll
        for (int ks = 0; ks < 8; ++ks) { const u32x4 qw = __builtin_bit_cast(u32x4, qf[ks]); const unsigned qq[4] = {qw.x, qw.y, qw.z, qw.w}; float qv[8];
#pragma unroll
            for (int e = 0; e < 4; ++e) { qv[2 * e] = bflo(qq[e]); qv[2 * e + 1] = bfhi(qq[e]); }
#pragma unroll
            for (int e = 0; e < 8; ++e) dq += qv[e] * NP[16 * ks + 8 * hi + e];
            const u32x4 sw = (u32x4){pk2(qv[0] * qs, qv[1] * qs), pk2(qv[2] * qs, qv[3] * qs), pk2(qv[4] * qs, qv[5] * qs), pk2(qv[6] * qs, qv[7] * qs)};
            const bf16x8 qp2 = __builtin_bit_cast(bf16x8, sw);
#pragma unroll
            for (int vt = 0; vt < 2; ++vt) { const bf16x8 cf = *(const bf16x8*)((const bf16*)(F.ws + WS_MLCT) + (size_t)idx * 16384 + (32 * (2 * vh + vt) + r32) * 128 + 16 * ks + 8 * hi);
                O[vt] = MFMA32(qp2, cf, O[vt]); } }
        dsum += shx(dsum, 32); dq += shx(dq, 32);
        const float den = dsum + qs * dq;
        const float inv = 1.0f / fmaxf(fabsf(den), __expf(-mt));
        asm volatile("" ::: "memory");
        INV[w * 32 + r32] = inv;
        LDS_WAIT();
#pragma unroll
        for (int vt = 0; vt < 2; ++vt)
#pragma unroll
            for (int r = 0; r < 16; ++r) { float* hp = HF + (32 * lb + crow(r, hi)) * 129 + 32 * (2 * vh + vt) + r32; const float hv_ = O[vt][r] * INV[w * 32 + crow(r, hi)];
                *hp = d ? (*hp + hv_) : hv_; }
        LDS_WAIT();
    }
    __syncthreads();
    { const int p = tid >> 2, part = tid & 3; const size_t row = (size_t)b * SEQ + 128 * n + p;
      float hv[32]; float ss = 0.f;
#pragma unroll
      for (int e = 0; e < 32; ++e) { hv[e] = HF[p * 129 + 32 * part + e]; ss += hv[e] * hv[e]; }
      ss += shx(ss, 1); ss += shx(ss, 2);
      const float rstd = rsqrtf(ss * (1.0f / 128.0f) + EPS);
      const bf16* op = proj + row * DINP + C_DO + 128 * h + 32 * part; const float* gp = F.in[I_MLG] + l * 512 + 128 * h + 32 * part;
      bf16* yp = (bf16*)(F.ws + WS_Y) + row * DM + 1536 + 128 * h + 32 * part;
#pragma unroll
      for (int e8 = 0; e8 < 4; ++e8) { const u32x4 ov = *(const u32x4*)(op + 8 * e8); const unsigned ow[4] = {ov.x, ov.y, ov.z, ov.w}; unsigned pk[4];
#pragma unroll
          for (int e = 0; e < 4; ++e) { const float y0 = hv[8 * e8 + 2 * e] * rstd * gp[8 * e8 + 2 * e] * sigmoidf_(bflo(ow[e])); const float y1 = hv[8 * e8 + 2 * e + 1] * rstd * gp[8 * e8 + 2 * e + 1] * sigmoidf_(bfhi(ow[e])); pk[e] = pk2(y0, y1); }
          *(u32x4*)(yp + 8 * e8) = (u32x4){pk[0], pk[1], pk[2], pk[3]}; } }
}

__device__ __forceinline__ void mixer_phase(Frame& F0, int l, int stage, int rep) {
    unsigned* ctr = (unsigned*)(F0.ws + WS_CTL) + 64 * (1 + (l * 3 + stage) * 2 + rep);
    const int nitems = (stage == 0) ? 1792 : 1024;
    for (;;) {
        const int it = next_item(ctr, F0.lds);
        if (it >= nitems) break;
        Frame F = F0;
        { unsigned zoff = 0u; asm volatile("" : "+s"(zoff)); F.ws = F0.ws + zoff; F.out = F0.out + zoff; F.in = F0.in + zoff; F.tid = lt(); F.lane = F.tid & 63; F.wave = __builtin_amdgcn_readfirstlane(F.tid >> 6); }
#if MK_PROBE
        if (rep == 1) { int ty; if (stage == 0) ty = it < 512 ? 4 : (it < 768 ? 3 : 5); else ty = it < 256 ? 1 : (it < 512 ? 2 : ((stage == 1 && it < 768) ? 3 : 4));
            if (!((MK_PTYPE >> ty) & 1)) continue; }
#endif
        if (stage == 0) {
            if (it < 512) ml1_item(F, it);
            else if (it < 768) lru_item<1>(F, l, it - 512);
            else if (it < 1536) hy_prep_item(F, l, it - 768);
            else attn_prep_item(F, l, it - 1536);
        } else {
            if (it < 256) hy_conv_item(F, l, stage - 1, it);
            else if (it < 512) {
                volatile unsigned* slot = (volatile unsigned*)(F.lds + SLOT_OFF);
                if (F.tid == 0) { unsigned* actr = (unsigned*)(F.ws + WS_CTL) + 64 * (32 + (l * 2 + (stage - 1)) * 8); const unsigned x0 = xb_xcc_id() & 7u; unsigned unit = 0u;
                    for (unsigned k = 0; k < 8; ++k) { const unsigned x = (x0 + k) & 7u; if (__hip_atomic_load(actr + 64 * x, __ATOMIC_RELAXED, __HIP_MEMORY_SCOPE_AGENT) >= 32u) continue;
                        const unsigned a = atomicAdd(actr + 64 * x, 1u); if (a < 32u) { unit = x * 32u + a; break; } }
                    slot[1] = unit; }
                __syncthreads();
                const int un = (int)slot[1]; const int x = un >> 5, a = un & 31; const int b_ = x >> 1, h_ = (x & 1) * 4 + (a >> 3), qb = (a & 7) + (stage == 2 ? 8 : 0);
                attn_body::attn_unit<8>(b_, h_, qb, (const attn_body::bf16*)(F.ws + WS_QB), (const attn_body::bf16*)(F.ws + WS_KB),
                                        (const attn_body::bf16*)(F.ws + WS_VB), (attn_body::bf16*)(F.ws + WS_Y) + 512, (char*)F.lds); }
            else if (stage == 1) { if (it < 768) lru_item<2>(F, l, it - 512); else ml2_item(F, it - 768); }
            else ml3_item(F, l, it - 512);
        }
    }
    __syncthreads();
}

constexpr int N_PHASES = 22;
__global__ void __launch_bounds__(512, 2) fwd_kernel(Args args) {
    extern __shared__ __attribute__((aligned(16))) unsigned char lds[];
    cg::grid_group grid = cg::this_grid();
    volatile LAS unsigned* xst = (volatile LAS unsigned*)((LAS unsigned char*)lds + SLOT_OFF + 16);
    if (threadIdx.x == 0) { xst[0] = 0u; xst[1] = 0u; }
    __syncthreads();
    const XcdBarrier xbar = xcd_barrier_post((unsigned*)(args.ws + WS_CTL) + 4096, xst);
    Frame F0; F0.lds = lds; F0.ws = args.ws; F0.in = args.in; F0.out = args.out;
    F0.tid = threadIdx.x; F0.lane = F0.tid & 63; F0.wave = __builtin_amdgcn_readfirstlane(F0.tid >> 6); F0.G = gridDim.x;
    int ph = args.ph_lo, rep = 0;
#if (MK_PROBE & 8)
#pragma unroll 1
    for (int i = 0; i < 40; ++i) grid.sync();
#endif
#pragma unroll 1
    while (ph < args.ph_hi) {
        Frame F = F0;
        { unsigned zoff = 0u; asm volatile("" : "+s"(zoff)); F.ws = F0.ws + zoff; F.out = F0.out + zoff; F.in = F0.in + zoff; F.tid = lt(); F.lane = F.tid & 63; F.wave = __builtin_amdgcn_readfirstlane(F.tid >> 6); }
        if (ph == 0) p0_prologue(F);
        else if (ph == N_PHASES - 1) final_norm_phase(F, F.out, F.in[I_FG]);
        else {
            const int l = (ph - 1) / 10, k = (ph - 1) % 10;
            const float* mod = (const float*)(F.ws + WS_MOD) + (size_t)l * 4 * 12288;
            if (k == 0 || k == 7) {
                if (ph == 1) hy_scale_reduce(F);
                const float* xin = (ph == 1) ? F.in[I_X] : F.out;
                if (k == 0) norm_phase(F, xin, F.in[I_NMG] + l * DM, mod + 0 * DM, mod + 1 * DM, (bf16*)(F.ws + WS_XN));
                else norm_phase(F, xin, F.in[I_NFG] + l * DM, mod + 3 * DM, mod + 4 * DM, (bf16*)(F.ws + WS_XN));
            } else if (k == 1) {
                pg8::Gemm g{(const pg8::bf16_t*)(F.ws + WS_XN), (const pg8::bf16_t*)(F.ws + WS_WIN) + (size_t)l * DINP * DM, MTOK, DINP, DM};
                pg8::StaticOrder S; S.init(MTOK, DINP, F.G, (int)blockIdx.x);
                pg8::EpiInProj E{(pg8::bf16_t*)(F.ws + WS_PROJ), DINP, (const float*)(F.ws + WS_BINP) + l * DINP, (float*)(F.ws + WS_GATES)};
                pg8::gemm_phase<pg8::EpiInProj, pg8::StaticOrder, true, false>((LAS unsigned char*)lds, g, S, E);
            } else if (k >= 2 && k <= 4) {
                mixer_phase(F, l, k - 2, rep);
            } else if (k == 5) {
                hy_out_phase(F);
            } else if (k == 6) {
                pg8::Gemm g{(const pg8::bf16_t*)(F.ws + WS_Y), (const pg8::bf16_t*)(F.ws + WS_WOUT) + (size_t)l * DM * DM, MTOK, DM, DM};
                pg8::StaticOrder S; S.init(MTOK, DM, F.G, (int)blockIdx.x);
                pg8::EpiResGate E{(l == 0) ? F.in[I_X] : (const float*)F.out, F.out, DM, mod + 2 * DM, 12288};
                pg8::gemm_phase<pg8::EpiResGate, pg8::StaticOrder, true, false>((LAS unsigned char*)lds, g, S, E);
            } else if (k == 8) {
                pg8::Gemm g{(const pg8::bf16_t*)(F.ws + WS_XN), (const pg8::bf16_t*)(F.ws + WS_W13) + (size_t)l * 2 * DFF * DM, MTOK, 2 * DFF, DM};
                pg8::StaticOrder S; S.init(MTOK, 2 * DFF, F.G, (int)blockIdx.x);
                pg8::EpiSwiGLU E{(pg8::bf16_t*)(F.ws + WS_PROJ), DFF};
                pg8::gemm_phase<pg8::EpiSwiGLU, pg8::StaticOrder, true, false>((LAS unsigned char*)lds, g, S, E);
            } else {
                pg8::Gemm g{(const pg8::bf16_t*)(F.ws + WS_PROJ), (const pg8::bf16_t*)(F.ws + WS_W2) + (size_t)l * DM * DFF, MTOK, DM, DFF};
                pg8::StaticOrder S; S.init(MTOK, DM, F.G, (int)blockIdx.x);
                pg8::EpiResGate E{(const float*)F.out, F.out, DM, mod + 5 * DM, 12288};
                pg8::gemm_phase<pg8::EpiResGate, pg8::StaticOrder, true, false>((LAS unsigned char*)lds, g, S, E);
            }
        }
        bool again = false;
#if MK_PROBE
        if (rep == 0) { const int kk = (ph == 0 || ph == N_PHASES - 1) ? -1 : (ph - 1) % 10;
          if ((MK_PROBE & 1) && kk >= 2 && kk <= 4) again = true;
          if ((MK_PROBE & 16) && kk == 2) again = true;
          if ((MK_PROBE & 64) && ph == 0) again = true;
          if ((MK_PROBE & 128) && (kk == 0 || kk == 7)) again = true;
          if ((MK_PROBE & 32) && kk == 3) again = true;
          if ((MK_PROBE & 2) && (kk == 1 || kk == 8)) again = true;
          if ((MK_PROBE & 4) && (kk == 0 || kk == 7 || ph == 0)) again = true; }
#endif
        if (again) rep = 1; else { rep = 0; ++ph; }
        if (ph < args.ph_hi) { if (ph == 1 && rep == 0) grid.sync(); else xcd_barrier(xbar); }
    }
}

#ifndef MK_N_LAUNCHES
#define MK_N_LAUNCHES 1
#endif
extern "C" void kernel_launch(void* const* d_in, const int* in_sizes, int n_in, void* d_out, int out_size, void* d_ws, size_t ws_size, hipStream_t stream) {
    static int grid = 0;
    if (grid == 0) {
        if (n_in != 33 || out_size != MTOK * DM || ws_size < WS_END) { fprintf(stderr, "kernel_launch: unexpected shapes (n_in %d, out %d, ws %zu < %zu)\n", n_in, out_size, ws_size, (size_t)WS_END); grid = -1; return; }
        int dev = 0, cus = 0, per_cu = 0;
        (void)hipGetDevice(&dev); (void)hipDeviceGetAttribute(&cus, hipDeviceAttributeMultiprocessorCount, dev);
        if (hipFuncSetAttribute((const void*)fwd_kernel, hipFuncAttributeMaxDynamicSharedMemorySize, LDS_BYTES) != hipSuccess) { fprintf(stderr, "kernel_launch: hipFuncSetAttribute failed\n"); grid = -1; return; }
        if (hipOccupancyMaxActiveBlocksPerMultiprocessor(&per_cu, (const void*)fwd_kernel, 512, LDS_BYTES) != hipSuccess || per_cu < 1) per_cu = 1;
        (void)hipGetLastError();
        grid = cus * per_cu;
        fprintf(stderr, "kernel_launch: grid %d (cus %d x %d), ws %zu\n", grid, cus, per_cu, ws_size);
    }
    if (grid < 0) return;
    (void)hipMemsetAsync((char*)d_ws + WS_CTL, 0, CTL_BYTES, stream);
    Args a{};
    for (int i = 0; i < 33; ++i) a.in[i] = (const float*)d_in[i];
    a.out = (float*)d_out; a.ws = (unsigned char*)d_ws;
    if (MK_N_LAUNCHES == 1) {
        a.ph_lo = 0; a.ph_hi = N_PHASES;
        void* kargs[] = {&a};
        const hipError_t e = hipLaunchCooperativeKernel((const void*)fwd_kernel, dim3(grid), dim3(512), kargs, LDS_BYTES, stream);
        if (e != hipSuccess) fprintf(stderr, "kernel_launch: cooperative launch failed: %s (grid %d)\n", hipGetErrorString(e), grid);
    } else {
        for (int ph = 0; ph < N_PHASES; ++ph) { a.ph_lo = ph; a.ph_hi = ph + 1; hipLaunchKernelGGL(fwd_kernel, dim3(grid), dim3(512), LDS_BYTES, stream, a); }
    }
}
```

```cpp
#include <hip/hip_runtime.h>
#include <hip/hip_cooperative_groups.h>
#include <hip/hip_bf16.h>
#include <cstdio>
#include <cstdint>
#include <cmath>
namespace cg = cooperative_groups;

#define LAS __attribute__((address_space(3)))
typedef unsigned short bf16;
typedef short bf16x8 __attribute__((ext_vector_type(8)));
typedef float f32x2 __attribute__((ext_vector_type(2)));
typedef float f32x4 __attribute__((ext_vector_type(4)));
typedef float f32x16 __attribute__((ext_vector_type(16)));
typedef unsigned u32x4 __attribute__((ext_vector_type(4)));
typedef unsigned u32x2 __attribute__((ext_vector_type(2)));

constexpr int DM = 2048, NBATCH = 4, SEQ = 4096, MTOK = NBATCH * SEQ, DEPTH = 2, DIN = 5392, DINP = 5632, DFF = 5632;
constexpr int C_AX = 0, C_AG = 512, C_BQ = 1024, C_BK = 1536, C_BV = 1664, C_CU = 1792, C_DQ = 3328, C_DK = 3840, C_DV = 4352, C_DO = 4864, C_GT = 5376;
constexpr float EPS = 1e-6f;

constexpr size_t MiB = (size_t)1 << 20;
constexpr size_t WS_CTL = 0, CTL_BYTES = 1 * MiB;
constexpr size_t WS_MOD = 1 * MiB;
constexpr size_t WS_HYSC = 1 * MiB + 512 * 1024;
constexpr size_t WS_BINP = 1 * MiB + 576 * 1024;
constexpr size_t WS_LRUS = 2 * MiB;
constexpr size_t WS_HYPART = 4 * MiB;
constexpr size_t WS_WIN = 8 * MiB;
constexpr size_t WS_WOUT = 52 * MiB;
constexpr size_t WS_W13 = 68 * MiB;
constexpr size_t WS_W2 = 156 * MiB;
constexpr size_t WS_HYFT = 200 * MiB;
constexpr size_t WS_LRUW = 232 * MiB;
constexpr size_t WS_MLDN = 233 * MiB;
constexpr size_t WS_MLNP = 233 * MiB + 512 * 1024;
constexpr size_t WS_MLSC = 234 * MiB;
constexpr size_t WS_GATES = 235 * MiB;
constexpr size_t WS_XN = 240 * MiB;
constexpr size_t WS_MLDC = WS_XN;
constexpr size_t WS_PROJ = 304 * MiB;
constexpr size_t WS_Y = 480 * MiB;
constexpr size_t WS_QB = 544 * MiB;
constexpr size_t WS_KB = 560 * MiB;
constexpr size_t WS_VB = 564 * MiB;
constexpr size_t WS_HT = 568 * MiB;
constexpr size_t WS_Z1T = 616 * MiB;
constexpr size_t WS_MLCT = 632 * MiB;
constexpr size_t WS_END = 664 * MiB;

constexpr int LDS_BYTES = 147456;
constexpr int SLOT_OFF = LDS_BYTES - 64;

__device__ __forceinline__ unsigned f2bf(float f) { unsigned u = __builtin_bit_cast(unsigned, f); return (u + 0x7fffu + ((u >> 16) & 1u)) >> 16; }
__device__ __forceinline__ unsigned pk2(float lo, float hi) { return f2bf(lo) | (f2bf(hi) << 16); }
__device__ __forceinline__ float bf2f(unsigned h) { return __builtin_bit_cast(float, h << 16); }
__device__ __forceinline__ float bflo(unsigned w) { return __builtin_bit_cast(float, w << 16); }
__device__ __forceinline__ float bfhi(unsigned w) { return __builtin_bit_cast(float, w & 0xffff0000u); }
__device__ __forceinline__ int lt() { int t = threadIdx.x; asm volatile("" : "+v"(t)); return t; }
__device__ __forceinline__ float shx(float v, int m) { const int l = lt() & 63; return __builtin_bit_cast(float, __builtin_amdgcn_ds_bpermute((l ^ m) << 2, __builtin_bit_cast(int, v))); }
__device__ __forceinline__ float shl_(float v, int src) { return __builtin_bit_cast(float, __builtin_amdgcn_ds_bpermute(src << 2, __builtin_bit_cast(int, v))); }
__device__ __forceinline__ float wave_sum(float v) {
#pragma unroll
    for (int o = 1; o < 64; o <<= 1) v += shx(v, o);
    return v;
}
__device__ __forceinline__ float sigmoidf_(float x) { return __builtin_amdgcn_rcpf(1.0f + __expf(-x)); }
__device__ __forceinline__ float sin_rad(float x) { return __builtin_amdgcn_sinf(x * 0.15915494309189535f); }
__device__ __forceinline__ float cos_rad(float x) { return __builtin_amdgcn_cosf(x * 0.15915494309189535f); }
__device__ __forceinline__ float logsigmoidf_(float x) { return fminf(x, 0.f) - log1pf(__expf(-fabsf(x))); }
__device__ __forceinline__ int crow(int r, int hi) { return (r & 3) + 8 * (r >> 2) + 4 * hi; }
#define LDS_WAIT() asm volatile("s_waitcnt lgkmcnt(0)" ::: "memory")


#define XB_TMO      128
#define XB_XCNT(j)  (256  + 64 * (j))
#define XB_XSUB(j)  (1280 + 64 * (j))
#define XB_XGEN(j)  (2304 + 64 * (j))
#define XB_TOP      3328
#define XB_TOPGEN   3392
#define XCD_BAR_WORDS 3456
#define XB_SPIN_CAP (1u << 18)

__device__ __forceinline__ unsigned xb_ld(unsigned* p)              { return __hip_atomic_load(p, __ATOMIC_RELAXED, __HIP_MEMORY_SCOPE_AGENT); }
__device__ __forceinline__ unsigned xb_add(unsigned* p, unsigned v) { return __hip_atomic_fetch_add(p, v, __ATOMIC_RELAXED, __HIP_MEMORY_SCOPE_AGENT); }
__device__ __forceinline__ unsigned xb_xcc_id() { return (unsigned)__builtin_amdgcn_s_getreg((3 << 11) | 20) & 0xFu; }
#define XB_SPIN(cond, bar) do { unsigned _sp = 0; while (cond) { __builtin_amdgcn_s_sleep(1); \
    if ((++_sp & 255u) == 0u) { if (xb_ld(&(bar)[XB_TMO])) break; if (_sp > XB_SPIN_CAP) { atomicAdd(&(bar)[XB_TMO], 1u); break; } } } } while (0)

struct XcdBarrier {
    unsigned* bar; unsigned x;
    volatile LAS unsigned* st;
};

__device__ __forceinline__ XcdBarrier xcd_barrier_post(unsigned* bar, volatile LAS unsigned* st) {
    XcdBarrier b; b.bar = bar; b.x = xb_xcc_id(); b.st = st;
    if (threadIdx.x == 0) (void)xb_add(&bar[XB_XCNT(b.x)], 1u);
    return b;
}
__device__ __forceinline__ void xcd_barrier_complete(unsigned* bar, unsigned x, unsigned& nloc, unsigned& nx) {
    const unsigned G = gridDim.x * gridDim.y * gridDim.z;
    unsigned sum, cnt, mine, sp = 0u;
    for (;;) {
        sum = 0u; cnt = 0u; mine = 0u;
#pragma unroll 1
        for (unsigned j = 0; j < 16; ++j) { const unsigned c = xb_ld(&bar[XB_XCNT(j)]); sum += c; cnt += (c > 0u) ? 1u : 0u; mine = (j == x) ? c : mine; }
        if (sum == G) break;
        __builtin_amdgcn_s_sleep(1);
        if ((++sp & 255u) == 0u) { if (xb_ld(&bar[XB_TMO])) break; if (sp > XB_SPIN_CAP) { atomicAdd(&bar[XB_TMO], 1u); break; } }
    }
    nloc = mine > 0u ? mine : 1u; nx = cnt > 0u ? cnt : 1u;
}

__device__ __forceinline__ void xcd_barrier(const XcdBarrier& b) {
    asm volatile("s_waitcnt vmcnt(0)" ::: "memory");
    __syncthreads();
    if (threadIdx.x == 0) {
        unsigned zo_ = 0u; asm volatile("" : "+s"(zo_));
        unsigned* bar = b.bar + zo_;
        __builtin_amdgcn_s_waitcnt(0);
        unsigned nloc = b.st[0], nx = b.st[1];
        if (nloc == 0u) { xcd_barrier_complete(bar, b.x, nloc, nx); b.st[0] = nloc; b.st[1] = nx; }
        const unsigned old = xb_add(&bar[XB_XSUB(b.x)], 1u);
        const unsigned gen = old / nloc;
        if (old + 1u == (gen + 1u) * nloc) {
            __builtin_amdgcn_fence(__ATOMIC_RELEASE, "agent");
            asm volatile("s_waitcnt vmcnt(0)" ::: "memory");
            const unsigned og = xb_add(&bar[XB_TOP], 1u);
            const unsigned tg = og / nx;
            if (og + 1u == (tg + 1u) * nx) xb_add(&bar[XB_TOPGEN], 1u);
            else XB_SPIN(xb_ld(&bar[XB_TOPGEN]) == tg, bar);
            __builtin_amdgcn_fence(__ATOMIC_ACQUIRE, "agent");
            xb_add(&bar[XB_XGEN(b.x)], 1u);
            asm volatile("s_waitcnt vmcnt(0)" ::: "memory");
        } else {
            XB_SPIN(xb_ld(&bar[XB_XGEN(b.x)]) == gen, bar);
            __builtin_amdgcn_fence(__ATOMIC_ACQUIRE, "agent");
            asm volatile("s_waitcnt vmcnt(0)" ::: "memory");
        }
    }
    __syncthreads();
}
namespace pg8 {
#define PG8_LAS __attribute__((address_space(3)))
typedef unsigned short bf16_t;
typedef short bf16x8 __attribute__((ext_vector_type(8)));
typedef float f32x4 __attribute__((ext_vector_type(4)));
typedef unsigned u32x4 __attribute__((ext_vector_type(4)));
constexpr int BM = 256, BK = 64, HALF = 128, HTB = HALF * BK * 2  , STAGE_BYTES = 8 * HTB, NXCD = 8, WGM = 8;

__host__ __device__ __forceinline__ int lds_byte(int r, int c) { const int st = (r >> 4) * 2 + (c >> 5), rr = r & 15, cc = c & 31, ob = rr * 64 + cc * 2; return st * 1024 + (ob ^ (((ob >> 9) & 1) << 5)); }
__host__ __device__ __forceinline__ void stage_rc(int b, int& R, int& C) { const int st = b / 1024, sb = b % 1024, swz = sb ^ (((sb >> 9) & 1) << 5); R = (st >> 1) * 16 + swz / 64; C = (st & 1) * 32 + (swz % 64) / 2; }
__host__ __device__ __forceinline__ int perm32(int rho) { const int n = rho >> 4, i = rho & 15; return 8 * (i >> 2) + 4 * n + (i & 3); }

struct Unit { int pm, pn; };
struct Gemm { const bf16_t* A; const bf16_t* Bt; int M, N, K; };

struct StaticOrder {
    int nM, nN, nwg, G, c;
    __host__ __device__ void init(int M, int N, int G_, int c_) { nM = M / BM; nN = N / BM; nwg = nM * nN; G = G_; c = c_; }
    __host__ __device__ bool next(int i, Unit& u) const {
        const long L = (long)i * G + c; if (L >= nwg) return false;
        int wgid = (int)L; { const int q = nwg / NXCD, r = nwg % NXCD, xcd = wgid % NXCD, off = wgid / NXCD; wgid = (xcd < r ? xcd * (q + 1) : r * (q + 1) + (xcd - r) * q) + off; }
        const int nig = WGM * nN, gid = wgid / nig, fm = gid * WGM, gsz = (nM - fm) < WGM ? (nM - fm) : WGM;
        u.pm = fm + ((wgid % nig) % gsz); u.pn = (wgid % nig) / gsz; return true;
    }
    __device__ __forceinline__ void a_ready(const Unit&) const {}
    __device__ __forceinline__ void done(const Unit&) const {}
};

__device__ __forceinline__ unsigned cvt_pk_bf16(float lo, float hi) { unsigned r; asm volatile("v_cvt_pk_bf16_f32 %0, %1, %2" : "=v"(r) : "v"(lo), "v"(hi)); return r; }

struct EpiInProj {
    static constexpr bool PERM = true, AFTER_DRAIN = false;
    bf16_t* O; int ldc; const float* bias; float* gates;
    __device__ __forceinline__ void operator()(const f32x4 (&acc)[2][2][4][2], const Unit& u, int wr, int wc, int fr, int fq) const {
        const int row0 = u.pm * BM + wr * 64 + fr; const int col0 = u.pn * BM + wc * 32 + 8 * fq;
        f32x4 bv[2][2];
#pragma unroll
        for (int bj = 0; bj < 2; ++bj)
#pragma unroll
            for (int n = 0; n < 2; ++n) bv[bj][n] = *(const f32x4*)(bias + col0 + bj * HALF + 4 * n);
        const bool gate_lane = (u.pn == 21) && (wc == 0) && (fq < 2);
#pragma unroll
        for (int ai = 0; ai < 2; ++ai)
#pragma unroll
            for (int m = 0; m < 4; ++m) { const int row = row0 + ai * HALF + m * 16; bf16_t* rowp = O + (size_t)row * ldc + col0;
#pragma unroll
                for (int bj = 0; bj < 2; ++bj) { const f32x4 v0 = acc[ai][bj][m][0] + bv[bj][0], v1 = acc[ai][bj][m][1] + bv[bj][1];
                    u32x4 w; w.x = cvt_pk_bf16(v0[0], v0[1]); w.y = cvt_pk_bf16(v0[2], v0[3]); w.z = cvt_pk_bf16(v1[0], v1[1]); w.w = cvt_pk_bf16(v1[2], v1[3]);
                    *(u32x4*)(rowp + bj * HALF) = w;
                    if (bj == 0 && gate_lane) { float* gp = gates + (size_t)row * 16 + 8 * fq; *(f32x4*)gp = v0; *(f32x4*)(gp + 4) = v1; } } }
    }
};
struct EpiResGate {
    static constexpr bool PERM = false, AFTER_DRAIN = false;
    const float* base; float* out; int ldc; const float* g; int ldg;
    __device__ __forceinline__ void operator()(const f32x4 (&acc)[2][2][4][2], const Unit& u, int wr, int wc, int fr, int fq) const {
        const int col0 = u.pn * BM + wc * 32 + 4 * fq; const int b = (u.pm * BM) >> 12;
        f32x4 gv[2][2];
#pragma unroll
        for (int bj = 0; bj < 2; ++bj)
#pragma unroll
            for (int n = 0; n < 2; ++n) gv[bj][n] = *(const f32x4*)(g + (size_t)b * ldg + col0 + bj * HALF + n * 16);
#pragma unroll
        for (int ai = 0; ai < 2; ++ai) {
            f32x4 bs[4][2][2];
#pragma unroll
            for (int m = 0; m < 4; ++m) { const int r = u.pm * BM + ai * HALF + wr * 64 + m * 16 + fr; const size_t off = (size_t)r * ldc + col0;
#pragma unroll
                for (int bj = 0; bj < 2; ++bj)
#pragma unroll
                    for (int n = 0; n < 2; ++n) bs[m][bj][n] = *(const f32x4*)(base + off + bj * HALF + n * 16); }
#pragma unroll
            for (int m = 0; m < 4; ++m) { const int r = u.pm * BM + ai * HALF + wr * 64 + m * 16 + fr; const size_t off = (size_t)r * ldc + col0;
#pragma unroll
                for (int bj = 0; bj < 2; ++bj)
#pragma unroll
                    for (int n = 0; n < 2; ++n) *(f32x4*)(out + off + bj * HALF + n * 16) = bs[m][bj][n] + gv[bj][n] * acc[ai][bj][m][n]; }
        }
    }
};
struct EpiSwiGLU {
    static constexpr bool PERM = true, AFTER_DRAIN = false;
    bf16_t* O; int ldc;
    __device__ __forceinline__ float silu(float x) const { return x * __builtin_amdgcn_rcpf(1.0f + __expf(-x)); }
    __device__ __forceinline__ void operator()(const f32x4 (&acc)[2][2][4][2], const Unit& u, int wr, int wc, int fr, int fq) const {
        const int row0 = u.pm * BM + wr * 64 + fr; const int col0 = u.pn * HALF + wc * 32 + 8 * fq;
#pragma unroll
        for (int ai = 0; ai < 2; ++ai)
#pragma unroll
            for (int m = 0; m < 4; ++m) { const int row = row0 + ai * HALF + m * 16;
                const f32x4 a0 = acc[ai][0][m][0], a1 = acc[ai][0][m][1], b0 = acc[ai][1][m][0], b1 = acc[ai][1][m][1];
                u32x4 w;
                w.x = cvt_pk_bf16(silu(a0[0]) * b0[0], silu(a0[1]) * b0[1]); w.y = cvt_pk_bf16(silu(a0[2]) * b0[2], silu(a0[3]) * b0[3]);
                w.z = cvt_pk_bf16(silu(a1[0]) * b1[0], silu(a1[1]) * b1[1]); w.w = cvt_pk_bf16(silu(a1[2]) * b1[2], silu(a1[3]) * b1[3]);
                *(u32x4*)(O + (size_t)row * ldc + col0) = w; }
    }
};

template <class Epi, class Sched, bool ALIGN_EPI = false, bool SP2 = false>
__device__ __forceinline__ void gemm_phase(PG8_LAS unsigned char* lds, const Gemm g, const Sched& S, const Epi& E) {
    const int tid = lt(), wid = __builtin_amdgcn_readfirstlane(tid >> 6), lane = tid & 63, wr = wid >> 2, wc = wid & 3, fr = lane & 15, fq = lane >> 4;
    const int K = g.K, nt = K / BK;
    unsigned voffA[2], voffB[2];
#pragma unroll
    for (int i = 0; i < 2; ++i) { int R, C; stage_rc(tid * 16 + i * 8192, R, C); const int Rb = Epi::PERM ? ((R & ~31) + perm32(R & 31)) : R;
        voffA[i] = (unsigned)(R * K + C) * 2u; voffB[i] = (unsigned)(Rb * K + C) * 2u; }
    const size_t kstep = (size_t)(BK * 2);
    const size_t hstep = (size_t)HALF * K * 2;
    const size_t tstep = 2 * hstep;
    const unsigned ldsw = (unsigned)wid * 1024u;
    const int aoff = lds_byte(wr * 64 + fr, fq * 8), boff = lds_byte(wc * 32 + fr, fq * 8);
#define PG8_SA(b, h) (((b) * 2 + (h)) * HTB)
#define PG8_SB(b, h) ((4 + (b) * 2 + (h)) * HTB)
#define PG8_STAGE(bufoff, gbase, voff) do { _Pragma("unroll") for (int _i = 0; _i < 2; ++_i) \
        __builtin_amdgcn_global_load_lds((const unsigned*)((const char*)(gbase) + (voff)[_i]), (PG8_LAS unsigned*)(lds + (bufoff) + ldsw + _i * 8192), 16, 0, 0); } while (0)
#define PG8_LDA(dst, b, h) do { _Pragma("unroll") for (int m = 0; m < 4; ++m) _Pragma("unroll") for (int k = 0; k < 2; ++k) dst[m][k] = *(const PG8_LAS bf16x8*)(lds + PG8_SA(b, h) + aoff + m * 2048 + k * 1024); } while (0)
#define PG8_LDB(dst, b, h) do { _Pragma("unroll") for (int n = 0; n < 2; ++n) _Pragma("unroll") for (int k = 0; k < 2; ++k) dst[n][k] = *(const PG8_LAS bf16x8*)(lds + PG8_SB(b, h) + boff + n * 2048 + k * 1024); } while (0)
#define PG8_MMA(ai, bj, At, Bt) do { __builtin_amdgcn_s_setprio(1); _Pragma("unroll") for (int m = 0; m < 4; ++m) _Pragma("unroll") for (int n = 0; n < 2; ++n) _Pragma("unroll") for (int k = 0; k < 2; ++k) \
        acc[ai][bj][m][n] = __builtin_amdgcn_mfma_f32_16x16x32_bf16(Bt[n][k], At[m][k], acc[ai][bj][m][n], 0, 0, 0); __builtin_amdgcn_s_setprio(0); } while (0)
#define PG8_WAIT_V(n) asm volatile("s_waitcnt vmcnt(" #n ")" ::: "memory")
#define PG8_WAIT_L(n) asm volatile("s_waitcnt lgkmcnt(" #n ")" ::: "memory")
#define PG8_BAR __builtin_amdgcn_s_barrier()
#define PG8_SCHED __builtin_amdgcn_sched_barrier(0)
    Unit cur, nxt; int ui = 0;
    if (!S.next(0, cur)) return;
    f32x4 acc[2][2][4][2];
#pragma unroll
    for (int a = 0; a < 2; ++a)
#pragma unroll
        for (int b = 0; b < 2; ++b)
#pragma unroll
            for (int m = 0; m < 4; ++m)
#pragma unroll
                for (int n = 0; n < 2; ++n) acc[a][b][m][n] = (f32x4){0.f, 0.f, 0.f, 0.f};
    bf16x8 At[4][2], B0[2][2], B1[2][2];
    const char* cA = (const char*)g.A + (size_t)cur.pm * tstep; const char* cB = (const char*)g.Bt + (size_t)cur.pn * tstep;
    S.a_ready(cur);
    if constexpr (SP2) {
        PG8_STAGE(PG8_SB(0, 0), cB, voffB); PG8_STAGE(PG8_SB(0, 1), cB + hstep, voffB); PG8_STAGE(PG8_SA(0, 0), cA, voffA); PG8_STAGE(PG8_SA(0, 1), cA + hstep, voffA);
        if (wr == 1) PG8_BAR;
        PG8_WAIT_V(2); PG8_BAR;
        PG8_STAGE(PG8_SB(1, 0), cB + kstep, voffB); PG8_STAGE(PG8_SA(1, 0), cA + kstep, voffA); PG8_STAGE(PG8_SB(1, 1), cB + hstep + kstep, voffB);
        PG8_WAIT_V(6); PG8_BAR;
    } else {
        PG8_STAGE(PG8_SB(0, 0), cB, voffB); PG8_STAGE(PG8_SA(0, 0), cA, voffA); PG8_STAGE(PG8_SB(0, 1), cB + hstep, voffB); PG8_STAGE(PG8_SA(0, 1), cA + hstep, voffA);
        if (wr == 1) PG8_BAR;
        PG8_WAIT_V(4); PG8_BAR;
        PG8_STAGE(PG8_SB(1, 0), cB + kstep, voffB); PG8_STAGE(PG8_SA(1, 0), cA + kstep, voffA); PG8_STAGE(PG8_SB(1, 1), cB + hstep + kstep, voffB);
        PG8_WAIT_V(6); PG8_BAR;
    }
    for (;;) {
        const bool has_next = S.next(ui + 1, nxt);
        const char* nA = has_next ? (const char*)g.A + (size_t)nxt.pm * tstep : cA; const char* nB = has_next ? (const char*)g.Bt + (size_t)nxt.pn * tstep : cB;
        for (int t = 0; t < nt; t += 2) {
            const bool last = (t == nt - 2);
            const char* a1 = cA + (size_t)(t + 1) * kstep;
            const char* a2 = last ? nA : cA + (size_t)(t + 2) * kstep; const char* b2 = last ? nB : cB + (size_t)(t + 2) * kstep;
            const char* a3 = a2 + kstep; const char* b3 = b2 + kstep;
            if (last && has_next) S.a_ready(nxt);
            if constexpr (SP2) {
            PG8_LDB(B0, 0, 0); PG8_LDB(B1, 0, 1); PG8_SCHED; PG8_LDA(At, 0, 0); PG8_STAGE(PG8_SA(1, 1), a1 + hstep, voffA);
            PG8_WAIT_V(8); PG8_WAIT_L(0); PG8_BAR; PG8_MMA(0, 0, At, B0); PG8_MMA(0, 1, At, B1); PG8_BAR; PG8_SCHED;
            PG8_LDA(At, 0, 1); PG8_STAGE(PG8_SB(0, 0), b2, voffB); PG8_STAGE(PG8_SB(0, 1), b2 + hstep, voffB); PG8_STAGE(PG8_SA(0, 0), a2, voffA);
            PG8_WAIT_V(8); PG8_WAIT_L(0); PG8_BAR; PG8_MMA(1, 0, At, B0); PG8_MMA(1, 1, At, B1); PG8_BAR; PG8_SCHED;
            PG8_LDB(B0, 1, 0); PG8_LDB(B1, 1, 1); PG8_SCHED; PG8_LDA(At, 1, 0); PG8_STAGE(PG8_SA(0, 1), a2 + hstep, voffA);
            PG8_WAIT_V(8); PG8_WAIT_L(0); PG8_BAR; PG8_MMA(0, 0, At, B0); PG8_MMA(0, 1, At, B1); PG8_BAR; PG8_SCHED;
            PG8_LDA(At, 1, 1); PG8_STAGE(PG8_SB(1, 0), b3, voffB); PG8_STAGE(PG8_SB(1, 1), b3 + hstep, voffB); PG8_STAGE(PG8_SA(1, 0), a3, voffA);
            PG8_WAIT_V(8); PG8_WAIT_L(0); PG8_BAR; PG8_MMA(1, 0, At, B0); PG8_MMA(1, 1, At, B1); PG8_BAR; PG8_SCHED;
            } else {
            PG8_LDB(B0, 0, 0); PG8_SCHED; PG8_LDA(At, 0, 0); PG8_STAGE(PG8_SA(1, 1), a1 + hstep, voffA);
            PG8_WAIT_L(8); PG8_BAR; PG8_WAIT_L(0); PG8_MMA(0, 0, At, B0); PG8_BAR; PG8_SCHED;
            PG8_LDB(B1, 0, 1); PG8_STAGE(PG8_SB(0, 0), b2, voffB);
            PG8_BAR; PG8_WAIT_L(0); PG8_MMA(0, 1, At, B1); PG8_BAR;
            PG8_LDA(At, 0, 1); PG8_STAGE(PG8_SA(0, 0), a2, voffA);
            PG8_BAR; PG8_WAIT_L(0); PG8_MMA(1, 0, At, B0); PG8_BAR; PG8_SCHED;
            PG8_STAGE(PG8_SB(0, 1), b2 + hstep, voffB);
            PG8_WAIT_V(6); PG8_BAR; PG8_MMA(1, 1, At, B1); PG8_BAR;
            PG8_LDB(B0, 1, 0); PG8_SCHED; PG8_LDA(At, 1, 0); PG8_STAGE(PG8_SA(0, 1), a2 + hstep, voffA);
            PG8_WAIT_L(8); PG8_BAR; PG8_WAIT_L(0); PG8_MMA(0, 0, At, B0); PG8_BAR; PG8_SCHED;
            PG8_LDB(B1, 1, 1); PG8_STAGE(PG8_SB(1, 0), b3, voffB);
            PG8_BAR; PG8_WAIT_L(0); PG8_MMA(0, 1, At, B1); PG8_BAR;
            PG8_LDA(At, 1, 1); PG8_STAGE(PG8_SA(1, 0), a3, voffA);
            PG8_BAR; PG8_WAIT_L(0); PG8_MMA(1, 0, At, B0); PG8_BAR; PG8_SCHED;
            PG8_STAGE(PG8_SB(1, 1), b3 + hstep, voffB);
            PG8_WAIT_V(6); PG8_BAR; PG8_MMA(1, 1, At, B1); PG8_BAR;
            }
        }
        if constexpr (ALIGN_EPI) { if (wr == 0) PG8_BAR; }
        if constexpr (!Epi::AFTER_DRAIN) { E(acc, cur, wr, wc, fr, fq); S.done(cur); }
        if (!has_next) break;
#pragma unroll
        for (int a = 0; a < 2; ++a)
#pragma unroll
            for (int b = 0; b < 2; ++b)
#pragma unroll
                for (int m = 0; m < 4; ++m)
#pragma unroll
                    for (int n = 0; n < 2; ++n) acc[a][b][m][n] = (f32x4){0.f, 0.f, 0.f, 0.f};
        cur = nxt; cA = nA; cB = nB; ++ui;
        if constexpr (ALIGN_EPI) { if (wr == 1) PG8_BAR; }
    }
    PG8_WAIT_V(0);
    if constexpr (!ALIGN_EPI) { if (wr == 0) PG8_BAR; }
    PG8_BAR;
    if constexpr (Epi::AFTER_DRAIN) { E.fused(acc, cur, wr, wc, fr, fq, lds, wid, lane); S.done(cur); }
#undef PG8_SA
#undef PG8_SB
#undef PG8_STAGE
#undef PG8_LDA
#undef PG8_LDB
#undef PG8_MMA
#undef PG8_WAIT_V
#undef PG8_WAIT_L
#undef PG8_BAR
#undef PG8_SCHED
}
}
namespace attn_body {
using bf16=__hip_bfloat16;
using bf16x8=__attribute__((ext_vector_type(8)))short;
using s16x4=__attribute__((ext_vector_type(4)))short;
using f32x16=__attribute__((ext_vector_type(16)))float;
using u32x4=__attribute__((ext_vector_type(4)))unsigned;
constexpr int BATCH=4,NHEAD=8,SEQ=4096,D=64,QP=512,KP=128,VP=128,OP=2048,GQ=4;
constexpr int NW=8,QBLK=32,QB=QBLK*NW,KVBLK=64,NQB=SEQ/QB;
constexpr int ATTN_UNIT_ROWS=QB;
__device__ __forceinline__ int crow(int r,int hi){return (r&3)+8*(r>>2)+4*hi;}
#define SBAR() __builtin_amdgcn_sched_barrier(0)
__device__ __forceinline__ void cmask(f32x16&p0,f32x16&p1,int jb,int qrel,int hi){
  const float NEG=-INFINITY; int kb=64*jb+4*hi;
  #pragma unroll
  for(int r=0;r<16;++r){int kv=kb+(r&3)+8*(r>>2); if(kv>qrel)p0[r]=NEG; if(kv+32>qrel)p1[r]=NEG;}
}

constexpr int NSLOT=3, SLOTB=8192;
constexpr int LDS_K=0, LDS_V=NSLOT*SLOTB, LDS_WS=2*NSLOT*SLOTB, LDS_OST=LDS_WS+NW*64*4, LDS_BYTES=LDS_OST+NW*4096;
constexpr float C2=0.125f*1.4426950408889634f;
__device__ __forceinline__ void glds16(const void*gsrc,unsigned lds_dst){unsigned keep;
  asm volatile("s_mov_b32 %0, m0\n\ts_mov_b32 m0, %2\n\ts_nop 0\n\tglobal_load_lds_dwordx4 %1, off\n\ts_mov_b32 m0, %0":"=&s"(keep):"v"(gsrc),"s"(lds_dst):"memory");}
__device__ __forceinline__ float max3f(float a,float b,float c){float r;asm("v_max3_f32 %0, %1, %2, %3":"=v"(r):"v"(a),"v"(b),"v"(c));return r;}
__device__ __forceinline__ float max2f(float a,float b){float r;asm("v_max_f32_e32 %0, %1, %2":"=v"(r):"v"(a),"v"(b));return r;}
__device__ __forceinline__ float fadd_s(float a,float b){float r;asm("v_add_f32_e32 %0, %1, %2":"=v"(r):"v"(a),"v"(b));return r;}
__device__ __forceinline__ float fsub_s(float a,float b){float r;asm("v_sub_f32_e32 %0, %1, %2":"=v"(r):"v"(a),"v"(b));return r;}
typedef float f32x2_t __attribute__((ext_vector_type(2))); typedef __bf16 bf16x2_t __attribute__((ext_vector_type(2)));
__device__ __forceinline__ unsigned cvtpk_s(float lo,float hi){f32x2_t v={lo,hi};bf16x2_t b=__builtin_convertvector(v,bf16x2_t);return __builtin_bit_cast(unsigned,b);}
#define WAIT_BAR(N) asm volatile("s_waitcnt vmcnt(" #N ") lgkmcnt(0)\n\ts_barrier":::"memory")

__device__ __forceinline__ void qkt(f32x16&p0,f32x16&p1,const char*Kslot,const bf16x8*qr,const f32x16&negm,int r32,int hi){
  const char*kb=Kslot+hi*1024+r32*16;
  #pragma unroll
  for(int d0=0;d0<4;++d0){
    const bf16x8 b0=*reinterpret_cast<const bf16x8*>(kb+d0*2048);
    const bf16x8 b1=*reinterpret_cast<const bf16x8*>(kb+d0*2048+512);
    if(d0==0){p0=__builtin_amdgcn_mfma_f32_32x32x16_bf16(b0,qr[0],negm,0,0,0);p1=__builtin_amdgcn_mfma_f32_32x32x16_bf16(b1,qr[0],negm,0,0,0);}
    else{p0=__builtin_amdgcn_mfma_f32_32x32x16_bf16(b0,qr[d0],p0,0,0,0);p1=__builtin_amdgcn_mfma_f32_32x32x16_bf16(b1,qr[d0],p1,0,0,0);}}
}
typedef __attribute__((address_space(3))) const char* lds_cptr;
typedef short v4i16_t __attribute__((ext_vector_type(4)));
__device__ __forceinline__ void kload8(bf16x8*kf,lds_cptr kp){
  kf[0]=*(const __attribute__((address_space(3))) bf16x8*)(kp);      kf[1]=*(const __attribute__((address_space(3))) bf16x8*)(kp+512);
  kf[2]=*(const __attribute__((address_space(3))) bf16x8*)(kp+2048); kf[3]=*(const __attribute__((address_space(3))) bf16x8*)(kp+2560);
  kf[4]=*(const __attribute__((address_space(3))) bf16x8*)(kp+4096); kf[5]=*(const __attribute__((address_space(3))) bf16x8*)(kp+4608);
  kf[6]=*(const __attribute__((address_space(3))) bf16x8*)(kp+6144); kf[7]=*(const __attribute__((address_space(3))) bf16x8*)(kp+6656);
}
__device__ __forceinline__ void kload2(bf16x8*kf,lds_cptr kp,int j){ kf[2*j]=*(const __attribute__((address_space(3))) bf16x8*)(kp+j*2048); kf[2*j+1]=*(const __attribute__((address_space(3))) bf16x8*)(kp+j*2048+512); }
__device__ __forceinline__ s16x4 vtr(lds_cptr p){ return __builtin_bit_cast(s16x4,__builtin_amdgcn_ds_read_tr16_b64_v4i16((__attribute__((address_space(3))) v4i16_t*)p)); }
__device__ __forceinline__ float rowmax(const f32x16&p0,const f32x16&p1){
  float a=max3f(p0[0],p0[1],p1[0]),b=max3f(p0[2],p0[3],p1[1]);a=max3f(a,p1[2],p1[3]);
  #pragma unroll
  for(int r=4;r<16;r+=4){a=max3f(a,p0[r],p0[r+1]);b=max3f(b,p0[r+2],p0[r+3]);a=max3f(a,p1[r],p1[r+1]);b=max3f(b,p1[r+2],p1[r+3]);}
  const float m=max2f(a,b);
  auto rr=__builtin_amdgcn_permlane32_swap(__float_as_uint(m),__float_as_uint(m),false,false);
  return max2f(__uint_as_float(rr[0]),__uint_as_float(rr[1]));
}
__device__ __forceinline__ void pv(f32x16*o,int vb,bf16x8 pa0,bf16x8 pa1,bf16x8 pa2,bf16x8 pa3){
  #pragma unroll
  for(int d0=0;d0<2;++d0){s16x4 lo[4],hi[4];
    #pragma unroll
    for(int ks=0;ks<4;++ks){
      asm volatile("ds_read_b64_tr_b16 %0,%1 offset:%c2":"=&v"(lo[ks]):"v"(vb),"i"(d0*4096+ks*1024):"memory");
      asm volatile("ds_read_b64_tr_b16 %0,%1 offset:%c2":"=&v"(hi[ks]):"v"(vb),"i"(d0*4096+ks*1024+512):"memory");}
    asm volatile("s_waitcnt lgkmcnt(0)":::"memory");SBAR();
    #define PK(k) (bf16x8){lo[k][0],lo[k][1],lo[k][2],lo[k][3],hi[k][0],hi[k][1],hi[k][2],hi[k][3]}
    o[d0]=__builtin_amdgcn_mfma_f32_32x32x16_bf16(pa0,PK(0),o[d0],0,0,0);
    o[d0]=__builtin_amdgcn_mfma_f32_32x32x16_bf16(pa1,PK(1),o[d0],0,0,0);
    o[d0]=__builtin_amdgcn_mfma_f32_32x32x16_bf16(pa2,PK(2),o[d0],0,0,0);
    o[d0]=__builtin_amdgcn_mfma_f32_32x32x16_bf16(pa3,PK(3),o[d0],0,0,0);
    #undef PK
  }
}

#ifndef ATTN_STORE16
#define ATTN_STORE16(p,v) (*(u32x4*)(p)=(v))
#endif
template<int THRL> __device__ __forceinline__ void attn_unit(int b,int h,int qb,const bf16*Q,const bf16*__restrict__ K,const bf16*__restrict__ V,bf16*O,char*shm){
  const int tid=lt(),lane=tid&63,r32=lane&31,hi=lane>>5; const int wid=__builtin_amdgcn_readfirstlane(tid>>6);
  const long rowbase=(long)b*SEQ; const int q0=qb*QB;
  const bf16*Qw=Q+(rowbase+q0+wid*QBLK)*QP+h*D;
  const bf16*Kh=K+rowbase*KP+(h/GQ)*D,*Vh=V+rowbase*VP+(h/GQ)*D;
  const unsigned lds0=(unsigned)(uintptr_t)shm;
  float*wsf=(float*)(shm+LDS_WS)+wid*64;
  const bf16*ksrc=Kh+(long)lane*KP+wid*8;
  const bf16*vsrc=Vh+(long)(16*(wid&3)+(lane>>2))*VP+(wid>>2)*32+(lane&3)*8;
  const unsigned kdst=lds0+LDS_K+wid*1024, vdst=lds0+LDS_V+wid*1024;
  #define DMA_K(t,slot) glds16(ksrc+(long)(t)*KVBLK*KP,(unsigned)__builtin_amdgcn_readfirstlane(kdst+(slot)))
  #define DMA_V(t,slot) glds16(vsrc+(long)(t)*KVBLK*VP,(unsigned)__builtin_amdgcn_readfirstlane(vdst+(slot)))
  const int vb0=(int)(lds0+LDS_V)+((lane>>4)&1)*32+(lane&3)*8+(4*hi+((lane&15)>>2))*64;
  const char*Kbase=shm+LDS_K; bf16x8 kf[8];
  const lds_cptr shm3=(lds_cptr)shm; const lds_cptr kp0=shm3+LDS_K+hi*1024+r32*16; const lds_cptr vp0=shm3+LDS_V+((lane>>4)&1)*32+(lane&3)*8+(4*hi+((lane&15)>>2))*64;
  const int NT=SEQ/KVBLK;
  DMA_K(0,0);DMA_V(0,0);DMA_K(1,SLOTB);
  bf16x8 qr[4];
  #pragma unroll
  for(int d0=0;d0<4;++d0)qr[d0]=*reinterpret_cast<const bf16x8*>(&Qw[(long)r32*QP+d0*16+hi*8]);
  float mhat=0.f,l_reg=0.f;f32x16 o[2];o[0]=f32x16{};o[1]=f32x16{};f32x16 negm=f32x16{};asm volatile("":"+v"(negm));
  const int qrel=wid*QBLK+r32;
  #define CMASK(P0,P1,t) do{}while(0)
  bool resc=false;
  #define START(P0,P1) do{ const float rm=rowmax(P0,P1); resc=false; \
    { const float dl=rm; mhat=fadd_s(mhat,dl); \
      _Pragma("unroll") for(int r=0;r<16;++r){P0[r]=fsub_s(P0[r],dl);P1[r]=fsub_s(P1[r],dl);} \
      _Pragma("unroll") for(int r=0;r<16;++r)negm[r]=-mhat; asm volatile("":"+v"(negm)); } \
    _Pragma("unroll") for(int r=0;r<16;++r)P0[r]=__builtin_amdgcn_exp2f(P0[r]); }while(0)
  #define RESC() do{ if(resc){ asm volatile("s_waitcnt lgkmcnt(0)":::"memory"); \
      _Pragma("unroll") for(int d_=0;d_<2;++d_) _Pragma("unroll") for(int r=0;r<16;++r)o[d_][r]*=wsf[crow(r,hi)]; } }while(0)
  f32x16 pA0,pA1,pB0,pB1;
  int sl_prev=0,sl_cur=0,sl_next=SLOTB;
  #define ROT() do{sl_prev=sl_cur;sl_cur=sl_next;sl_next=(sl_next==(NSLOT-1)*SLOTB)?0:sl_next+SLOTB;}while(0)
  DMA_K(2,2*SLOTB);
  WAIT_BAR(3);
  qkt(pA0,pA1,Kbase,qr,negm,r32,hi);asm volatile("s_nop 15\n\ts_nop 7":"+v"(pA0),"+v"(pA1));CMASK(pA0,pA1,0);
  START(pA0,pA1);
  _Pragma("unroll") for(int r=0;r<16;++r)pA1[r]=__builtin_amdgcn_exp2f(pA1[r]);
  WAIT_BAR(0);
  DMA_K(3,0);DMA_V(1,SLOTB);
  ROT();
  kload8(kf,kp0+sl_cur);
  WAIT_BAR(2);
  s16x4 vlo[8],vhi[8]; u32x4 pw0,pw1,pw2,pw3;
  #define PKW(P,B) cvtpk_s(P[B],P[B+1])
  #define PAF(k) __builtin_bit_cast(bf16x8,pw##k)
  #define VFR(i) (bf16x8){vlo[i][0],vlo[i][1],vlo[i][2],vlo[i][3],vhi[i][0],vhi[i][1],vhi[i][2],vhi[i][3]}
  #define PIN(x) asm volatile("":"+v"(x))
  #define MX3(a,b,c) __builtin_fmaxf(__builtin_fmaxf((a),(b)),(c))
  #define GAPA(MF,A0,A1,A2,A3,W0,W1,PW) do{ MF; sacc+=A0; sacc+=A1; sacc+=A2; sacc+=A3; PIN(sacc); W0; W1; PIN(PW); SBAR(); }while(0)
  #define EX(v) __builtin_amdgcn_exp2f(v)
  #define GAPB(MF,X,B) do{ MF; X[B]=EX(X[B]); X[B+1]=EX(X[B+1]); X[B+2]=EX(X[B+2]); X[B+3]=EX(X[B+3]); PIN(X); SBAR(); }while(0)
  #define VRD(i) do{ vlo[i]=vtr(vp_+(((i)>>2)*4096+((i)&3)*1024)); vhi[i]=vtr(vp_+(((i)>>2)*4096+((i)&3)*1024+512)); }while(0)
  #define KRD(G,j) do{ if(G){ kload2(kf,kp0+sl_next,j); SBAR(); } }while(0)
  #define STEP(C0,C1,P0,P1,t,GK,GV,GL) do{ SBAR(); \
    const lds_cptr vp_=vp0+sl_prev; \
    VRD(0); SBAR(); float sacc=(P0[0]+P0[1]); \
    GAPA(C0=__builtin_amdgcn_mfma_f32_32x32x16_bf16(kf[0],qr[0],negm,0,0,0), P0[2],P0[3],P0[4],P0[5],     pw0[0]=PKW(P0,0), pw0[1]=PKW(P0,2), pw0); \
    VRD(4); SBAR(); GAPA(C1=__builtin_amdgcn_mfma_f32_32x32x16_bf16(kf[1],qr[0],negm,0,0,0), P0[6],P0[7],P0[8],P0[9],     pw0[2]=PKW(P0,4), pw0[3]=PKW(P0,6), pw0); \
    VRD(1); SBAR(); GAPA(C0=__builtin_amdgcn_mfma_f32_32x32x16_bf16(kf[2],qr[1],C0,0,0,0),   P0[10],P0[11],P0[12],P0[13], pw1[0]=PKW(P0,8), pw1[1]=PKW(P0,10), pw1); \
    VRD(5); SBAR(); GAPA(C1=__builtin_amdgcn_mfma_f32_32x32x16_bf16(kf[3],qr[1],C1,0,0,0),   P0[14],P0[15],P1[0],P1[1],   pw1[2]=PKW(P0,12),pw1[3]=PKW(P0,14), pw1); \
    VRD(2); SBAR(); GAPA(C0=__builtin_amdgcn_mfma_f32_32x32x16_bf16(kf[4],qr[2],C0,0,0,0),   P1[2],P1[3],P1[4],P1[5],     pw2[0]=PKW(P1,0), pw2[1]=PKW(P1,2), pw2); \
    VRD(6); SBAR(); GAPA(C1=__builtin_amdgcn_mfma_f32_32x32x16_bf16(kf[5],qr[2],C1,0,0,0),   P1[6],P1[7],P1[8],P1[9],     pw2[2]=PKW(P1,4), pw2[3]=PKW(P1,6), pw2); \
    VRD(3); SBAR(); GAPA(C0=__builtin_amdgcn_mfma_f32_32x32x16_bf16(kf[6],qr[3],C0,0,0,0),   P1[10],P1[11],P1[12],P1[13], pw3[0]=PKW(P1,8), pw3[1]=PKW(P1,10), pw3); \
    VRD(7); SBAR(); GAPA(C1=__builtin_amdgcn_mfma_f32_32x32x16_bf16(kf[7],qr[3],C1,0,0,0),   P1[14],P1[15],0.f,0.f,       pw3[2]=PKW(P1,12),pw3[3]=PKW(P1,14), pw3); \
    l_reg+=sacc; \
    if(GK){DMA_K((t)+3,sl_cur);} if(GV){DMA_V((t)+1,sl_next);} \
    CMASK(C0,C1,t); \
    { float a=MX3(C0[0],C0[1],C1[0]),b=MX3(C0[2],C0[3],C1[1]); a=MX3(a,C1[2],C1[3]); \
      _Pragma("unroll") for(int r=4;r<16;r+=4){a=MX3(a,C0[r],C0[r+1]);b=MX3(b,C0[r+2],C0[r+3]);a=MX3(a,C1[r],C1[r+1]);b=MX3(b,C1[r+2],C1[r+3]);} \
      float rm=__builtin_fmaxf(a,b); { auto rr=__builtin_amdgcn_permlane32_swap(__float_as_uint(rm),__float_as_uint(rm),false,false); rm=__builtin_fmaxf(__uint_as_float(rr[0]),__uint_as_float(rr[1])); } \
      resc=false; \
      if(__builtin_expect(__any(rm>(float)THRL),0)){ const float dl=__builtin_fmaxf(rm,0.f); mhat+=dl; \
        _Pragma("unroll") for(int r=0;r<16;++r){C0[r]-=dl;C1[r]-=dl;} \
        _Pragma("unroll") for(int r=0;r<16;++r)negm[r]=-mhat; asm volatile("":"+v"(negm)); \
        const float f=__builtin_amdgcn_exp2f(-dl); l_reg*=f; if(hi==0)wsf[r32]=f; resc=true; } } \
    SBAR(); \
    GAPB(o[0]=__builtin_amdgcn_mfma_f32_32x32x16_bf16(PAF(0),VFR(0),o[0],0,0,0), C0,0); \
    GAPB(o[1]=__builtin_amdgcn_mfma_f32_32x32x16_bf16(PAF(0),VFR(4),o[1],0,0,0), C0,4); \
    KRD(GL,0); GAPB(o[0]=__builtin_amdgcn_mfma_f32_32x32x16_bf16(PAF(1),VFR(1),o[0],0,0,0), C0,8); \
    KRD(GL,1); GAPB(o[1]=__builtin_amdgcn_mfma_f32_32x32x16_bf16(PAF(1),VFR(5),o[1],0,0,0), C0,12); \
    KRD(GL,2); GAPB(o[0]=__builtin_amdgcn_mfma_f32_32x32x16_bf16(PAF(2),VFR(2),o[0],0,0,0), C1,0); \
    KRD(GL,3); GAPB(o[1]=__builtin_amdgcn_mfma_f32_32x32x16_bf16(PAF(2),VFR(6),o[1],0,0,0), C1,4); \
    GAPB(o[0]=__builtin_amdgcn_mfma_f32_32x32x16_bf16(PAF(3),VFR(3),o[0],0,0,0), C1,8); \
    GAPB(o[1]=__builtin_amdgcn_mfma_f32_32x32x16_bf16(PAF(3),VFR(7),o[1],0,0,0), C1,12); \
    }while(0)
  int t=1;
  #undef CMASK
  #define CMASK(P0,P1,t) do{}while(0)
  for(;t+5<NT;t+=2){
    STEP(pB0,pB1,pA0,pA1,t,true,true,true);     WAIT_BAR(2); RESC(); ROT();
    STEP(pA0,pA1,pB0,pB1,t+1,true,true,true);   WAIT_BAR(2); RESC(); ROT();
  }
  #undef CMASK
  #define CMASK(P0,P1,t) do{}while(0)
  #define ENDW(tt) do{ if((tt)+3<NT){WAIT_BAR(2);} else if((tt)+2<NT){WAIT_BAR(1);} else {WAIT_BAR(0);} }while(0)
  for(;t+1<NT;t+=2){
    STEP(pB0,pB1,pA0,pA1,t,(t+3<NT),(t+1<NT),(t+1<NT));       ENDW(t);   RESC(); ROT();
    STEP(pA0,pA1,pB0,pB1,t+1,(t+4<NT),(t+2<NT),(t+2<NT));     ENDW(t+1); RESC(); ROT();
  }
  STEP(pB0,pB1,pA0,pA1,NT-1,false,false,false); RESC();
  { float sacc=pB0[0]+pB0[1]; _Pragma("unroll") for(int r=2;r<16;++r)sacc+=pB0[r]; _Pragma("unroll") for(int r=0;r<16;++r)sacc+=pB1[r]; l_reg+=sacc;
    pw0=(u32x4){PKW(pB0,0),PKW(pB0,2),PKW(pB0,4),PKW(pB0,6)};pw1=(u32x4){PKW(pB0,8),PKW(pB0,10),PKW(pB0,12),PKW(pB0,14)};pw2=(u32x4){PKW(pB1,0),PKW(pB1,2),PKW(pB1,4),PKW(pB1,6)};pw3=(u32x4){PKW(pB1,8),PKW(pB1,10),PKW(pB1,12),PKW(pB1,14)};
    SBAR(); pv(o,vb0+sl_cur,PAF(0),PAF(1),PAF(2),PAF(3)); }
  #undef PKW
  #undef PAF
  #undef VFR
  #undef PIN
  #undef MX3
  #undef GAPA
  #undef GAPB
  #undef EX
  #undef VRD
  #undef KRD
  #undef STEP
  #undef ENDW
  {auto rr=__builtin_amdgcn_permlane32_swap(__float_as_uint(l_reg),__float_as_uint(l_reg),false,false);l_reg=__uint_as_float(rr[0])+__uint_as_float(rr[1]);}
  if(hi==0)wsf[32+r32]=l_reg;asm volatile("s_waitcnt lgkmcnt(0)":::"memory");
  float rli[16];
  #pragma unroll
  for(int r=0;r<16;++r)rli[r]=__builtin_amdgcn_rcpf(wsf[32+crow(r,hi)]);
  bf16*Ow=O+(rowbase+q0+wid*QBLK)*OP+h*D;
  { bf16*stg=(bf16*)(shm+LDS_OST)+wid*2048;
    #pragma unroll
    for(int r=0;r<16;++r){const int orow=crow(r,hi);
      #pragma unroll
      for(int d0=0;d0<2;++d0)stg[orow*64+d0*32+r32]=__float2bfloat16(o[d0][r]*rli[r]);}
    asm volatile("s_waitcnt lgkmcnt(0)":::"memory");
    #pragma unroll
    for(int i=0;i<4;++i){const int row=i*8+(lane>>3),ch=lane&7; const u32x4 v=*(const u32x4*)(stg+row*64+ch*8); ATTN_STORE16(Ow+(long)row*OP+ch*8,v);} }
  asm volatile("s_waitcnt lgkmcnt(0)\n\ts_barrier":::"memory");
  #undef DMA_K
  #undef DMA_V
  #undef CMASK
  #undef START
  #undef RESC
  #undef ROT
}
#undef SBAR
#undef WAIT_BAR
}
#ifndef MK_PROBE
#define MK_PROBE 0
#endif
#ifndef MK_PTYPE
#define MK_PTYPE 0xff
#endif

struct Args { const float* in[33]; float* out; unsigned char* ws; int ph_lo, ph_hi; };
enum { I_X = 0, I_C, I_WIN, I_BIN, I_WOUT, I_NMG, I_NFG, I_ADAW, I_ADAB, I_LCW, I_LCB, I_LWA, I_LBA, I_LWX, I_LBX, I_LLAM, I_QG, I_KG,
       I_HCW, I_HCB, I_HW1, I_HB1, I_HW2, I_HB2, I_HW3, I_HSF, I_HDEC, I_HSKIP, I_MLG, I_F1, I_F3, I_F2, I_FG };

struct Frame {
    unsigned char* lds; unsigned char* ws; const float* const* in; float* out;
    int tid, lane, wave, G;
};
#define MFMA32(a, b, c) __builtin_amdgcn_mfma_f32_32x32x16_bf16((a), (b), (c), 0, 0, 0)
#define MFMA16(a, b, c) __builtin_amdgcn_mfma_f32_16x16x32_bf16((a), (b), (c), 0, 0, 0)

__device__ __forceinline__ int next_item(unsigned* ctr, unsigned char* lds) {
    volatile unsigned* slot = (volatile unsigned*)(lds + SLOT_OFF);
    __syncthreads();
    if (threadIdx.x == 0) *slot = atomicAdd(ctr, 1u);
    __syncthreads();
    return (int)*slot;
}

__device__ __forceinline__ void transpose_item(const float* W, int K, int N, bf16* WT, int mode, float* scr, int item, int lane) {
    const int nblk = (N + 63) / 64, kb = item / nblk, nb = item % nblk, k0 = 64 * kb, n0 = 64 * nb;
    const int nl0 = 4 * (lane & 15); const bool nok = (n0 + nl0) < N;
    f32x4 v[16];
#pragma unroll
    for (int i = 0; i < 16; ++i) { const int kk = 4 * i + (lane >> 4); v[i] = nok ? *(const f32x4*)(W + (size_t)(k0 + kk) * N + n0 + nl0) : (f32x4){0.f, 0.f, 0.f, 0.f}; }
#pragma unroll
    for (int i = 0; i < 16; ++i) { const int kk = 4 * i + (lane >> 4); float* d = scr + kk * 65 + nl0; d[0] = v[i].x; d[1] = v[i].y; d[2] = v[i].z; d[3] = v[i].w; }
    LDS_WAIT();
    const int c = lane & 7;
#pragma unroll
    for (int j = 0; j < 8; ++j) { const int nl = (lane >> 3) + 8 * j; const int n = n0 + nl; const float* sp = scr + (8 * c) * 65 + nl;
        u32x4 o; o.x = pk2(sp[0 * 65], sp[1 * 65]); o.y = pk2(sp[2 * 65], sp[3 * 65]); o.z = pk2(sp[4 * 65], sp[5 * 65]); o.w = pk2(sp[6 * 65], sp[7 * 65]);
        const int dr = (mode == 0) ? n : ((n >> 7) * 256 + (n & 127) + (mode == 2 ? 128 : 0));
        if (n < N) *(u32x4*)(WT + (size_t)dr * K + k0 + 8 * c) = o; }
    LDS_WAIT();
}

__device__ __forceinline__ void p0_prologue(Frame& F) {
    const int tid = F.tid, lane = F.lane, wave = F.wave;
    const long gt = (long)blockIdx.x * 512 + tid, GT = (long)F.G * 512;
    {
        float* ca = (float*)F.lds;
        float* part = (float*)(F.lds + 32768);
        bool have = false;
        for (int it = blockIdx.x; it < 192; it += F.G) {
            if (!have) { for (int i = tid; i < 8192; i += 512) { const float c = F.in[I_C][i]; ca[i] = c * sigmoidf_(c); } have = true; }
            __syncthreads();
            const int layer = it / 96, col0 = (it % 96) * 128;
            const float* W = F.in[I_ADAW] + (size_t)layer * 2048 * 12288 + col0 + 2 * lane;
            float a00 = 0, a01 = 0, a10 = 0, a11 = 0, a20 = 0, a21 = 0, a30 = 0, a31 = 0;
            const int kb = wave * 256;
#pragma unroll 16
            for (int k = kb; k < kb + 256; ++k) { const f32x2 w = *(const f32x2*)(W + (size_t)k * 12288);
                const float c0 = ca[k], c1 = ca[2048 + k], c2 = ca[4096 + k], c3 = ca[6144 + k];
                a00 += c0 * w.x; a01 += c0 * w.y; a10 += c1 * w.x; a11 += c1 * w.y; a20 += c2 * w.x; a21 += c2 * w.y; a30 += c3 * w.x; a31 += c3 * w.y; }
            float* pp = part + (wave * 4) * 128 + 2 * lane;
            pp[0] = a00; pp[1] = a01; pp[128] = a10; pp[129] = a11; pp[256] = a20; pp[257] = a21; pp[384] = a30; pp[385] = a31;
            __syncthreads();
            { const int b = tid >> 7, col = tid & 127; float s = F.in[I_ADAB][layer * 12288 + col0 + col];
#pragma unroll
              for (int w = 0; w < 8; ++w) s += part[(w * 4 + b) * 128 + col];
              ((float*)(F.ws + WS_MOD))[(layer * 4 + b) * 12288 + col0 + col] = s; }
        }
        __syncthreads();
    }
    {
        bf16* lw = (bf16*)(F.ws + WS_LRUW);
        for (long e = gt; e < 262144; e += GT) { const int k = e & 63, j = (e >> 6) & 63, gate = (e >> 12) & 1, blk = (e >> 13) & 7, dir = (e >> 16) & 1, l = (int)(e >> 17);
            const float* src = gate ? F.in[I_LWX] : F.in[I_LWA];
            lw[e] = (bf16)f2bf(src[((((size_t)(l * 2 + dir) * 8 + blk) * 64 + k) * 64) + j]); }
        float* bp = (float*)(F.ws + WS_BINP);
        for (long e = gt; e < 2 * DINP; e += GT) { const int l = (int)(e / DINP), n = (int)(e % DINP); bp[e] = n < DIN ? F.in[I_BIN][l * DIN + n] : 0.f; }
        for (long e = gt; e < 2L * 240 * 256; e += GT) { const int l = (int)(e / (240 * 256)); const long r = e % (240 * 256);
            *(u32x4*)(F.ws + WS_WIN + (size_t)l * DINP * DM * 2 + (size_t)DIN * DM * 2 + r * 16) = (u32x4){0u, 0u, 0u, 0u}; }
    }
    {
        float* feat = (float*)F.lds; float* h1 = (float*)(F.lds + 2048); float* h2 = (float*)(F.lds + 6144); float* w1s = (float*)(F.lds + 10240); float* w2s = (float*)(F.lds + 14848);
        for (int it = blockIdx.x; it < 512; it += F.G) {
            const int l = it >> 8, pb = it & 255;
            __syncthreads();
            for (int i = tid; i < 17 * 64; i += 512) w1s[i] = F.in[I_HW1][l * 17 * 64 + i];
#pragma unroll
            for (int i = 0; i < 8; ++i) w2s[tid + 512 * i] = F.in[I_HW2][l * 4096 + tid + 512 * i];
            if (tid < 272) { const int p = tid / 17, f = tid % 17; const float pos = (float)(16 * pb + p); float val;
                if (f == 0) val = pos / 4095.0f;
                else { const int bi = (f - 1) & 7; const float band = 1e-4f + (float)bi * ((7.0f - 1e-4f) / 7.0f); const float ang = (6.283185307179586f * pos / 4096.0f) * band;
                       val = (f <= 8) ? cos_rad(ang) : -sin_rad(ang); }
                feat[p * 17 + f] = val; }
            __syncthreads();
            for (int idx = tid; idx < 1024; idx += 512) { const int p = idx >> 6, j = idx & 63; float s = F.in[I_HB1][l * 64 + j];
#pragma unroll
                for (int f = 0; f < 17; ++f) s += feat[p * 17 + f] * w1s[f * 64 + j];
                h1[idx] = sin_rad(F.in[I_HSF][l * 64 + j] * s); }
            __syncthreads();
            for (int idx = tid; idx < 1024; idx += 512) { const int p = idx >> 6, j = idx & 63; float s = F.in[I_HB2][l * 64 + j];
#pragma unroll 16
                for (int i = 0; i < 64; ++i) s += h1[p * 64 + i] * w2s[i * 64 + j];
                h2[idx] = sin_rad(F.in[I_HSF][l * 64 + j] * s); }
            __syncthreads();
            float acc[4][16];
#pragma unroll
            for (int q = 0; q < 4; ++q)
#pragma unroll
                for (int p = 0; p < 16; ++p) acc[q][p] = 0.f;
            const float* w3 = F.in[I_HW3] + (size_t)l * 64 * 2048 + tid;
#pragma unroll 8
            for (int i = 0; i < 64; ++i) { const float w0 = w3[i * 2048], w1 = w3[i * 2048 + 512], w2 = w3[i * 2048 + 1024], w3v = w3[i * 2048 + 1536];
#pragma unroll
                for (int p = 0; p < 16; ++p) { const float hv = h2[p * 64 + i]; acc[0][p] += hv * w0; acc[1][p] += hv * w1; acc[2][p] += hv * w2; acc[3][p] += hv * w3v; } }
#pragma unroll
            for (int q = 0; q < 4; ++q) { const int j = tid + 512 * q; const int o = j >> 10, dir = (j >> 9) & 1, wch = j & 511;
                const float dec = fabsf(F.in[I_HDEC][l * 2048 + j]);
                bf16* base = (bf16*)(F.ws + WS_HYFT) + ((size_t)((l * 2 + o) * 512 + wch)) * 8192;
                float ss = 0.f; float vv[16];
#pragma unroll
                for (int p = 0; p < 16; ++p) { const int pos = 16 * pb + p; const float t = (float)pos / 4095.0f; vv[p] = acc[q][p] * __expf(-t * dec); ss += vv[p] * vv[p]; }
                if (dir == 0) { bf16* fp = base + 4080 - 16 * pb;
                    *(u32x4*)fp = (u32x4){pk2(vv[15], vv[14]), pk2(vv[13], vv[12]), pk2(vv[11], vv[10]), pk2(vv[9], vv[8])};
                    *(u32x4*)(fp + 8) = (u32x4){pk2(vv[7], vv[6]), pk2(vv[5], vv[4]), pk2(vv[3], vv[2]), pk2(vv[1], vv[0])}; }
                else { bf16* bp = base + 4095 + 16 * pb;
                    if (pb > 0) bp[0] = (bf16)f2bf(vv[0]);
                    *(u32x4*)(bp + 1) = (u32x4){pk2(vv[1], vv[2]), pk2(vv[3], vv[4]), pk2(vv[5], vv[6]), pk2(vv[7], vv[8])};
                    *(u32x2*)(bp + 9) = (u32x2){pk2(vv[9], vv[10]), pk2(vv[11], vv[12])};
                    *(unsigned*)(bp + 13) = pk2(vv[13], vv[14]);
                    bp[15] = (bf16)f2bf(vv[15]);
                    if (pb == 0) base[8191] = 0; }
                ((float*)(F.ws + WS_HYPART))[(size_t)(l * 256 + pb) * 2048 + j] = ss; }
        }
        __syncthreads();
    }
    {
        float* scr = (float*)(F.lds + wave * 16640);
        unsigned* tctr = (unsigned*)(F.ws + WS_CTL) + 64 * 30;
        constexpr int I_IN = 32 * 85, I_OUT = 32 * 32, I_W1 = 32 * 88, I_W2 = 88 * 32, PER_L = I_IN + I_OUT + 2 * I_W1 + I_W2;
        for (;;) {
            unsigned base = 0u; if (lane == 0) base = atomicAdd(tctr, 4u);
            base = (unsigned)__builtin_amdgcn_readfirstlane((int)base);
            if (base >= (unsigned)(2 * PER_L)) break;
#pragma unroll 1
            for (int q = 0; q < 4; ++q) { const int it = (int)base + q; if (it >= 2 * PER_L) break;
                const int l = it / PER_L; int r = it % PER_L;
                if (r < I_IN) { transpose_item(F.in[I_WIN] + (size_t)l * DM * DIN, DM, DIN, (bf16*)(F.ws + WS_WIN) + (size_t)l * DINP * DM, 0, scr, r, lane); continue; } r -= I_IN;
                if (r < I_OUT) { transpose_item(F.in[I_WOUT] + (size_t)l * DM * DM, DM, DM, (bf16*)(F.ws + WS_WOUT) + (size_t)l * DM * DM, 0, scr, r, lane); continue; } r -= I_OUT;
                if (r < I_W1) { transpose_item(F.in[I_F1] + (size_t)l * DM * DFF, DM, DFF, (bf16*)(F.ws + WS_W13) + (size_t)l * 2 * DFF * DM, 1, scr, r, lane); continue; } r -= I_W1;
                if (r < I_W1) { transpose_item(F.in[I_F3] + (size_t)l * DM * DFF, DM, DFF, (bf16*)(F.ws + WS_W13) + (size_t)l * 2 * DFF * DM, 2, scr, r, lane); continue; } r -= I_W1;
                transpose_item(F.in[I_F2] + (size_t)l * DFF * DM, DFF, DM, (bf16*)(F.ws + WS_W2) + (size_t)l * DM * DFF, 0, scr, r, lane); }
        }
    }
}

__device__ __forceinline__ void norm_phase(Frame& F, const float* xin, const float* g, const float* sh, const float* sc, bf16* xn) {
    const int gw = blockIdx.x * 8 + F.wave, NGW = F.G * 8, lane = F.lane;
    for (int m = gw; m < MTOK; m += NGW) {
        const int b = m >> 12;
        const f32x4* xr = (const f32x4*)(xin + (size_t)m * DM) + lane;
        f32x4 v[8]; float ss = 0.f;
#pragma unroll
        for (int j = 0; j < 8; ++j) { v[j] = xr[64 * j]; ss += (v[j].x * v[j].x + v[j].y * v[j].y) + (v[j].z * v[j].z + v[j].w * v[j].w); }
        const float rstd = rsqrtf(wave_sum(ss) * (1.0f / DM) + EPS);
#pragma unroll
        for (int j = 0; j < 8; ++j) { const int col = 4 * (lane + 64 * j);
            const f32x4 gv = *(const f32x4*)(g + col), scv = *(const f32x4*)(sc + (size_t)b * 12288 + col), shv = *(const f32x4*)(sh + (size_t)b * 12288 + col);
            const f32x4 o = (v[j] * rstd) * gv * (scv + 1.0f) + shv;
            u32x2 w; w.x = pk2(o.x, o.y); w.y = pk2(o.z, o.w);
            *(u32x2*)(xn + (size_t)m * DM + col) = w; }
    }
}
__device__ __forceinline__ void final_norm_phase(Frame& F, float* x, const float* g) {
    const int gw = blockIdx.x * 8 + F.wave, NGW = F.G * 8, lane = F.lane;
    for (int m = gw; m < MTOK; m += NGW) {
        f32x4* xr = (f32x4*)(x + (size_t)m * DM) + lane;
        f32x4 v[8]; float ss = 0.f;
#pragma unroll
        for (int j = 0; j < 8; ++j) { v[j] = xr[64 * j]; ss += (v[j].x * v[j].x + v[j].y * v[j].y) + (v[j].z * v[j].z + v[j].w * v[j].w); }
        const float rstd = rsqrtf(wave_sum(ss) * (1.0f / DM) + EPS);
#pragma unroll
        for (int j = 0; j < 8; ++j) { const f32x4 gv = *(const f32x4*)(g + 4 * (lane + 64 * j)); xr[64 * j] = (v[j] * rstd) * gv; }
    }
}
__device__ __forceinline__ void hy_scale_reduce(Frame& F) {
    const long gt = (long)blockIdx.x * 512 + F.tid;
    if (gt < 2048) { const int l = (int)(gt >> 10), o = (int)(gt >> 9) & 1, w = (int)gt & 511; const float* pp = (const float*)(F.ws + WS_HYPART) + (size_t)l * 256 * 2048 + o * 1024 + w;
        float s = 0.f; for (int pb = 0; pb < 256; ++pb) s += pp[(size_t)pb * 2048] + pp[(size_t)pb * 2048 + 512];
        ((float*)(F.ws + WS_HYSC))[gt] = rsqrtf(s + EPS); }
}

__device__ __forceinline__ void attn_prep_item(Frame& F, int l, int it) {
    const bf16* proj = (const bf16*)(F.ws + WS_PROJ); bf16* qb = (bf16*)(F.ws + WS_QB); bf16* kb = (bf16*)(F.ws + WS_KB);
#pragma unroll 1
    for (int pi = F.tid; pi < 768; pi += 512) {
        const int tok = pi / 12, hd = pi % 12; const int row = it * 64 + tok; const int pos = row & 4095;
        const bf16* src = proj + (size_t)row * DINP + (hd < 8 ? C_BQ + hd * 64 : (hd < 10 ? C_BK + (hd - 8) * 64 : C_BV + (hd - 10) * 64));
        u32x4 raw[8];
#pragma unroll
        for (int i = 0; i < 8; ++i) raw[i] = *(const u32x4*)(src + 8 * i);
        if (hd >= 10) {
            bf16* vd = (bf16*)(F.ws + WS_VB) + (size_t)row * 128 + (hd - 10) * 64;
#pragma unroll
            for (int i = 0; i < 8; ++i) *(u32x4*)(vd + 8 * i) = raw[i];
            continue; }
        float x[64]; float ss = 0.f;
#pragma unroll
        for (int i = 0; i < 8; ++i) { const unsigned w4[4] = {raw[i].x, raw[i].y, raw[i].z, raw[i].w};
#pragma unroll
            for (int e = 0; e < 4; ++e) { x[8 * i + 2 * e] = bflo(w4[e]); x[8 * i + 2 * e + 1] = bfhi(w4[e]); } }
#pragma unroll
        for (int i = 0; i < 64; ++i) ss += x[i] * x[i];
        const float r = rsqrtf(ss * (1.0f / 64.0f) + EPS);
        const float* g = (hd < 8 ? F.in[I_QG] : F.in[I_KG]) + l * 64;
        const float osc = (hd < 8) ? (0.125f * 1.4426950408889634f) : 1.0f;
#pragma unroll
        for (int i = 0; i < 64; ++i) x[i] = x[i] * r * g[i];
        float o[64];
#pragma unroll
        for (int seg = 0; seg < 2; ++seg) { const float p = seg ? (float)(pos & 63) : (float)(pos >> 6);
#pragma unroll
            for (int i = 0; i < 16; ++i) { const float inv = exp2f(-(float)i * (13.287712379549449f / 16.0f)); const float ang = p * inv; const float cs = cos_rad(ang), sn = sin_rad(ang);
                const float x1 = x[32 * seg + i], x2 = x[32 * seg + 16 + i];
                o[32 * seg + i] = (x1 * cs - x2 * sn) * osc; o[32 * seg + 16 + i] = (x2 * cs + x1 * sn) * osc; } }
        bf16* dst = (hd < 8) ? qb + (size_t)row * 512 + hd * 64 : kb + (size_t)row * 128 + (hd - 8) * 64;
#pragma unroll
        for (int i = 0; i < 8; ++i) *(u32x4*)(dst + 8 * i) = (u32x4){pk2(o[8 * i], o[8 * i + 1]), pk2(o[8 * i + 2], o[8 * i + 3]), pk2(o[8 * i + 4], o[8 * i + 5]), pk2(o[8 * i + 6], o[8 * i + 7])};
    }
}

__device__ __forceinline__ void hy_prep_item(Frame& F, int l, int it) {
    const bf16* proj = (const bf16*)(F.ws + WS_PROJ); bf16* ht = (bf16*)(F.ws + WS_HT);
    const int b = it / 192, rem = it % 192, tt = rem / 24, ct = rem % 24, t0 = tt * 512, c0 = ct * 64, tid = F.tid;
    float* raw = (float*)F.lds;
    u32x4 v[9];
#pragma unroll
    for (int j = 0; j < 9; ++j) { const int idx = tid + 512 * j; const int t = t0 - 1 + (idx >> 3);
        v[j] = (u32x4){0u, 0u, 0u, 0u};
        if (idx < 4112 && t >= 0 && t < SEQ) v[j] = *(const u32x4*)(proj + (size_t)(b * SEQ + t) * DINP + C_CU + c0 + (idx & 7) * 8); }
#pragma unroll
    for (int j = 0; j < 9; ++j) { const int idx = tid + 512 * j; if (idx < 4112) { float* d = raw + (idx >> 3) * 65 + (idx & 7) * 8; const unsigned w4[4] = {v[j].x, v[j].y, v[j].z, v[j].w};
#pragma unroll
        for (int e = 0; e < 4; ++e) { d[2 * e] = bflo(w4[e]); d[2 * e + 1] = bfhi(w4[e]); } } }
    __syncthreads();
    { const int ch = tid >> 3, seg = tid & 7; const int c = c0 + ch;
      const float w0 = F.in[I_HCW][(l * 3 + 0) * 1536 + c], w1 = F.in[I_HCW][(l * 3 + 1) * 1536 + c], w2 = F.in[I_HCW][(l * 3 + 2) * 1536 + c], cb = F.in[I_HCB][l * 1536 + c];
#pragma unroll
      for (int sb = 0; sb < 4; ++sb) { const int ts = 16 * (8 * sb + seg);
          unsigned pk[8];
#pragma unroll
          for (int e = 0; e < 16; e += 2) { const int tr = ts + e + 1;
              const float o0 = cb + w0 * raw[(tr - 1) * 65 + ch] + w1 * raw[tr * 65 + ch] + w2 * raw[(tr + 1) * 65 + ch];
              const float o1 = cb + w0 * raw[tr * 65 + ch] + w1 * raw[(tr + 1) * 65 + ch] + w2 * raw[(tr + 2) * 65 + ch];
              pk[e >> 1] = pk2(o0, o1); }
          u32x4* dst = (u32x4*)(ht + ((size_t)(b * 1536 + c)) * SEQ + t0 + ts);
          dst[0] = (u32x4){pk[0], pk[1], pk[2], pk[3]}; dst[1] = (u32x4){pk[4], pk[5], pk[6], pk[7]}; } }
}

__device__ __forceinline__ void hy_conv_item(Frame& F, int l, int order, int cp) {
    const int tid = F.tid, lane = F.lane, w = F.wave, r32 = lane & 31, hi = lane >> 5;
    unsigned* RVc = (unsigned*)F.lds;
    bf16* U = (bf16*)(F.lds + 65536);
    const int c0 = 2 * cp;
    { const unsigned* src = (const unsigned*)((const bf16*)(F.ws + WS_HYFT) + ((size_t)((l * 2 + order) * 512 + c0)) * 8192);
#pragma unroll
      for (int i0 = 0; i0 < 2048; i0 += 512) { const int i = tid + i0; const int cc = i >> 10, j4 = (i & 1023) * 4;
          const u32x4 a = *(const u32x4*)(src + cc * 4096 + j4); const unsigned nx = (j4 + 4 < 4096) ? src[cc * 4096 + j4 + 4] : 0u;
          *(u32x4*)(RVc + (cc * 2 + 0) * 4096 + j4) = a;
          *(u32x4*)(RVc + (cc * 2 + 1) * 4096 + j4) = (u32x4){__builtin_amdgcn_alignbit(a.y, a.x, 16), __builtin_amdgcn_alignbit(a.z, a.y, 16), __builtin_amdgcn_alignbit(a.w, a.z, 16), __builtin_amdgcn_alignbit(nx, a.w, 16)}; }
      u32x4 uv[8];
#pragma unroll
      for (int q = 0; q < 8; ++q) { const int i = tid + 512 * q; const int cc = i >> 11, b = (i >> 9) & 3, off = i & 511;
          const bf16* sp = (order == 0) ? (const bf16*)(F.ws + WS_HT) + ((size_t)(b * 1536 + c0 + cc)) * SEQ : (const bf16*)(F.ws + WS_Z1T) + ((size_t)(b * 512 + c0 + cc)) * SEQ;
          uv[q] = ((const u32x4*)sp)[off]; }
#pragma unroll
      for (int q = 0; q < 8; ++q) { const int i = tid + 512 * q; const int rowi = i >> 9, off = i & 511;
          *(u32x4*)(U + rowi * 4608 + 8 * off + (off >> 3) * 8) = uv[q]; } }
    if (tid < 32) ((unsigned*)(F.lds + 65536 + 73728))[tid] = 0u;
    __syncthreads();
    const int cc = w >> 2, b = w & 3, c = c0 + cc;
    bf16* Uc = U + (cc * 4 + b) * 4608;
    f32x16 acc[2][2];
#pragma unroll
    for (int a = 0; a < 2; ++a)
#pragma unroll
        for (int q = 0; q < 2; ++q)
#pragma unroll
            for (int r = 0; r < 16; ++r) acc[a][q][r] = 0.f;
    const unsigned lds_rv = (unsigned)(uintptr_t)(RVc + cc * 2 * 4096);
#define HY_RD(DST, ADDR, O) do { asm volatile("ds_read2_b32 %0, %1 offset0:%2 offset1:%3" : "=v"((DST)[0]) : "v"(ADDR), "i"(O), "i"((O) + 1)); \
                                 asm volatile("ds_read2_b32 %0, %1 offset0:%2 offset1:%3" : "=v"((DST)[1]) : "v"(ADDR), "i"((O) + 2), "i"((O) + 3)); } while (0)
#define HY_LDB(DST, DD) do { const int ip0_ = r32 - (DD), ip1_ = 32 + r32 - (DD); const bool ok0_ = (ip0_ >= 0) && (ip0_ < 64), ok1_ = (ip1_ >= 0) && (ip1_ < 64); \
        const bf16* p0_ = ok0_ ? (Uc + 72 * ip0_ + 8 * hi) : ZR; const bf16* p1_ = ok1_ ? (Uc + 72 * ip1_ + 8 * hi) : ZR;        \
        _Pragma("unroll") for (int ks = 0; ks < 4; ++ks) { (DST)[ks][0] = *(const bf16x8*)(p0_ + 16 * ks); (DST)[ks][1] = *(const bf16x8*)(p1_ + 16 * ks); } } while (0)
    u32x2 W[6][2], nW[4][2]; bf16x8 B[4][2], nB[4][2];
    const bf16* ZR = (const bf16*)(F.lds + 65536 + 73728);
    unsigned aaddr;
    { const int s1 = 4095 - (64 * (-63) + 32 + r32 - 8 * hi); aaddr = lds_rv + (unsigned)(s1 & 1) * 16384u + (unsigned)(s1 >> 1) * 4u; }
    HY_RD(W[0], aaddr, 40); HY_RD(W[1], aaddr, 32); HY_RD(W[2], aaddr, 24); HY_RD(W[3], aaddr, 16); HY_RD(W[4], aaddr, 8); HY_RD(W[5], aaddr, 0);
    HY_LDB(B, -63);
#pragma unroll
    for (int i = 0; i < 4; ++i) { nW[i][0] = (u32x2){0u, 0u}; nW[i][1] = (u32x2){0u, 0u}; }
#pragma unroll
    for (int ks = 0; ks < 4; ++ks) { nB[ks][0] = (bf16x8){0, 0, 0, 0, 0, 0, 0, 0}; nB[ks][1] = (bf16x8){0, 0, 0, 0, 0, 0, 0, 0}; }
    asm volatile("s_waitcnt lgkmcnt(0)" : "+v"(W[0][0]), "+v"(W[0][1]), "+v"(W[1][0]), "+v"(W[1][1]), "+v"(W[2][0]), "+v"(W[2][1]), "+v"(W[3][0]), "+v"(W[3][1]), "+v"(W[4][0]), "+v"(W[4][1]), "+v"(W[5][0]), "+v"(W[5][1]),
                                            "+v"(B[0][0]), "+v"(B[0][1]), "+v"(B[1][0]), "+v"(B[1][1]), "+v"(B[2][0]), "+v"(B[2][1]), "+v"(B[3][0]), "+v"(B[3][1]) :: "memory");
#pragma unroll 1
    for (int D = -63; D <= 63; ++D) {
        const bool v0 = (D <= 31), v1 = (D >= -31);
        const unsigned an = aaddr - 128u;
        if (D < 63) { HY_RD(nW[0], an, 24); HY_RD(nW[1], an, 16); HY_RD(nW[2], an, 8); HY_RD(nW[3], an, 0); HY_LDB(nB, D + 1); }
        __builtin_amdgcn_sched_barrier(0);
#pragma unroll
        for (int ks = 0; ks < 4; ++ks) {
            const bf16x8 a0 = __builtin_bit_cast(bf16x8, (u32x4){W[3 - ks][0].x, W[3 - ks][0].y, W[3 - ks][1].x, W[3 - ks][1].y});
            const bf16x8 a1 = __builtin_bit_cast(bf16x8, (u32x4){W[5 - ks][0].x, W[5 - ks][0].y, W[5 - ks][1].x, W[5 - ks][1].y});
            if (v0) { acc[0][0] = MFMA32(a0, B[ks][0], acc[0][0]); acc[1][0] = MFMA32(a1, B[ks][0], acc[1][0]); }
            if (v1) { acc[0][1] = MFMA32(a0, B[ks][1], acc[0][1]); acc[1][1] = MFMA32(a1, B[ks][1], acc[1][1]); } }
        __builtin_amdgcn_sched_barrier(0);
        asm volatile("s_waitcnt lgkmcnt(0)" : "+v"(nW[0][0]), "+v"(nW[0][1]), "+v"(nW[1][0]), "+v"(nW[1][1]), "+v"(nW[2][0]), "+v"(nW[2][1]), "+v"(nW[3][0]), "+v"(nW[3][1]),
                                                "+v"(nB[0][0]), "+v"(nB[0][1]), "+v"(nB[1][0]), "+v"(nB[1][1]), "+v"(nB[2][0]), "+v"(nB[2][1]), "+v"(nB[3][0]), "+v"(nB[3][1]) :: "memory");
        W[0][0] = W[4][0]; W[0][1] = W[4][1]; W[1][0] = W[5][0]; W[1][1] = W[5][1];
#pragma unroll
        for (int i = 0; i < 4; ++i) { W[2 + i][0] = nW[i][0]; W[2 + i][1] = nW[i][1]; }
#pragma unroll
        for (int ks = 0; ks < 4; ++ks) { B[ks][0] = nB[ks][0]; B[ks][1] = nB[ks][1]; }
        aaddr = an;
    }
#undef HY_RD
#undef HY_LDB
    const float scale = ((const float*)(F.ws + WS_HYSC))[(l * 2 + order) * 512 + c], sk = F.in[I_HSKIP][(l * 2 + order) * 512 + c];
#pragma unroll
    for (int jt = 0; jt < 2; ++jt)
#pragma unroll
        for (int itl = 0; itl < 2; ++itl)
#pragma unroll
            for (int r = 0; r < 16; ++r) { const int t = 72 * (32 * itl + r32) + 32 * jt + crow(r, hi);
                const float u = bf2f(Uc[t]); Uc[t] = (bf16)f2bf(acc[jt][itl][r] * scale + sk * u); }
    LDS_WAIT();
    const bf16* gate = (const bf16*)(F.ws + WS_HT) + ((size_t)(b * 1536 + (order == 0 ? 512 : 1024) + c)) * SEQ;
    bf16* zdst = (bf16*)(F.ws + WS_Z1T) + ((size_t)(b * 512 + c)) * SEQ;
#pragma unroll
    for (int q = 0; q < 8; ++q) { const int t = 8 * lane + 512 * q;
        const u32x4 uv = *(const u32x4*)(Uc + t + (t >> 6) * 8); const u32x4 gv = *(const u32x4*)(gate + t);
        *(u32x4*)(zdst + t) = (u32x4){pk2(bflo(uv.x) * bflo(gv.x), bfhi(uv.x) * bfhi(gv.x)), pk2(bflo(uv.y) * bflo(gv.y), bfhi(uv.y) * bfhi(gv.y)),
                                      pk2(bflo(uv.z) * bflo(gv.z), bfhi(uv.z) * bfhi(gv.z)), pk2(bflo(uv.w) * bflo(gv.w), bfhi(uv.w) * bfhi(gv.w))}; }
}
__device__ __forceinline__ void hy_out_phase(Frame& F) {
    bf16* tile = (bf16*)F.lds;
    const int tid = F.tid;
    for (int it = blockIdx.x; it < 1024; it += F.G) {
        const int b = it >> 8, cb = (it >> 5) & 7, tb = it & 31;
        __syncthreads();
#pragma unroll
        for (int j = 0; j < 2; ++j) { const int idx = tid + 512 * j; const int ch = idx >> 4, t8 = (idx & 15) * 8;
            *(u32x4*)(tile + ch * 136 + t8) = *(const u32x4*)((const bf16*)(F.ws + WS_Z1T) + ((size_t)(b * 512 + 64 * cb + ch)) * SEQ + 128 * tb + t8); }
        __syncthreads();
#pragma unroll
        for (int j = 0; j < 2; ++j) { const int idx = tid + 512 * j; const int t = idx >> 3, c8 = (idx & 7) * 8; unsigned pk[4];
#pragma unroll
            for (int e = 0; e < 4; ++e) pk[e] = (unsigned)tile[(c8 + 2 * e) * 136 + t] | ((unsigned)tile[(c8 + 2 * e + 1) * 136 + t] << 16);
            *(u32x4*)((bf16*)(F.ws + WS_Y) + ((size_t)(b * SEQ + 128 * tb + t)) * DM + 1024 + 64 * cb + c8) = (u32x4){pk[0], pk[1], pk[2], pk[3]}; }
    }
    __syncthreads();
}

__device__ __forceinline__ float gelu_tanh(float x) { const float z = 0.7978845608028654f * (x + 0.044715f * x * x * x); const float t = 1.0f - 2.0f * __builtin_amdgcn_rcpf(__expf(2.0f * z) + 1.0f); return 0.5f * x * (1.0f + t); }
template <int STAGE> __device__ __forceinline__ void lru_item(Frame& F, int l, int it) {
    const bf16* proj = (const bf16*)(F.ws + WS_PROJ); bf16* Y = (bf16*)(F.ws + WS_Y);
    const int tid = F.tid, lane = F.lane, w = F.wave, r16 = lane & 15, q = lane >> 4;
    const int b = it >> 6, chunk = it & 63, t0 = chunk * 64;
    bf16* XC = (bf16*)F.lds;
    bf16* HFL = (bf16*)(F.lds + 66560);
    { const int c8 = (tid & 63) * 8, run = tid >> 6;
      u32x4 rw[11];
#pragma unroll
      for (int j = 0; j < 11; ++j) { const int tt = t0 + 8 * run - 2 + j; rw[j] = (u32x4){0u, 0u, 0u, 0u};
          if (tt >= 0 && tt < SEQ) rw[j] = *(const u32x4*)(proj + (size_t)(b * SEQ + tt) * DINP + C_AX + c8); }
      float wv[4][8], bv8[8];
#pragma unroll
      for (int e = 0; e < 8; ++e) { bv8[e] = F.in[I_LCB][l * 512 + c8 + e];
#pragma unroll
          for (int jj = 0; jj < 4; ++jj) wv[jj][e] = F.in[I_LCW][(l * 4 + jj) * 512 + c8 + e]; }
#pragma unroll
      for (int tk = 0; tk < 8; ++tk) { float o[8];
#pragma unroll
          for (int e = 0; e < 8; ++e) o[e] = bv8[e];
#pragma unroll
          for (int jj = 0; jj < 4; ++jj) { const u32x4 r4 = rw[tk + jj]; const unsigned w4[4] = {r4.x, r4.y, r4.z, r4.w};
#pragma unroll
              for (int e = 0; e < 4; ++e) { o[2 * e] += wv[jj][2 * e] * bflo(w4[e]); o[2 * e + 1] += wv[jj][2 * e + 1] * bfhi(w4[e]); } }
          *(u32x4*)(XC + (8 * run + tk) * 520 + c8) = (u32x4){pk2(o[0], o[1]), pk2(o[2], o[3]), pk2(o[4], o[5]), pk2(o[6], o[7])}; } }
    __syncthreads();
    const int blk = w;
    f32x2* sums = (f32x2*)(F.ws + WS_LRUS);
#pragma unroll 1
    for (int dir = 0; dir < 2; ++dir) {
        bf16x8 Bw[2][4][2]; float bav[4], bxv[4], lamc[4], hc[4], Ap[4];
#pragma unroll
        for (int nt = 0; nt < 4; ++nt) { const int ch = 64 * blk + 16 * nt + r16;
            bav[nt] = F.in[I_LBA][(l * 2 + dir) * 512 + ch]; bxv[nt] = F.in[I_LBX][(l * 2 + dir) * 512 + ch];
            lamc[nt] = -8.0f * log1pf(__expf(-F.in[I_LLAM][(l * 2 + dir) * 512 + ch])); hc[nt] = 0.f; Ap[nt] = 1.f;
#pragma unroll
            for (int gate = 0; gate < 2; ++gate)
#pragma unroll
                for (int ks = 0; ks < 2; ++ks)
                    Bw[gate][nt][ks] = *(const bf16x8*)((const bf16*)(F.ws + WS_LRUW) + ((((size_t)(l * 2 + dir) * 8 + blk) * 2 + gate) * 64 + 16 * nt + r16) * 64 + 32 * ks + 8 * q); }
        if (STAGE == 2) {
            const int cbeg = dir ? chunk + 1 : 0, cend = dir ? 64 : chunk;
#pragma unroll 1
            for (int ci = cbeg; ci < cend; ci += 8) { f32x2 sv[8][4];
#pragma unroll
                for (int u = 0; u < 8; ++u) { const int cu = ci + u; const int cj = dir ? (cend - 1 - (cu - cbeg)) : cu;
#pragma unroll
                    for (int nt = 0; nt < 4; ++nt) sv[u][nt] = (cu < cend) ? sums[((size_t)(b * 64 + cj) * 2 + dir) * 512 + 64 * blk + 16 * nt + r16] : (f32x2){1.f, 0.f}; }
#pragma unroll
                for (int u = 0; u < 8; ++u)
#pragma unroll
                    for (int nt = 0; nt < 4; ++nt) hc[nt] = sv[u][nt].x * hc[nt] + sv[u][nt].y; }
        }
        const int myi = dir ? 3 - q : q;
#pragma unroll 1
        for (int mi = 0; mi < 4; ++mi) { const int mt = dir ? 3 - mi : mi;
            bf16x8 af[2];
#pragma unroll
            for (int ks = 0; ks < 2; ++ks) af[ks] = *(const bf16x8*)(XC + (16 * mt + r16) * 520 + 64 * blk + 32 * ks + 8 * q);
            unsigned short gaw[4][4];
            if (STAGE == 2 && dir == 1) {
#pragma unroll
                for (int nt = 0; nt < 4; ++nt)
#pragma unroll
                    for (int r = 0; r < 4; ++r) gaw[nt][r] = proj[((size_t)b * SEQ + t0 + 16 * mt + 4 * q + r) * DINP + C_AG + 64 * blk + 16 * nt + r16]; }
#pragma unroll
            for (int nt = 0; nt < 4; ++nt) {
                f32x4 ga = (f32x4){0.f, 0.f, 0.f, 0.f}, gx = (f32x4){0.f, 0.f, 0.f, 0.f};
                ga = MFMA16(af[0], Bw[0][nt][0], ga); ga = MFMA16(af[1], Bw[0][nt][1], ga);
                gx = MFMA16(af[0], Bw[1][nt][0], gx); gx = MFMA16(af[1], Bw[1][nt][1], gx);
                float a_[4], u_[4];
#pragma unroll
                for (int r = 0; r < 4; ++r) { const int tok = 16 * mt + 4 * q + r;
                    const float rg = sigmoidf_(ga[r] + bav[nt]), ig = sigmoidf_(gx[r] + bxv[nt]);
                    const float la = lamc[nt] * rg; a_[r] = __expf(la); const float mult = __builtin_amdgcn_sqrtf(fmaxf(1.0f - a_[r] * a_[r], 0.f));
                    u_[r] = mult * ig * bf2f(XC[tok * 520 + 64 * blk + 16 * nt + r16]); }
                float ap[4], up[4];
#pragma unroll
                for (int i = 0; i < 4; ++i) { ap[i] = dir ? a_[3 - i] : a_[i]; up[i] = dir ? u_[3 - i] : u_[i]; }
                const float A = (ap[0] * ap[1]) * (ap[2] * ap[3]); const float U = ((up[0] * ap[1] + up[1]) * ap[2] + up[2]) * ap[3] + up[3];
                float h = hc[nt], hin = 0.f, aprod = 1.f;
#pragma unroll
                for (int i = 0; i < 4; ++i) { const int qs = dir ? 3 - i : i; const float Aq = shl_(A, r16 + 16 * qs), Uq = shl_(U, r16 + 16 * qs);
                    hin = (myi == i) ? h : hin; h = Aq * h + Uq; aprod *= Aq; }
                hc[nt] = h; Ap[nt] *= aprod;
                if (STAGE == 2) {
                    float hh = hin;
#pragma unroll
                    for (int i = 0; i < 4; ++i) { hh = ap[i] * hh + up[i];
                        const int r = dir ? 3 - i : i; const int tok = 16 * mt + 4 * q + r; const int ch = 64 * blk + 16 * nt + r16;
                        if (dir == 0) HFL[tok * 512 + ch] = (bf16)f2bf(hh);
                        else { const size_t row = (size_t)b * SEQ + t0 + tok; const float gav = bf2f(dir ? (i == 0 ? gaw[nt][3] : i == 1 ? gaw[nt][2] : i == 2 ? gaw[nt][1] : gaw[nt][0]) : 0);
                               Y[row * DM + ch] = (bf16)f2bf(gelu_tanh(gav) * (bf2f(HFL[tok * 512 + ch]) + hh)); } }
                }
            }
        }
        if (STAGE == 1) { if (q == 0) {
#pragma unroll
            for (int nt = 0; nt < 4; ++nt) sums[((size_t)(b * 64 + chunk) * 2 + dir) * 512 + 64 * blk + 16 * nt + r16] = (f32x2){Ap[nt], hc[nt]}; } }
        LDS_WAIT();
    }
}

__device__ __forceinline__ void ml_gates(Frame& F, float* G, int b, int h, int n) {
    const int tid = F.tid;
    __syncthreads();
    if (tid < 128) { const float* g = (const float*)(F.ws + WS_GATES) + ((size_t)b * SEQ + 128 * n + tid) * 16;
        G[tid] = g[h]; G[128 + tid] = logsigmoidf_(g[4 + h]); G[256 + tid] = g[8 + h]; G[384 + tid] = logsigmoidf_(g[12 + h]); }
    __syncthreads();
    if (tid < 256) { const int p0 = tid & 127; const bool sfx = tid >= 128; const float* src = G + (sfx ? 384 : 128); float s = 0.f;
#pragma unroll 16
        for (int p = 0; p < 128; ++p) { const float v = src[p]; s += (sfx ? (p >= p0) : (p <= p0)) ? v : 0.f; }
        G[(sfx ? 640 : 512) + p0] = s; }
    __syncthreads();
}
template <bool WITH_K> __device__ __forceinline__ void ml_load_T(Frame& F, bf16* VT, bf16* KTf, bf16* KTb, const float* Ef, const float* Eb, int b, int h, int n) {
    const bf16* proj = (const bf16*)(F.ws + WS_PROJ);
#pragma unroll
    for (int qq = 0; qq < 4; ++qq) { const int chunk = F.tid + 512 * qq; const int p = chunk & 127, cc = chunk >> 7; const size_t row = (size_t)b * SEQ + 128 * n + p;
        const u32x4 vv = *(const u32x4*)(proj + row * DINP + C_DV + 128 * h + 8 * cc);
        const unsigned vw[4] = {vv.x, vv.y, vv.z, vv.w};
#pragma unroll
        for (int e = 0; e < 4; ++e) { VT[(8 * cc + 2 * e) * 136 + p] = (bf16)(vw[e] & 0xffffu); VT[(8 * cc + 2 * e + 1) * 136 + p] = (bf16)(vw[e] >> 16); }
        if (WITH_K) { const u32x4 kv = *(const u32x4*)(proj + row * DINP + C_DK + 128 * h + 8 * cc); const unsigned kw[4] = {kv.x, kv.y, kv.z, kv.w}; const float ef = Ef[p], eb = Eb[p];
#pragma unroll
            for (int e = 0; e < 4; ++e) { const float k0 = bflo(kw[e]), k1 = bfhi(kw[e]);
                KTf[(8 * cc + 2 * e) * 136 + p] = (bf16)f2bf(k0 * ef); KTf[(8 * cc + 2 * e + 1) * 136 + p] = (bf16)f2bf(k1 * ef);
                KTb[(8 * cc + 2 * e) * 136 + p] = (bf16)f2bf(k0 * eb); KTb[(8 * cc + 2 * e + 1) * 136 + p] = (bf16)f2bf(k1 * eb); } } }
}
__device__ __forceinline__ void ml1_item(Frame& F, int it) {
    const int tid = F.tid, lane = F.lane, w = F.wave, r32 = lane & 31, hi = lane >> 5;
    const int b = it >> 7, h = (it >> 5) & 3, n = it & 31;
    bf16* VT = (bf16*)F.lds; bf16* KTf = (bf16*)(F.lds + 34816); bf16* KTb = (bf16*)(F.lds + 69632); float* G = (float*)(F.lds + 104448);
    ml_gates(F, G, b, h, n);
    float* Wd = G + 768; float* Ed = G + 1024; float* MX = G + 1280;
    if (tid < 256) { const int d = tid >> 7, p = tid & 127; Wd[tid] = d == 0 ? (G[512 + 127] - G[512 + p] + G[p]) : (G[640] - G[640 + p] + G[256 + p]); }
    __syncthreads();
    if (tid < 256) { const int d = tid >> 7, p = tid & 127; float mx = -INFINITY;
#pragma unroll 16
        for (int pp = 0; pp < 128; ++pp) mx = fmaxf(mx, Wd[d * 128 + pp]); Ed[tid] = __expf(Wd[tid] - mx); if (p == 0) MX[d] = mx; }
    __syncthreads();
    ml_load_T<true>(F, VT, KTf, KTb, Ed, Ed + 128, b, h, n);
    __syncthreads();
    const int d = w >> 2, vb = w & 3; const bf16* KT = d ? KTb : KTf;
    f32x16 acc[4];
#pragma unroll
    for (int kt = 0; kt < 4; ++kt)
#pragma unroll
        for (int r = 0; r < 16; ++r) acc[kt][r] = 0.f;
#pragma unroll
    for (int ps = 0; ps < 8; ++ps) { const bf16x8 a = *(const bf16x8*)(VT + (32 * vb + r32) * 136 + 16 * ps + 8 * hi);
#pragma unroll
        for (int kt = 0; kt < 4; ++kt) { const bf16x8 bb = *(const bf16x8*)(KT + (32 * kt + r32) * 136 + 16 * ps + 8 * hi); acc[kt] = MFMA32(a, bb, acc[kt]); } }
    const int idx = ((b * 4 + h) * 2 + d) * 32 + (d ? 31 - n : n);
    float* dst = (float*)(F.ws + WS_MLDC) + (size_t)idx * 16384;
#pragma unroll
    for (int kt = 0; kt < 4; ++kt)
#pragma unroll
        for (int r = 0; r < 16; ++r) dst[(32 * vb + crow(r, hi)) * 128 + 32 * kt + r32] = acc[kt][r];
    if (tid < 256) { const int dd = tid >> 7, k = tid & 127; const bf16* K2 = dd ? KTb : KTf; float s = 0.f; for (int p = 0; p < 128; ++p) s += bf2f(K2[k * 136 + p]);
        const int idx2 = ((b * 4 + h) * 2 + dd) * 32 + (dd ? 31 - n : n);
        ((float*)(F.ws + WS_MLDN))[(size_t)idx2 * 128 + k] = s;
        if (k == 0) { float* sc = (float*)(F.ws + WS_MLSC) + (size_t)idx2 * 4; sc[0] = MX[dd]; sc[1] = dd ? G[640] : G[512 + 127]; } }
}
__device__ __forceinline__ void ml2_item(Frame& F, int it) {
    const int tid = F.tid, bhd = it >> 3, part = it & 7, e0 = part * 2048 + tid * 4;
    const float* sc = (const float*)(F.ws + WS_MLSC); float* scw = (float*)(F.ws + WS_MLSC);
    const bool nthr = (part == 0) && (tid < 32);
    float m = 0.f; f32x4 C = (f32x4){0.f, 0.f, 0.f, 0.f}, nv = (f32x4){0.f, 0.f, 0.f, 0.f};
#pragma unroll 8
    for (int cn = 0; cn < 32; ++cn) { const size_t idx = (size_t)bhd * 32 + cn; const float mloc = sc[idx * 4], bt = sc[idx * 4 + 1];
        const float mnew = fmaxf(bt + m, mloc), dec = __expf(bt + m - mnew), gn = __expf(mloc - mnew);
        *(u32x2*)((bf16*)(F.ws + WS_MLCT) + idx * 16384 + e0) = (u32x2){pk2(C.x, C.y), pk2(C.z, C.w)};
        if (nthr) *(f32x4*)((float*)(F.ws + WS_MLNP) + idx * 128 + 4 * tid) = nv;
        if (part == 0 && tid == 0) scw[idx * 4 + 2] = m;
        const f32x4 dc = *(const f32x4*)((const float*)(F.ws + WS_MLDC) + idx * 16384 + e0); C = C * dec + dc * gn;
        if (nthr) { const f32x4 dn = *(const f32x4*)((const float*)(F.ws + WS_MLDN) + idx * 128 + 4 * tid); nv = nv * dec + dn * gn; }
        m = mnew; }
}
__device__ __forceinline__ void ml3_item(Frame& F, int l, int it) {
    const bf16* proj = (const bf16*)(F.ws + WS_PROJ);
    const int tid = F.tid, lane = F.lane, w = F.wave, r32 = lane & 31, hi = lane >> 5;
    const int b = it >> 7, h = (it >> 5) & 3, n = it & 31;
    bf16* VT = (bf16*)F.lds; bf16* KN = (bf16*)(F.lds + 34816); float* HF = (float*)(F.lds + 69632); float* G = (float*)(F.lds + 135680); float* INV = (float*)(F.lds + 143872);
    ml_gates(F, G, b, h, n);
    const int idx_f = ((b * 4 + h) * 2 + 0) * 32 + n, idx_b = ((b * 4 + h) * 2 + 1) * 32 + (31 - n);
    const float mpf = ((const float*)(F.ws + WS_MLSC))[(size_t)idx_f * 4 + 2], mpb = ((const float*)(F.ws + WS_MLSC))[(size_t)idx_b * 4 + 2];
    if (tid < 128) { G[7 * 128 + tid] = G[tid] - G[512 + tid]; G[11 * 128 + tid] = G[256 + tid] - G[640 + tid]; }
    __syncthreads();
    if (tid < 128) { const int p = tid; float pm = -INFINITY;
#pragma unroll 16
        for (int s = 0; s < 128; ++s) { const float v = G[7 * 128 + s]; pm = fmaxf(pm, (s <= p) ? v : -INFINITY); }
        const float bl = G[512 + p], mint = bl + mpf, mt = fmaxf(mint, bl + pm); G[8 * 128 + p] = __expf(mint - mt); G[6 * 128 + p] = bl - mt; G[9 * 128 + p] = mt; }
    else if (tid < 256) { const int p = tid - 128; float pm = -INFINITY;
#pragma unroll 16
        for (int s = 0; s < 128; ++s) { const float v = G[11 * 128 + s]; pm = fmaxf(pm, (s >= p) ? v : -INFINITY); }
        const float bl = G[640 + p], mint = bl + mpb, mt = fmaxf(mint, bl + pm); G[12 * 128 + p] = __expf(mint - mt); G[10 * 128 + p] = bl - mt; G[13 * 128 + p] = mt; }
    else if (tid < 384) { const int k = tid - 256; G[14 * 128 + k] = ((const float*)(F.ws + WS_MLNP))[(size_t)idx_f * 128 + k]; }
    else { const int k = tid - 384; G[15 * 128 + k] = ((const float*)(F.ws + WS_MLNP))[(size_t)idx_b * 128 + k]; }
    ml_load_T<false>(F, VT, nullptr, nullptr, nullptr, nullptr, b, h, n);
    { u32x4 kv[4];
#pragma unroll
      for (int qq = 0; qq < 4; ++qq) { const int chunk = tid + 512 * qq; const int p = chunk >> 4, cc = chunk & 15; kv[qq] = *(const u32x4*)(proj + ((size_t)b * SEQ + 128 * n + p) * DINP + C_DK + 128 * h + 8 * cc); }
#pragma unroll
      for (int qq = 0; qq < 4; ++qq) { const int chunk = tid + 512 * qq; const int p = chunk >> 4, cc = chunk & 15; *(u32x4*)(KN + p * 136 + 8 * cc) = kv[qq]; } }
    __syncthreads();
    const int lb = w & 3, vh = w >> 2, ll = 32 * lb + r32;
    const float SCALE = 0.08838834764831845f;
    bf16x8 qf[8];
    { const bf16* qp = proj + ((size_t)b * SEQ + 128 * n + ll) * DINP + C_DQ + 128 * h + 8 * hi;
#pragma unroll
      for (int ks = 0; ks < 8; ++ks) qf[ks] = *(const bf16x8*)(qp + 16 * ks); }
#pragma unroll 1
    for (int d = 0; d < 2; ++d) {
        const int idx = d ? idx_b : idx_f;
        const float* RT = G + (d ? 10 : 6) * 128; const float* CF = G + (d ? 11 : 7) * 128; const float* EI = G + (d ? 12 : 8) * 128; const float* MT = G + (d ? 13 : 9) * 128; const float* NP = G + (d ? 15 : 14) * 128;
        const float rt = RT[ll], ei = EI[ll], mt = MT[ll];
        f32x16 O[2];
#pragma unroll
        for (int vt = 0; vt < 2; ++vt)
#pragma unroll
            for (int r = 0; r < 16; ++r) O[vt][r] = 0.f;
        float dsum = 0.f;
        const int st_lo = d ? lb : 0, st_hi = d ? 3 : lb;
#pragma unroll 1
        for (int st = st_lo; st <= st_hi; ++st) {
            f32x16 sacc;
#pragma unroll
            for (int r = 0; r < 16; ++r) sacc[r] = 0.f;
            const bf16* kp = KN + (32 * st + r32) * 136 + 8 * hi;
#pragma unroll
            for (int ks = 0; ks < 8; ++ks) { const bf16x8 kf = *(const bf16x8*)(kp + 16 * ks); sacc = MFMA32(kf, qf[ks], sacc); }
            float P[16];
#pragma unroll
            for (int r = 0; r < 16; ++r) { const int s_ = 32 * st + crow(r, hi); const bool ok = d ? (s_ >= ll) : (s_ <= ll);
                const float pv = ok ? sacc[r] * SCALE * __expf(rt + CF[s_]) : 0.f; P[r] = pv; dsum += pv; }
#pragma unroll
            for (int half = 0; half < 2; ++half) {
                const u32x4 pw = (u32x4){pk2(P[8 * half + 0], P[8 * half + 1]), pk2(P[8 * half + 2], P[8 * half + 3]), pk2(P[8 * half + 4], P[8 * half + 5]), pk2(P[8 * half + 6], P[8 * half + 7])};
                const bf16x8 pa = __builtin_bit_cast(bf16x8, pw);
#pragma unroll
                for (int vt = 0; vt < 2; ++vt) { const bf16* vp = VT + (32 * (2 * vh + vt) + r32) * 136 + 32 * st + 16 * half + 4 * hi;
                    const u32x2 lo = *(const u32x2*)vp, hi2 = *(const u32x2*)(vp + 8);
                    const bf16x8 bv = __builtin_bit_cast(bf16x8, (u32x4){lo.x, lo.y, hi2.x, hi2.y});
                    O[vt] = MFMA32(pa, bv, O[vt]); } } }
        const float qs = ei * SCALE; float dq = 0.f;
#pragma unroll
        for (int ks = 0; ks < 8; ++ks) { const u32x4 qw = __builtin_bit_cast(u32x4, qf[ks]); const unsigned qq[4] = {qw.x, qw.y, qw.z, qw.w}; float qv[8];
#pragma unroll
            for (int e = 0; e < 4; ++e) { qv[2 * e] = bflo(qq[e]); qv[2 * e + 1] = bfhi(qq[e]); }
#pragma unroll
            for (int e = 0; e < 8; ++e) dq += qv[e] * NP[16 * ks + 8 * hi + e];
            const u32x4 sw = (u32x4){pk2(qv[0] * qs, qv[1] * qs), pk2(qv[2] * qs, qv[3] * qs), pk2(qv[4] * qs, qv[5] * qs), pk2(qv[6] * qs, qv[7] * qs)};
            const bf16x8 qp2 = __builtin_bit_cast(bf16x8, sw);
#pragma unroll
            for (int vt = 0; vt < 2; ++vt) { const bf16x8 cf = *(const bf16x8*)((const bf16*)(F.ws + WS_MLCT) + (size_t)idx * 16384 + (32 * (2 * vh + vt) + r32) * 128 + 16 * ks + 8 * hi);
                O[vt] = MFMA32(qp2, cf, O[vt]); } }
        dsum += shx(dsum, 32); dq += shx(dq, 32);
        const float den = dsum + qs * dq;
        const float inv = 1.0f / fmaxf(fabsf(den), __expf(-mt));
        asm volatile("" ::: "memory");
        INV[w * 32 + r32] = inv;
        LDS_WAIT();
#pragma unroll
        for (int vt = 0; vt < 2; ++vt)
#pragma unroll
            for (int r = 0; r < 16; ++r) { float* hp = HF + (32 * lb + crow(r, hi)) * 129 + 32 * (2 * vh + vt) + r32; const float hv_ = O[vt][r] * INV[w * 32 + crow(r, hi)];
                *hp = d ? (*hp + hv_) : hv_; }
        LDS_WAIT();
    }
    __syncthreads();
    { const int p = tid >> 2, part = tid & 3; const size_t row = (size_t)b * SEQ + 128 * n + p;
      float hv[32]; float ss = 0.f;
#pragma unroll
      for (int e = 0; e < 32; ++e) { hv[e] = HF[p * 129 + 32 * part + e]; ss += hv[e] * hv[e]; }
      ss += shx(ss, 1); ss += shx(ss, 2);
      const float rstd = rsqrtf(ss * (1.0f / 128.0f) + EPS);
      const bf16* op = proj + row * DINP + C_DO + 128 * h + 32 * part; const float* gp = F.in[I_MLG] + l * 512 + 128 * h + 32 * part;
      bf16* yp = (bf16*)(F.ws + WS_Y) + row * DM + 1536 + 128 * h + 32 * part;
#pragma unroll
      for (int e8 = 0; e8 < 4; ++e8) { const u32x4 ov = *(const u32x4*)(op + 8 * e8); const unsigned ow[4] = {ov.x, ov.y, ov.z, ov.w}; unsigned pk[4];
#pragma unroll
          for (int e = 0; e < 4; ++e) { const float y0 = hv[8 * e8 + 2 * e] * rstd * gp[8 * e8 + 2 * e] * sigmoidf_(bflo(ow[e])); const float y1 = hv[8 * e8 + 2 * e + 1] * rstd * gp[8 * e8 + 2 * e + 1] * sigmoidf_(bfhi(ow[e])); pk[e] = pk2(y0, y1); }
          *(u32x4*)(yp + 8 * e8) = (u32x4){pk[0], pk[1], pk[2], pk[3]}; } }
}

__device__ __forceinline__ void mixer_phase(Frame& F0, int l, int stage, int rep) {
    unsigned* ctr = (unsigned*)(F0.ws + WS_CTL) + 64 * (1 + (l * 3 + stage) * 2 + rep);
    const int nitems = (stage == 0) ? 1792 : 1024;
    for (;;) {
        const int it = next_item(ctr, F0.lds);
        if (it >= nitems) break;
        Frame F = F0;
        { unsigned zoff = 0u; asm volatile("" : "+s"(zoff)); F.ws = F0.ws + zoff; F.out = F0.out + zoff; F.in = F0.in + zoff; F.tid = lt(); F.lane = F.tid & 63; F.wave = __builtin_amdgcn_readfirstlane(F.tid >> 6); }
#if MK_PROBE
        if (rep == 1) { int ty; if (stage == 0) ty = it < 512 ? 4 : (it < 768 ? 3 : 5); else ty = it < 256 ? 1 : (it < 512 ? 2 : ((stage == 1 && it < 768) ? 3 : 4));
            if (!((MK_PTYPE >> ty) & 1)) continue; }
#endif
        if (stage == 0) {
            if (it < 512) ml1_item(F, it);
            else if (it < 768) lru_item<1>(F, l, it - 512);
            else if (it < 1536) hy_prep_item(F, l, it - 768);
            else attn_prep_item(F, l, it - 1536);
        } else {
            if (it < 256) hy_conv_item(F, l, stage - 1, it);
            else if (it < 512) {
                volatile unsigned* slot = (volatile unsigned*)(F.lds + SLOT_OFF);
                if (F.tid == 0) { unsigned* actr = (unsigned*)(F.ws + WS_CTL) + 64 * (32 + (l * 2 + (stage - 1)) * 8); const unsigned x0 = xb_xcc_id() & 7u; unsigned unit = 0u;
                    for (unsigned k = 0; k < 8; ++k) { const unsigned x = (x0 + k) & 7u; if (__hip_atomic_load(actr + 64 * x, __ATOMIC_RELAXED, __HIP_MEMORY_SCOPE_AGENT) >= 32u) continue;
                        const unsigned a = atomicAdd(actr + 64 * x, 1u); if (a < 32u) { unit = x * 32u + a; break; } }
                    slot[1] = unit; }
                __syncthreads();
                const int un = (int)slot[1]; const int x = un >> 5, a = un & 31; const int b_ = x >> 1, h_ = (x & 1) * 4 + (a >> 3), qb = (a & 7) + (stage == 2 ? 8 : 0);
                attn_body::attn_unit<8>(b_, h_, qb, (const attn_body::bf16*)(F.ws + WS_QB), (const attn_body::bf16*)(F.ws + WS_KB),
                                        (const attn_body::bf16*)(F.ws + WS_VB), (attn_body::bf16*)(F.ws + WS_Y) + 512, (char*)F.lds); }
            else if (stage == 1) { if (it < 768) lru_item<2>(F, l, it - 512); else ml2_item(F, it - 768); }
            else ml3_item(F, l, it - 512);
        }
    }
    __syncthreads();
}

constexpr int N_PHASES = 22;
__global__ void __launch_bounds__(512, 2) fwd_kernel(Args args) {
    extern __shared__ __attribute__((aligned(16))) unsigned char lds[];
    cg::grid_group grid = cg::this_grid();
    volatile LAS unsigned* xst = (volatile LAS unsigned*)((LAS unsigned char*)lds + SLOT_OFF + 16);
    if (threadIdx.x == 0) { xst[0] = 0u; xst[1] = 0u; }
    __syncthreads();
    const XcdBarrier xbar = xcd_barrier_post((unsigned*)(args.ws + WS_CTL) + 4096, xst);
    Frame F0; F0.lds = lds; F0.ws = args.ws; F0.in = args.in; F0.out = args.out;
    F0.tid = threadIdx.x; F0.lane = F0.tid & 63; F0.wave = __builtin_amdgcn_readfirstlane(F0.tid >> 6); F0.G = gridDim.x;
    int ph = args.ph_lo, rep = 0;
#if (MK_PROBE & 8)
#pragma unroll 1
    for (int i = 0; i < 40; ++i) grid.sync();
#endif
#pragma unroll 1
    while (ph < args.ph_hi) {
        Frame F = F0;
        { unsigned zoff = 0u; asm volatile("" : "+s"(zoff)); F.ws = F0.ws + zoff; F.out = F0.out + zoff; F.in = F0.in + zoff; F.tid = lt(); F.lane = F.tid & 63; F.wave = __builtin_amdgcn_readfirstlane(F.tid >> 6); }
        if (ph == 0) p0_prologue(F);
        else if (ph == N_PHASES - 1) final_norm_phase(F, F.out, F.in[I_FG]);
        else {
            const int l = (ph - 1) / 10, k = (ph - 1) % 10;
            const float* mod = (const float*)(F.ws + WS_MOD) + (size_t)l * 4 * 12288;
            if (k == 0 || k == 7) {
                if (ph == 1) hy_scale_reduce(F);
                const float* xin = (ph == 1) ? F.in[I_X] : F.out;
                if (k == 0) norm_phase(F, xin, F.in[I_NMG] + l * DM, mod + 0 * DM, mod + 1 * DM, (bf16*)(F.ws + WS_XN));
                else norm_phase(F, xin, F.in[I_NFG] + l * DM, mod + 3 * DM, mod + 4 * DM, (bf16*)(F.ws + WS_XN));
            } else if (k == 1) {
                pg8::Gemm g{(const pg8::bf16_t*)(F.ws + WS_XN), (const pg8::bf16_t*)(F.ws + WS_WIN) + (size_t)l * DINP * DM, MTOK, DINP, DM};
                pg8::StaticOrder S; S.init(MTOK, DINP, F.G, (int)blockIdx.x);
                pg8::EpiInProj E{(pg8::bf16_t*)(F.ws + WS_PROJ), DINP, (const float*)(F.ws + WS_BINP) + l * DINP, (float*)(F.ws + WS_GATES)};
                pg8::gemm_phase<pg8::EpiInProj, pg8::StaticOrder, true, true>((LAS unsigned char*)lds, g, S, E);
            } else if (k >= 2 && k <= 4) {
                mixer_phase(F, l, k - 2, rep);
            } else if (k == 5) {
                hy_out_phase(F);
            } else if (k == 6) {
                pg8::Gemm g{(const pg8::bf16_t*)(F.ws + WS_Y), (const pg8::bf16_t*)(F.ws + WS_WOUT) + (size_t)l * DM * DM, MTOK, DM, DM};
                pg8::StaticOrder S; S.init(MTOK, DM, F.G, (int)blockIdx.x);
                pg8::EpiResGate E{(l == 0) ? F.in[I_X] : (const float*)F.out, F.out, DM, mod + 2 * DM, 12288};
                pg8::gemm_phase<pg8::EpiResGate, pg8::StaticOrder, true, true>((LAS unsigned char*)lds, g, S, E);
            } else if (k == 8) {
                pg8::Gemm g{(const pg8::bf16_t*)(F.ws + WS_XN), (const pg8::bf16_t*)(F.ws + WS_W13) + (size_t)l * 2 * DFF * DM, MTOK, 2 * DFF, DM};
                pg8::StaticOrder S; S.init(MTOK, 2 * DFF, F.G, (int)blockIdx.x);
                pg8::EpiSwiGLU E{(pg8::bf16_t*)(F.ws + WS_PROJ), DFF};
                pg8::gemm_phase<pg8::EpiSwiGLU, pg8::StaticOrder, true, true>((LAS unsigned char*)lds, g, S, E);
            } else {
                pg8::Gemm g{(const pg8::bf16_t*)(F.ws + WS_PROJ), (const pg8::bf16_t*)(F.ws + WS_W2) + (size_t)l * DM * DFF, MTOK, DM, DFF};
                pg8::StaticOrder S; S.init(MTOK, DM, F.G, (int)blockIdx.x);
                pg8::EpiResGate E{(const float*)F.out, F.out, DM, mod + 5 * DM, 12288};
                pg8::gemm_phase<pg8::EpiResGate, pg8::StaticOrder, true, true>((LAS unsigned char*)lds, g, S, E);
            }
        }
        bool again = false;
#if MK_PROBE
        if (rep == 0) { const int kk = (ph == 0 || ph == N_PHASES - 1) ? -1 : (ph - 1) % 10;
          if ((MK_PROBE & 1) && kk >= 2 && kk <= 4) again = true;
          if ((MK_PROBE & 16) && kk == 2) again = true;
          if ((MK_PROBE & 64) && ph == 0) again = true;
          if ((MK_PROBE & 128) && (kk == 0 || kk == 7)) again = true;
          if ((MK_PROBE & 32) && kk == 3) again = true;
          if ((MK_PROBE & 2) && (kk == 1 || kk == 8)) again = true;
          if ((MK_PROBE & 4) && (kk == 0 || kk == 7 || ph == 0)) again = true; }
#endif
        if (again) rep = 1; else { rep = 0; ++ph; }
        if (ph < args.ph_hi) { if (ph == 1 && rep == 0) grid.sync(); else xcd_barrier(xbar); }
    }
}

#ifndef MK_N_LAUNCHES
#define MK_N_LAUNCHES 1
#endif
extern "C" void kernel_launch(void* const* d_in, const int* in_sizes, int n_in, void* d_out, int out_size, void* d_ws, size_t ws_size, hipStream_t stream) {
    static int grid = 0;
    if (grid == 0) {
        if (n_in != 33 || out_size != MTOK * DM || ws_size < WS_END) { fprintf(stderr, "kernel_launch: unexpected shapes (n_in %d, out %d, ws %zu < %zu)\n", n_in, out_size, ws_size, (size_t)WS_END); grid = -1; return; }
        int dev = 0, cus = 0, per_cu = 0;
        (void)hipGetDevice(&dev); (void)hipDeviceGetAttribute(&cus, hipDeviceAttributeMultiprocessorCount, dev);
        if (hipFuncSetAttribute((const void*)fwd_kernel, hipFuncAttributeMaxDynamicSharedMemorySize, LDS_BYTES) != hipSuccess) { fprintf(stderr, "kernel_launch: hipFuncSetAttribute failed\n"); grid = -1; return; }
        if (hipOccupancyMaxActiveBlocksPerMultiprocessor(&per_cu, (const void*)fwd_kernel, 512, LDS_BYTES) != hipSuccess || per_cu < 1) per_cu = 1;
        (void)hipGetLastError();
        grid = cus * per_cu;
        fprintf(stderr, "kernel_launch: grid %d (cus %d x %d), ws %zu\n", grid, cus, per_cu, ws_size);
    }
    if (grid < 0) return;
    (void)hipMemsetAsync((char*)d_ws + WS_CTL, 0, CTL_BYTES, stream);
    Args a{};
    for (int i = 0; i < 33; ++i) a.in[i] = (const float*)d_in[i];
    a.out = (float*)d_out; a.ws = (unsigned char*)d_ws;
    if (MK_N_LAUNCHES == 1) {
        a.ph_lo = 0; a.ph_hi = N_PHASES;
        void* kargs[] = {&a};
        const hipError_t e = hipLaunchCooperativeKernel((const void*)fwd_kernel, dim3(grid), dim3(512), kargs, LDS_BYTES, stream);
        if (e != hipSuccess) fprintf(stderr, "kernel_launch: cooperative launch failed: %s (grid %d)\n", hipGetErrorString(e), grid);
    } else {
        for (int ph = 0; ph < N_PHASES; ++ph) { a.ph_lo = ph; a.ph_hi = ph + 1; hipLaunchKernelGGL(fwd_kernel, dim3(grid), dim3(512), LDS_BYTES, stream, a); }
    }
}
```

```cpp
#include <hip/hip_runtime.h>
#include <hip/hip_cooperative_groups.h>
#include <hip/hip_bf16.h>
#include <cstdio>
#include <cstdint>
#include <cmath>
namespace cg = cooperative_groups;

#define LAS __attribute__((address_space(3)))
typedef unsigned short bf16;
typedef short bf16x8 __attribute__((ext_vector_type(8)));
typedef float f32x2 __attribute__((ext_vector_type(2)));
typedef float f32x4 __attribute__((ext_vector_type(4)));
typedef float f32x16 __attribute__((ext_vector_type(16)));
typedef unsigned u32x4 __attribute__((ext_vector_type(4)));
typedef unsigned u32x2 __attribute__((ext_vector_type(2)));

constexpr int DM = 2048, NBATCH = 4, SEQ = 4096, MTOK = NBATCH * SEQ, DEPTH = 2, DIN = 5392, DINP = 5632, DFF = 5632;
constexpr int C_AX = 0, C_AG = 512, C_BQ = 1024, C_BK = 1536, C_BV = 1664, C_CU = 1792, C_DQ = 3328, C_DK = 3840, C_DV = 4352, C_DO = 4864, C_GT = 5376;
constexpr float EPS = 1e-6f;

constexpr size_t MiB = (size_t)1 << 20;
constexpr size_t WS_CTL = 0, CTL_BYTES = 1 * MiB;
constexpr size_t WS_MOD = 1 * MiB;
constexpr size_t WS_HYSC = 1 * MiB + 512 * 1024;
constexpr size_t WS_BINP = 1 * MiB + 576 * 1024;
constexpr size_t WS_LRUS = 2 * MiB;
constexpr size_t WS_HYPART = 4 * MiB;
constexpr size_t WS_WIN = 8 * MiB;
constexpr size_t WS_WOUT = 52 * MiB;
constexpr size_t WS_W13 = 68 * MiB;
constexpr size_t WS_W2 = 156 * MiB;
constexpr size_t WS_HYFT = 200 * MiB;
constexpr size_t WS_LRUW = 232 * MiB;
constexpr size_t WS_MLDN = 233 * MiB;
constexpr size_t WS_MLNP = 233 * MiB + 512 * 1024;
constexpr size_t WS_MLSC = 234 * MiB;
constexpr size_t WS_GATES = 235 * MiB;
constexpr size_t WS_XN = 240 * MiB;
constexpr size_t WS_MLDC = WS_XN;
constexpr size_t WS_PROJ = 304 * MiB;
constexpr size_t WS_Y = 480 * MiB;
constexpr size_t WS_QB = 544 * MiB;
constexpr size_t WS_KB = 560 * MiB;
constexpr size_t WS_VB = 564 * MiB;
constexpr size_t WS_HT = 568 * MiB;
constexpr size_t WS_Z1T = 616 * MiB;
constexpr size_t WS_MLCT = 632 * MiB;
constexpr size_t WS_END = 664 * MiB;

constexpr int LDS_BYTES = 147456;
constexpr int SLOT_OFF = LDS_BYTES - 64;

__device__ __forceinline__ unsigned f2bf(float f) { unsigned u = __builtin_bit_cast(unsigned, f); return (u + 0x7fffu + ((u >> 16) & 1u)) >> 16; }
__device__ __forceinline__ unsigned pk2(float lo, float hi) { return f2bf(lo) | (f2bf(hi) << 16); }
__device__ __forceinline__ float bf2f(unsigned h) { return __builtin_bit_cast(float, h << 16); }
__device__ __forceinline__ float bflo(unsigned w) { return __builtin_bit_cast(float, w << 16); }
__device__ __forceinline__ float bfhi(unsigned w) { return __builtin_bit_cast(float, w & 0xffff0000u); }
__device__ __forceinline__ int lt() { int t = threadIdx.x; asm volatile("" : "+v"(t)); return t; }
__device__ __forceinline__ float shx(float v, int m) { const int l = lt() & 63; return __builtin_bit_cast(float, __builtin_amdgcn_ds_bpermute((l ^ m) << 2, __builtin_bit_cast(int, v))); }
__device__ __forceinline__ float shl_(float v, int src) { return __builtin_bit_cast(float, __builtin_amdgcn_ds_bpermute(src << 2, __builtin_bit_cast(int, v))); }
__device__ __forceinline__ float wave_sum(float v) {
#pragma unroll
    for (int o = 1; o < 64; o <<= 1) v += shx(v, o);
    return v;
}
__device__ __forceinline__ float sigmoidf_(float x) { return __builtin_amdgcn_rcpf(1.0f + __expf(-x)); }
__device__ __forceinline__ float sin_rad(float x) { return __builtin_amdgcn_sinf(x * 0.15915494309189535f); }
__device__ __forceinline__ float cos_rad(float x) { return __builtin_amdgcn_cosf(x * 0.15915494309189535f); }
__device__ __forceinline__ float logsigmoidf_(float x) { return fminf(x, 0.f) - log1pf(__expf(-fabsf(x))); }
__device__ __forceinline__ int crow(int r, int hi) { return (r & 3) + 8 * (r >> 2) + 4 * hi; }
#define LDS_WAIT() asm volatile("s_waitcnt lgkmcnt(0)" ::: "memory")


#define XB_TMO      128
#define XB_XCNT(j)  (256  + 64 * (j))
#define XB_XSUB(j)  (1280 + 64 * (j))
#define XB_XGEN(j)  (2304 + 64 * (j))
#define XB_TOP      3328
#define XB_TOPGEN   3392
#define XCD_BAR_WORDS 3456
#define XB_SPIN_CAP (1u << 18)

__device__ __forceinline__ unsigned xb_ld(unsigned* p)              { return __hip_atomic_load(p, __ATOMIC_RELAXED, __HIP_MEMORY_SCOPE_AGENT); }
__device__ __forceinline__ unsigned xb_add(unsigned* p, unsigned v) { return __hip_atomic_fetch_add(p, v, __ATOMIC_RELAXED, __HIP_MEMORY_SCOPE_AGENT); }
__device__ __forceinline__ unsigned xb_xcc_id() { return (unsigned)__builtin_amdgcn_s_getreg((3 << 11) | 20) & 0xFu; }
#define XB_SPIN(cond, bar) do { unsigned _sp = 0; while (cond) { __builtin_amdgcn_s_sleep(1); \
    if ((++_sp & 255u) == 0u) { if (xb_ld(&(bar)[XB_TMO])) break; if (_sp > XB_SPIN_CAP) { atomicAdd(&(bar)[XB_TMO], 1u); break; } } } } while (0)

struct XcdBarrier {
    unsigned* bar; unsigned x;
    volatile LAS unsigned* st;
};

__device__ __forceinline__ XcdBarrier xcd_barrier_post(unsigned* bar, volatile LAS unsigned* st) {
    XcdBarrier b; b.bar = bar; b.x = xb_xcc_id(); b.st = st;
    if (threadIdx.x == 0) (void)xb_add(&bar[XB_XCNT(b.x)], 1u);
    return b;
}
__device__ __forceinline__ void xcd_barrier_complete(unsigned* bar, unsigned x, unsigned& nloc, unsigned& nx) {
    const unsigned G = gridDim.x * gridDim.y * gridDim.z;
    unsigned sum, cnt, mine, sp = 0u;
    for (;;) {
        sum = 0u; cnt = 0u; mine = 0u;
#pragma unroll 1
        for (unsigned j = 0; j < 16; ++j) { const unsigned c = xb_ld(&bar[XB_XCNT(j)]); sum += c; cnt += (c > 0u) ? 1u : 0u; mine = (j == x) ? c : mine; }
        if (sum == G) break;
        __builtin_amdgcn_s_sleep(1);
        if ((++sp & 255u) == 0u) { if (xb_ld(&bar[XB_TMO])) break; if (sp > XB_SPIN_CAP) { atomicAdd(&bar[XB_TMO], 1u); break; } }
    }
    nloc = mine > 0u ? mine : 1u; nx = cnt > 0u ? cnt : 1u;
}

__device__ __forceinline__ void xcd_barrier(const XcdBarrier& b) {
    asm volatile("s_waitcnt vmcnt(0)" ::: "memory");
    __syncthreads();
    if (threadIdx.x == 0) {
        unsigned zo_ = 0u; asm volatile("" : "+s"(zo_));
        unsigned* bar = b.bar + zo_;
        __builtin_amdgcn_s_waitcnt(0);
        unsigned nloc = b.st[0], nx = b.st[1];
        if (nloc == 0u) { xcd_barrier_complete(bar, b.x, nloc, nx); b.st[0] = nloc; b.st[1] = nx; }
        const unsigned old = xb_add(&bar[XB_XSUB(b.x)], 1u);
        const unsigned gen = old / nloc;
        if (old + 1u == (gen + 1u) * nloc) {
            __builtin_amdgcn_fence(__ATOMIC_RELEASE, "agent");
            asm volatile("s_waitcnt vmcnt(0)" ::: "memory");
            const unsigned og = xb_add(&bar[XB_TOP], 1u);
            const unsigned tg = og / nx;
            if (og + 1u == (tg + 1u) * nx) xb_add(&bar[XB_TOPGEN], 1u);
            else XB_SPIN(xb_ld(&bar[XB_TOPGEN]) == tg, bar);
            __builtin_amdgcn_fence(__ATOMIC_ACQUIRE, "agent");
            xb_add(&bar[XB_XGEN(b.x)], 1u);
            asm volatile("s_waitcnt vmcnt(0)" ::: "memory");
        } else {
            XB_SPIN(xb_ld(&bar[XB_XGEN(b.x)]) == gen, bar);
            __builtin_amdgcn_fence(__ATOMIC_ACQUIRE, "agent");
            asm volatile("s_waitcnt vmcnt(0)" ::: "memory");
        }
    }
    __syncthreads();
}
namespace pg8 {
#define PG8_LAS __attribute__((address_space(3)))
typedef unsigned short bf16_t;
typedef short bf16x8 __attribute__((ext_vector_type(8)));
typedef float f32x4 __attribute__((ext_vector_type(4)));
typedef unsigned u32x4 __attribute__((ext_vector_type(4)));
constexpr int BM = 256, BK = 64, HALF = 128, HTB = HALF * BK * 2  , STAGE_BYTES = 8 * HTB, NXCD = 8, WGM = 8;

__host__ __device__ __forceinline__ int lds_byte(int r, int c) { const int st = (r >> 4) * 2 + (c >> 5), rr = r & 15, cc = c & 31, ob = rr * 64 + cc * 2; return st * 1024 + (ob ^ (((ob >> 9) & 1) << 5)); }
__host__ __device__ __forceinline__ void stage_rc(int b, int& R, int& C) { const int st = b / 1024, sb = b % 1024, swz = sb ^ (((sb >> 9) & 1) << 5); R = (st >> 1) * 16 + swz / 64; C = (st & 1) * 32 + (swz % 64) / 2; }
__host__ __device__ __forceinline__ int perm32(int rho) { const int n = rho >> 4, i = rho & 15; return 8 * (i >> 2) + 4 * n + (i & 3); }

struct Unit { int pm, pn; };
struct Gemm { const bf16_t* A; const bf16_t* Bt; int M, N, K; };

struct StaticOrder {
    int nM, nN, nwg, G, c;
    __host__ __device__ void init(int M, int N, int G_, int c_) { nM = M / BM; nN = N / BM; nwg = nM * nN; G = G_; c = c_; }
    __host__ __device__ bool next(int i, Unit& u) const {
        const long L = (long)i * G + c; if (L >= nwg) return false;
        int wgid = (int)L; { const int q = nwg / NXCD, r = nwg % NXCD, xcd = wgid % NXCD, off = wgid / NXCD; wgid = (xcd < r ? xcd * (q + 1) : r * (q + 1) + (xcd - r) * q) + off; }
        const int nig = WGM * nN, gid = wgid / nig, fm = gid * WGM, gsz = (nM - fm) < WGM ? (nM - fm) : WGM;
        u.pm = fm + ((wgid % nig) % gsz); u.pn = (wgid % nig) / gsz; return true;
    }
    __device__ __forceinline__ void a_ready(const Unit&) const {}
    __device__ __forceinline__ void done(const Unit&) const {}
};

__device__ __forceinline__ unsigned cvt_pk_bf16(float lo, float hi) { unsigned r; asm volatile("v_cvt_pk_bf16_f32 %0, %1, %2" : "=v"(r) : "v"(lo), "v"(hi)); return r; }

struct EpiInProj {
    static constexpr bool PERM = true, AFTER_DRAIN = false;
    bf16_t* O; int ldc; const float* bias; float* gates;
    __device__ __forceinline__ void operator()(const f32x4 (&acc)[2][2][4][2], const Unit& u, int wr, int wc, int fr, int fq) const {
        const int row0 = u.pm * BM + wr * 64 + fr; const int col0 = u.pn * BM + wc * 32 + 8 * fq;
        f32x4 bv[2][2];
#pragma unroll
        for (int bj = 0; bj < 2; ++bj)
#pragma unroll
            for (int n = 0; n < 2; ++n) bv[bj][n] = *(const f32x4*)(bias + col0 + bj * HALF + 4 * n);
        const bool gate_lane = (u.pn == 21) && (wc == 0) && (fq < 2);
#pragma unroll
        for (int ai = 0; ai < 2; ++ai)
#pragma unroll
            for (int m = 0; m < 4; ++m) { const int row = row0 + ai * HALF + m * 16; bf16_t* rowp = O + (size_t)row * ldc + col0;
#pragma unroll
                for (int bj = 0; bj < 2; ++bj) { const f32x4 v0 = acc[ai][bj][m][0] + bv[bj][0], v1 = acc[ai][bj][m][1] + bv[bj][1];
                    u32x4 w; w.x = cvt_pk_bf16(v0[0], v0[1]); w.y = cvt_pk_bf16(v0[2], v0[3]); w.z = cvt_pk_bf16(v1[0], v1[1]); w.w = cvt_pk_bf16(v1[2], v1[3]);
                    *(u32x4*)(rowp + bj * HALF) = w;
                    if (bj == 0 && gate_lane) { float* gp = gates + (size_t)row * 16 + 8 * fq; *(f32x4*)gp = v0; *(f32x4*)(gp + 4) = v1; } } }
    }
};
struct EpiResGate {
    static constexpr bool PERM = false, AFTER_DRAIN = false;
    const float* base; float* out; int ldc; const float* g; int ldg;
    __device__ __forceinline__ void operator()(const f32x4 (&acc)[2][2][4][2], const Unit& u, int wr, int wc, int fr, int fq) const {
        const int col0 = u.pn * BM + wc * 32 + 4 * fq; const int b = (u.pm * BM) >> 12;
        f32x4 gv[2][2];
#pragma unroll
        for (int bj = 0; bj < 2; ++bj)
#pragma unroll
            for (int n = 0; n < 2; ++n) gv[bj][n] = *(const f32x4*)(g + (size_t)b * ldg + col0 + bj * HALF + n * 16);
#pragma unroll
        for (int ai = 0; ai < 2; ++ai) {
            f32x4 bs[4][2][2];
#pragma unroll
            for (int m = 0; m < 4; ++m) { const int r = u.pm * BM + ai * HALF + wr * 64 + m * 16 + fr; const size_t off = (size_t)r * ldc + col0;
#pragma unroll
                for (int bj = 0; bj < 2; ++bj)
#pragma unroll
                    for (int n = 0; n < 2; ++n) bs[m][bj][n] = *(const f32x4*)(base + off + bj * HALF + n * 16); }
#pragma unroll
            for (int m = 0; m < 4; ++m) { const int r = u.pm * BM + ai * HALF + wr * 64 + m * 16 + fr; const size_t off = (size_t)r * ldc + col0;
#pragma unroll
                for (int bj = 0; bj < 2; ++bj)
#pragma unroll
                    for (int n = 0; n < 2; ++n) *(f32x4*)(out + off + bj * HALF + n * 16) = bs[m][bj][n] + gv[bj][n] * acc[ai][bj][m][n]; }
        }
    }
};
struct EpiSwiGLU {
    static constexpr bool PERM = true, AFTER_DRAIN = false;
    bf16_t* O; int ldc;
    __device__ __forceinline__ float silu(float x) const { return x * __builtin_amdgcn_rcpf(1.0f + __expf(-x)); }
    __device__ __forceinline__ void operator()(const f32x4 (&acc)[2][2][4][2], const Unit& u, int wr, int wc, int fr, int fq) const {
        const int row0 = u.pm * BM + wr * 64 + fr; const int col0 = u.pn * HALF + wc * 32 + 8 * fq;
#pragma unroll
        for (int ai = 0; ai < 2; ++ai)
#pragma unroll
            for (int m = 0; m < 4; ++m) { const int row = row0 + ai * HALF + m * 16;
                const f32x4 a0 = acc[ai][0][m][0], a1 = acc[ai][0][m][1], b0 = acc[ai][1][m][0], b1 = acc[ai][1][m][1];
                u32x4 w;
                w.x = cvt_pk_bf16(silu(a0[0]) * b0[0], silu(a0[1]) * b0[1]); w.y = cvt_pk_bf16(silu(a0[2]) * b0[2], silu(a0[3]) * b0[3]);
                w.z = cvt_pk_bf16(silu(a1[0]) * b1[0], silu(a1[1]) * b1[1]); w.w = cvt_pk_bf16(silu(a1[2]) * b1[2], silu(a1[3]) * b1[3]);
                *(u32x4*)(O + (size_t)row * ldc + col0) = w; }
    }
};

template <class Epi, class Sched, bool ALIGN_EPI = false, bool SP2 = false>
__device__ __forceinline__ void gemm_phase(PG8_LAS unsigned char* lds, const Gemm g, const Sched& S, const Epi& E) {
    const int tid = lt(), wid = __builtin_amdgcn_readfirstlane(tid >> 6), lane = tid & 63, wr = wid >> 2, wc = wid & 3, fr = lane & 15, fq = lane >> 4;
    const int K = g.K, nt = K / BK;
    unsigned voffA[2], voffB[2];
#pragma unroll
    for (int i = 0; i < 2; ++i) { int R, C; stage_rc(tid * 16 + i * 8192, R, C); const int Rb = Epi::PERM ? ((R & ~31) + perm32(R & 31)) : R;
        voffA[i] = (unsigned)(R * K + C) * 2u; voffB[i] = (unsigned)(Rb * K + C) * 2u; }
    const size_t kstep = (size_t)(BK * 2);
    const size_t hstep = (size_t)HALF * K * 2;
    const size_t tstep = 2 * hstep;
    const unsigned ldsw = (unsigned)wid * 1024u;
    const int aoff = lds_byte(wr * 64 + fr, fq * 8), boff = lds_byte(wc * 32 + fr, fq * 8);
#define PG8_SA(b, h) (((b) * 2 + (h)) * HTB)
#define PG8_SB(b, h) ((4 + (b) * 2 + (h)) * HTB)
#define PG8_STAGE(bufoff, gbase, voff) do { _Pragma("unroll") for (int _i = 0; _i < 2; ++_i) \
        __builtin_amdgcn_global_load_lds((const unsigned*)((const char*)(gbase) + (voff)[_i]), (PG8_LAS unsigned*)(lds + (bufoff) + ldsw + _i * 8192), 16, 0, 0); } while (0)
#define PG8_LDA(dst, b, h) do { _Pragma("unroll") for (int m = 0; m < 4; ++m) _Pragma("unroll") for (int k = 0; k < 2; ++k) dst[m][k] = *(const PG8_LAS bf16x8*)(lds + PG8_SA(b, h) + aoff + m * 2048 + k * 1024); } while (0)
#define PG8_LDB(dst, b, h) do { _Pragma("unroll") for (int n = 0; n < 2; ++n) _Pragma("unroll") for (int k = 0; k < 2; ++k) dst[n][k] = *(const PG8_LAS bf16x8*)(lds + PG8_SB(b, h) + boff + n * 2048 + k * 1024); } while (0)
#define PG8_MMA(ai, bj, At, Bt) do { __builtin_amdgcn_s_setprio(1); _Pragma("unroll") for (int m = 0; m < 4; ++m) _Pragma("unroll") for (int n = 0; n < 2; ++n) _Pragma("unroll") for (int k = 0; k < 2; ++k) \
        acc[ai][bj][m][n] = __builtin_amdgcn_mfma_f32_16x16x32_bf16(Bt[n][k], At[m][k], acc[ai][bj][m][n], 0, 0, 0); __builtin_amdgcn_s_setprio(0); } while (0)
#define PG8_WAIT_V(n) asm volatile("s_waitcnt vmcnt(" #n ")" ::: "memory")
#define PG8_WAIT_L(n) asm volatile("s_waitcnt lgkmcnt(" #n ")" ::: "memory")
#define PG8_BAR __builtin_amdgcn_s_barrier()
#define PG8_SCHED __builtin_amdgcn_sched_barrier(0)
    Unit cur, nxt; int ui = 0;
    if (!S.next(0, cur)) return;
    f32x4 acc[2][2][4][2];
#pragma unroll
    for (int a = 0; a < 2; ++a)
#pragma unroll
        for (int b = 0; b < 2; ++b)
#pragma unroll
            for (int m = 0; m < 4; ++m)
#pragma unroll
                for (int n = 0; n < 2; ++n) acc[a][b][m][n] = (f32x4){0.f, 0.f, 0.f, 0.f};
    bf16x8 At[4][2], B0[2][2], B1[2][2];
    const char* cA = (const char*)g.A + (size_t)cur.pm * tstep; const char* cB = (const char*)g.Bt + (size_t)cur.pn * tstep;
    S.a_ready(cur);
    if constexpr (SP2) {
        PG8_STAGE(PG8_SB(0, 0), cB, voffB); PG8_STAGE(PG8_SB(0, 1), cB + hstep, voffB); PG8_STAGE(PG8_SA(0, 0), cA, voffA); PG8_STAGE(PG8_SA(0, 1), cA + hstep, voffA);
        if (wr == 1) PG8_BAR;
        PG8_WAIT_V(2); PG8_BAR;
        PG8_STAGE(PG8_SB(1, 0), cB + kstep, voffB); PG8_STAGE(PG8_SA(1, 0), cA + kstep, voffA); PG8_STAGE(PG8_SB(1, 1), cB + hstep + kstep, voffB);
        PG8_WAIT_V(6); PG8_BAR;
    } else {
        PG8_STAGE(PG8_SB(0, 0), cB, voffB); PG8_STAGE(PG8_SA(0, 0), cA, voffA); PG8_STAGE(PG8_SB(0, 1), cB + hstep, voffB); PG8_STAGE(PG8_SA(0, 1), cA + hstep, voffA);
        if (wr == 1) PG8_BAR;
        PG8_WAIT_V(4); PG8_BAR;
        PG8_STAGE(PG8_SB(1, 0), cB + kstep, voffB); PG8_STAGE(PG8_SA(1, 0), cA + kstep, voffA); PG8_STAGE(PG8_SB(1, 1), cB + hstep + kstep, voffB);
        PG8_WAIT_V(6); PG8_BAR;
    }
    for (;;) {
        const bool has_next = S.next(ui + 1, nxt);
        const char* nA = has_next ? (const char*)g.A + (size_t)nxt.pm * tstep : cA; const char* nB = has_next ? (const char*)g.Bt + (size_t)nxt.pn * tstep : cB;
        for (int t = 0; t < nt; t += 2) {
            const bool last = (t == nt - 2);
            const char* a1 = cA + (size_t)(t + 1) * kstep;
            const char* a2 = last ? nA : cA + (size_t)(t + 2) * kstep; const char* b2 = last ? nB : cB + (size_t)(t + 2) * kstep;
            const char* a3 = a2 + kstep; const char* b3 = b2 + kstep;
            if (last && has_next) S.a_ready(nxt);
            if constexpr (SP2) {
            PG8_LDB(B0, 0, 0); PG8_LDB(B1, 0, 1); PG8_SCHED; PG8_LDA(At, 0, 0); PG8_STAGE(PG8_SA(1, 1), a1 + hstep, voffA);
            PG8_WAIT_V(8); PG8_WAIT_L(0); PG8_BAR; PG8_MMA(0, 0, At, B0); PG8_MMA(0, 1, At, B1); PG8_BAR; PG8_SCHED;
            PG8_LDA(At, 0, 1); PG8_STAGE(PG8_SB(0, 0), b2, voffB); PG8_STAGE(PG8_SB(0, 1), b2 + hstep, voffB); PG8_STAGE(PG8_SA(0, 0), a2, voffA);
            PG8_WAIT_V(8); PG8_WAIT_L(0); PG8_BAR; PG8_MMA(1, 0, At, B0); PG8_MMA(1, 1, At, B1); PG8_BAR; PG8_SCHED;
            PG8_LDB(B0, 1, 0); PG8_LDB(B1, 1, 1); PG8_SCHED; PG8_LDA(At, 1, 0); PG8_STAGE(PG8_SA(0, 1), a2 + hstep, voffA);
            PG8_WAIT_V(8); PG8_WAIT_L(0); PG8_BAR; PG8_MMA(0, 0, At, B0); PG8_MMA(0, 1, At, B1); PG8_BAR; PG8_SCHED;
            PG8_LDA(At, 1, 1); PG8_STAGE(PG8_SB(1, 0), b3, voffB); PG8_STAGE(PG8_SB(1, 1), b3 + hstep, voffB); PG8_STAGE(PG8_SA(1, 0), a3, voffA);
            PG8_WAIT_V(8); PG8_WAIT_L(0); PG8_BAR; PG8_MMA(1, 0, At, B0); PG8_MMA(1, 1, At, B1); PG8_BAR; PG8_SCHED;
            } else {
            PG8_LDB(B0, 0, 0); PG8_SCHED; PG8_LDA(At, 0, 0); PG8_STAGE(PG8_SA(1, 1), a1 + hstep, voffA);
            PG8_WAIT_L(8); PG8_BAR; PG8_WAIT_L(0); PG8_MMA(0, 0, At, B0); PG8_BAR; PG8_SCHED;
            PG8_LDB(B1, 0, 1); PG8_STAGE(PG8_SB(0, 0), b2, voffB);
            PG8_BAR; PG8_WAIT_L(0); PG8_MMA(0, 1, At, B1); PG8_BAR;
            PG8_LDA(At, 0, 1); PG8_STAGE(PG8_SA(0, 0), a2, voffA);
            PG8_BAR; PG8_WAIT_L(0); PG8_MMA(1, 0, At, B0); PG8_BAR; PG8_SCHED;
            PG8_STAGE(PG8_SB(0, 1), b2 + hstep, voffB);
            PG8_WAIT_V(6); PG8_BAR; PG8_MMA(1, 1, At, B1); PG8_BAR;
            PG8_LDB(B0, 1, 0); PG8_SCHED; PG8_LDA(At, 1, 0); PG8_STAGE(PG8_SA(0, 1), a2 + hstep, voffA);
            PG8_WAIT_L(8); PG8_BAR; PG8_WAIT_L(0); PG8_MMA(0, 0, At, B0); PG8_BAR; PG8_SCHED;
            PG8_LDB(B1, 1, 1); PG8_STAGE(PG8_SB(1, 0), b3, voffB);
            PG8_BAR; PG8_WAIT_L(0); PG8_MMA(0, 1, At, B1); PG8_BAR;
            PG8_LDA(At, 1, 1); PG8_STAGE(PG8_SA(1, 0), a3, voffA);
            PG8_BAR; PG8_WAIT_L(0); PG8_MMA(1, 0, At, B0); PG8_BAR; PG8_SCHED;
            PG8_STAGE(PG8_SB(1, 1), b3 + hstep, voffB);
            PG8_WAIT_V(6); PG8_BAR; PG8_MMA(1, 1, At, B1); PG8_BAR;
            }
        }
        if constexpr (ALIGN_EPI) { if (wr == 0) PG8_BAR; }
        if constexpr (!Epi::AFTER_DRAIN) { E(acc, cur, wr, wc, fr, fq); S.done(cur); }
        if (!has_next) break;
#pragma unroll
        for (int a = 0; a < 2; ++a)
#pragma unroll
            for (int b = 0; b < 2; ++b)
#pragma unroll
                for (int m = 0; m < 4; ++m)
#pragma unroll
                    for (int n = 0; n < 2; ++n) acc[a][b][m][n] = (f32x4){0.f, 0.f, 0.f, 0.f};
        cur = nxt; cA = nA; cB = nB; ++ui;
        if constexpr (ALIGN_EPI) { if (wr == 1) PG8_BAR; }
    }
    PG8_WAIT_V(0);
    if constexpr (!ALIGN_EPI) { if (wr == 0) PG8_BAR; }
    PG8_BAR;
    if constexpr (Epi::AFTER_DRAIN) { E.fused(acc, cur, wr, wc, fr, fq, lds, wid, lane); S.done(cur); }
#undef PG8_SA
#undef PG8_SB
#undef PG8_STAGE
#undef PG8_LDA
#undef PG8_LDB
#undef PG8_MMA
#undef PG8_WAIT_V
#undef PG8_WAIT_L
#undef PG8_BAR
#undef PG8_SCHED
}
}
namespace attn_body {
using bf16=__hip_bfloat16;
using bf16x8=__attribute__((ext_vector_type(8)))short;
using s16x4=__attribute__((ext_vector_type(4)))short;
using f32x16=__attribute__((ext_vector_type(16)))float;
using u32x4=__attribute__((ext_vector_type(4)))unsigned;
constexpr int BATCH=4,NHEAD=8,SEQ=4096,D=64,QP=512,KP=128,VP=128,OP=2048,GQ=4;
constexpr int NW=8,QBLK=32,QB=QBLK*NW,KVBLK=64,NQB=SEQ/QB;
constexpr int ATTN_UNIT_ROWS=QB;
__device__ __forceinline__ int crow(int r,int hi){return (r&3)+8*(r>>2)+4*hi;}
#define SBAR() __builtin_amdgcn_sched_barrier(0)
__device__ __forceinline__ void cmask(f32x16&p0,f32x16&p1,int jb,int qrel,int hi){
  const float NEG=-INFINITY; int kb=64*jb+4*hi;
  #pragma unroll
  for(int r=0;r<16;++r){int kv=kb+(r&3)+8*(r>>2); if(kv>qrel)p0[r]=NEG; if(kv+32>qrel)p1[r]=NEG;}
}

constexpr int NSLOT=3, SLOTB=8192;
constexpr int LDS_K=0, LDS_V=NSLOT*SLOTB, LDS_WS=2*NSLOT*SLOTB, LDS_OST=LDS_WS+NW*64*4, LDS_BYTES=LDS_OST+NW*4096;
constexpr float C2=0.125f*1.4426950408889634f;
__device__ __forceinline__ void glds16(const void*gsrc,unsigned lds_dst){unsigned keep;
  asm volatile("s_mov_b32 %0, m0\n\ts_mov_b32 m0, %2\n\ts_nop 0\n\tglobal_load_lds_dwordx4 %1, off\n\ts_mov_b32 m0, %0":"=&s"(keep):"v"(gsrc),"s"(lds_dst):"memory");}
__device__ __forceinline__ float max3f(float a,float b,float c){float r;asm("v_max3_f32 %0, %1, %2, %3":"=v"(r):"v"(a),"v"(b),"v"(c));return r;}
__device__ __forceinline__ float max2f(float a,float b){float r;asm("v_max_f32_e32 %0, %1, %2":"=v"(r):"v"(a),"v"(b));return r;}
__device__ __forceinline__ float fadd_s(float a,float b){float r;asm("v_add_f32_e32 %0, %1, %2":"=v"(r):"v"(a),"v"(b));return r;}
__device__ __forceinline__ float fsub_s(float a,float b){float r;asm("v_sub_f32_e32 %0, %1, %2":"=v"(r):"v"(a),"v"(b));return r;}
typedef float f32x2_t __attribute__((ext_vector_type(2))); typedef __bf16 bf16x2_t __attribute__((ext_vector_type(2)));
__device__ __forceinline__ unsigned cvtpk_s(float lo,float hi){f32x2_t v={lo,hi};bf16x2_t b=__builtin_convertvector(v,bf16x2_t);return __builtin_bit_cast(unsigned,b);}
#define WAIT_BAR(N) asm volatile("s_waitcnt vmcnt(" #N ") lgkmcnt(0)\n\ts_barrier":::"memory")

__device__ __forceinline__ void qkt(f32x16&p0,f32x16&p1,const char*Kslot,const bf16x8*qr,const f32x16&negm,int r32,int hi){
  const char*kb=Kslot+hi*1024+r32*16;
  #pragma unroll
  for(int d0=0;d0<4;++d0){
    const bf16x8 b0=*reinterpret_cast<const bf16x8*>(kb+d0*2048);
    const bf16x8 b1=*reinterpret_cast<const bf16x8*>(kb+d0*2048+512);
    if(d0==0){p0=__builtin_amdgcn_mfma_f32_32x32x16_bf16(b0,qr[0],negm,0,0,0);p1=__builtin_amdgcn_mfma_f32_32x32x16_bf16(b1,qr[0],negm,0,0,0);}
    else{p0=__builtin_amdgcn_mfma_f32_32x32x16_bf16(b0,qr[d0],p0,0,0,0);p1=__builtin_amdgcn_mfma_f32_32x32x16_bf16(b1,qr[d0],p1,0,0,0);}}
}
typedef __attribute__((address_space(3))) const char* lds_cptr;
typedef short v4i16_t __attribute__((ext_vector_type(4)));
__device__ __forceinline__ void kload8(bf16x8*kf,lds_cptr kp){
  kf[0]=*(const __attribute__((address_space(3))) bf16x8*)(kp);      kf[1]=*(const __attribute__((address_space(3))) bf16x8*)(kp+512);
  kf[2]=*(const __attribute__((address_space(3))) bf16x8*)(kp+2048); kf[3]=*(const __attribute__((address_space(3))) bf16x8*)(kp+2560);
  kf[4]=*(const __attribute__((address_space(3))) bf16x8*)(kp+4096); kf[5]=*(const __attribute__((address_space(3))) bf16x8*)(kp+4608);
  kf[6]=*(const __attribute__((address_space(3))) bf16x8*)(kp+6144); kf[7]=*(const __attribute__((address_space(3))) bf16x8*)(kp+6656);
}
__device__ __forceinline__ void kload2(bf16x8*kf,lds_cptr kp,int j){ kf[2*j]=*(const __attribute__((address_space(3))) bf16x8*)(kp+j*2048); kf[2*j+1]=*(const __attribute__((address_space(3))) bf16x8*)(kp+j*2048+512); }
__device__ __forceinline__ s16x4 vtr(lds_cptr p){ return __builtin_bit_cast(s16x4,__builtin_amdgcn_ds_read_tr16_b64_v4i16((__attribute__((address_space(3))) v4i16_t*)p)); }
__device__ __forceinline__ float rowmax(const f32x16&p0,const f32x16&p1){
  float a=max3f(p0[0],p0[1],p1[0]),b=max3f(p0[2],p0[3],p1[1]);a=max3f(a,p1[2],p1[3]);
  #pragma unroll
  for(int r=4;r<16;r+=4){a=max3f(a,p0[r],p0[r+1]);b=max3f(b,p0[r+2],p0[r+3]);a=max3f(a,p1[r],p1[r+1]);b=max3f(b,p1[r+2],p1[r+3]);}
  const float m=max2f(a,b);
  auto rr=__builtin_amdgcn_permlane32_swap(__float_as_uint(m),__float_as_uint(m),false,false);
  return max2f(__uint_as_float(rr[0]),__uint_as_float(rr[1]));
}
__device__ __forceinline__ void pv(f32x16*o,int vb,bf16x8 pa0,bf16x8 pa1,bf16x8 pa2,bf16x8 pa3){
  #pragma unroll
  for(int d0=0;d0<2;++d0){s16x4 lo[4],hi[4];
    #pragma unroll
    for(int ks=0;ks<4;++ks){
      asm volatile("ds_read_b64_tr_b16 %0,%1 offset:%c2":"=&v"(lo[ks]):"v"(vb),"i"(d0*4096+ks*1024):"memory");
      asm volatile("ds_read_b64_tr_b16 %0,%1 offset:%c2":"=&v"(hi[ks]):"v"(vb),"i"(d0*4096+ks*1024+512):"memory");}
    asm volatile("s_waitcnt lgkmcnt(0)":::"memory");SBAR();
    #define PK(k) (bf16x8){lo[k][0],lo[k][1],lo[k][2],lo[k][3],hi[k][0],hi[k][1],hi[k][2],hi[k][3]}
    o[d0]=__builtin_amdgcn_mfma_f32_32x32x16_bf16(pa0,PK(0),o[d0],0,0,0);
    o[d0]=__builtin_amdgcn_mfma_f32_32x32x16_bf16(pa1,PK(1),o[d0],0,0,0);
    o[d0]=__builtin_amdgcn_mfma_f32_32x32x16_bf16(pa2,PK(2),o[d0],0,0,0);
    o[d0]=__builtin_amdgcn_mfma_f32_32x32x16_bf16(pa3,PK(3),o[d0],0,0,0);
    #undef PK
  }
}

#ifndef ATTN_STORE16
#define ATTN_STORE16(p,v) (*(u32x4*)(p)=(v))
#endif
template<int THRL> __device__ __forceinline__ void attn_unit(int b,int h,int qb,const bf16*Q,const bf16*__restrict__ K,const bf16*__restrict__ V,bf16*O,char*shm){
  const int tid=lt(),lane=tid&63,r32=lane&31,hi=lane>>5; const int wid=__builtin_amdgcn_readfirstlane(tid>>6);
  const long rowbase=(long)b*SEQ; const int q0=qb*QB;
  const bf16*Qw=Q+(rowbase+q0+wid*QBLK)*QP+h*D;
  const bf16*Kh=K+rowbase*KP+(h/GQ)*D,*Vh=V+rowbase*VP+(h/GQ)*D;
  const unsigned lds0=(unsigned)(uintptr_t)shm;
  float*wsf=(float*)(shm+LDS_WS)+wid*64;
  const bf16*ksrc=Kh+(long)lane*KP+wid*8;
  const bf16*vsrc=Vh+(long)(16*(wid&3)+(lane>>2))*VP+(wid>>2)*32+(lane&3)*8;
  const unsigned kdst=lds0+LDS_K+wid*1024, vdst=lds0+LDS_V+wid*1024;
  #define DMA_K(t,slot) glds16(ksrc+(long)(t)*KVBLK*KP,(unsigned)__builtin_amdgcn_readfirstlane(kdst+(slot)))
  #define DMA_V(t,slot) glds16(vsrc+(long)(t)*KVBLK*VP,(unsigned)__builtin_amdgcn_readfirstlane(vdst+(slot)))
  const int vb0=(int)(lds0+LDS_V)+((lane>>4)&1)*32+(lane&3)*8+(4*hi+((lane&15)>>2))*64;
  const char*Kbase=shm+LDS_K; bf16x8 kf[8];
  const lds_cptr shm3=(lds_cptr)shm; const lds_cptr kp0=shm3+LDS_K+hi*1024+r32*16; const lds_cptr vp0=shm3+LDS_V+((lane>>4)&1)*32+(lane&3)*8+(4*hi+((lane&15)>>2))*64;
  const int NT=SEQ/KVBLK;
  DMA_K(0,0);DMA_V(0,0);DMA_K(1,SLOTB);
  bf16x8 qr[4];
  #pragma unroll
  for(int d0=0;d0<4;++d0)qr[d0]=*reinterpret_cast<const bf16x8*>(&Qw[(long)r32*QP+d0*16+hi*8]);
  float mhat=0.f,l_reg=0.f;f32x16 o[2];o[0]=f32x16{};o[1]=f32x16{};f32x16 negm=f32x16{};asm volatile("":"+v"(negm));
  const int qrel=wid*QBLK+r32;
  #define CMASK(P0,P1,t) do{}while(0)
  bool resc=false;
  #define START(P0,P1) do{ const float rm=rowmax(P0,P1); resc=false; \
    { const float dl=rm; mhat=fadd_s(mhat,dl); \
      _Pragma("unroll") for(int r=0;r<16;++r){P0[r]=fsub_s(P0[r],dl);P1[r]=fsub_s(P1[r],dl);} \
      _Pragma("unroll") for(int r=0;r<16;++r)negm[r]=-mhat; asm volatile("":"+v"(negm)); } \
    _Pragma("unroll") for(int r=0;r<16;++r)P0[r]=__builtin_amdgcn_exp2f(P0[r]); }while(0)
  #define RESC() do{ if(resc){ asm volatile("s_waitcnt lgkmcnt(0)":::"memory"); \
      _Pragma("unroll") for(int d_=0;d_<2;++d_) _Pragma("unroll") for(int r=0;r<16;++r)o[d_][r]*=wsf[crow(r,hi)]; } }while(0)
  f32x16 pA0,pA1,pB0,pB1;
  int sl_prev=0,sl_cur=0,sl_next=SLOTB;
  #define ROT() do{sl_prev=sl_cur;sl_cur=sl_next;sl_next=(sl_next==(NSLOT-1)*SLOTB)?0:sl_next+SLOTB;}while(0)
  DMA_K(2,2*SLOTB);
  WAIT_BAR(3);
  qkt(pA0,pA1,Kbase,qr,negm,r32,hi);asm volatile("s_nop 15\n\ts_nop 7":"+v"(pA0),"+v"(pA1));CMASK(pA0,pA1,0);
  START(pA0,pA1);
  _Pragma("unroll") for(int r=0;r<16;++r)pA1[r]=__builtin_amdgcn_exp2f(pA1[r]);
  WAIT_BAR(0);
  DMA_K(3,0);DMA_V(1,SLOTB);
  ROT();
  kload8(kf,kp0+sl_cur);
  WAIT_BAR(2);
  s16x4 vlo[8],vhi[8]; u32x4 pw0,pw1,pw2,pw3;
  #define PKW(P,B) cvtpk_s(P[B],P[B+1])
  #define PAF(k) __builtin_bit_cast(bf16x8,pw##k)
  #define VFR(i) (bf16x8){vlo[i][0],vlo[i][1],vlo[i][2],vlo[i][3],vhi[i][0],vhi[i][1],vhi[i][2],vhi[i][3]}
  #define PIN(x) asm volatile("":"+v"(x))
  #define MX3(a,b,c) __builtin_fmaxf(__builtin_fmaxf((a),(b)),(c))
  #define GAPA(MF,A0,A1,A2,A3,W0,W1,PW) do{ MF; sacc+=A0; sacc+=A1; sacc+=A2; sacc+=A3; PIN(sacc); W0; W1; PIN(PW); SBAR(); }while(0)
  #define EX(v) __builtin_amdgcn_exp2f(v)
  #define GAPB(MF,X,B) do{ MF; X[B]=EX(X[B]); X[B+1]=EX(X[B+1]); X[B+2]=EX(X[B+2]); X[B+3]=EX(X[B+3]); PIN(X); SBAR(); }while(0)
  #define VRD(i) do{ vlo[i]=vtr(vp_+(((i)>>2)*4096+((i)&3)*1024)); vhi[i]=vtr(vp_+(((i)>>2)*4096+((i)&3)*1024+512)); }while(0)
  #define KRD(G,j) do{ if(G){ kload2(kf,kp0+sl_next,j); SBAR(); } }while(0)
  #define STEP(C0,C1,P0,P1,t,GK,GV,GL) do{ SBAR(); \
    const lds_cptr vp_=vp0+sl_prev; \
    VRD(0); SBAR(); float sacc=(P0[0]+P0[1]); \
    GAPA(C0=__builtin_amdgcn_mfma_f32_32x32x16_bf16(kf[0],qr[0],negm,0,0,0), P0[2],P0[3],P0[4],P0[5],     pw0[0]=PKW(P0,0), pw0[1]=PKW(P0,2), pw0); \
    VRD(4); SBAR(); GAPA(C1=__builtin_amdgcn_mfma_f32_32x32x16_bf16(kf[1],qr[0],negm,0,0,0), P0[6],P0[7],P0[8],P0[9],     pw0[2]=PKW(P0,4), pw0[3]=PKW(P0,6), pw0); \
    VRD(1); SBAR(); GAPA(C0=__builtin_amdgcn_mfma_f32_32x32x16_bf16(kf[2],qr[1],C0,0,0,0),   P0[10],P0[11],P0[12],P0[13], pw1[0]=PKW(P0,8), pw1[1]=PKW(P0,10), pw1); \
    VRD(5); SBAR(); GAPA(C1=__builtin_amdgcn_mfma_f32_32x32x16_bf16(kf[3],qr[1],C1,0,0,0),   P0[14],P0[15],P1[0],P1[1],   pw1[2]=PKW(P0,12),pw1[3]=PKW(P0,14), pw1); \
    VRD(2); SBAR(); GAPA(C0=__builtin_amdgcn_mfma_f32_32x32x16_bf16(kf[4],qr[2],C0,0,0,0),   P1[2],P1[3],P1[4],P1[5],     pw2[0]=PKW(P1,0), pw2[1]=PKW(P1,2), pw2); \
    VRD(6); SBAR(); GAPA(C1=__builtin_amdgcn_mfma_f32_32x32x16_bf16(kf[5],qr[2],C1,0,0,0),   P1[6],P1[7],P1[8],P1[9],     pw2[2]=PKW(P1,4), pw2[3]=PKW(P1,6), pw2); \
    VRD(3); SBAR(); GAPA(C0=__builtin_amdgcn_mfma_f32_32x32x16_bf16(kf[6],qr[3],C0,0,0,0),   P1[10],P1[11],P1[12],P1[13], pw3[0]=PKW(P1,8), pw3[1]=PKW(P1,10), pw3); \
    VRD(7); SBAR(); GAPA(C1=__builtin_amdgcn_mfma_f32_32x32x16_bf16(kf[7],qr[3],C1,0,0,0),   P1[14],P1[15],0.f,0.f,       pw3[2]=PKW(P1,12),pw3[3]=PKW(P1,14), pw3); \
    l_reg+=sacc; \
    if(GK){DMA_K((t)+3,sl_cur);} if(GV){DMA_V((t)+1,sl_next);} \
    CMASK(C0,C1,t); \
    { float a=MX3(C0[0],C0[1],C1[0]),b=MX3(C0[2],C0[3],C1[1]); a=MX3(a,C1[2],C1[3]); \
      _Pragma("unroll") for(int r=4;r<16;r+=4){a=MX3(a,C0[r],C0[r+1]);b=MX3(b,C0[r+2],C0[r+3]);a=MX3(a,C1[r],C1[r+1]);b=MX3(b,C1[r+2],C1[r+3]);} \
      float rm=__builtin_fmaxf(a,b); { auto rr=__builtin_amdgcn_permlane32_swap(__float_as_uint(rm),__float_as_uint(rm),false,false); rm=__builtin_fmaxf(__uint_as_float(rr[0]),__uint_as_float(rr[1])); } \
      resc=false; \
      if(__builtin_expect(__any(rm>(float)THRL),0)){ const float dl=__builtin_fmaxf(rm,0.f); mhat+=dl; \
        _Pragma("unroll") for(int r=0;r<16;++r){C0[r]-=dl;C1[r]-=dl;} \
        _Pragma("unroll") for(int r=0;r<16;++r)negm[r]=-mhat; asm volatile("":"+v"(negm)); \
        const float f=__builtin_amdgcn_exp2f(-dl); l_reg*=f; if(hi==0)wsf[r32]=f; resc=true; } } \
    SBAR(); \
    GAPB(o[0]=__builtin_amdgcn_mfma_f32_32x32x16_bf16(PAF(0),VFR(0),o[0],0,0,0), C0,0); \
    GAPB(o[1]=__builtin_amdgcn_mfma_f32_32x32x16_bf16(PAF(0),VFR(4),o[1],0,0,0), C0,4); \
    KRD(GL,0); GAPB(o[0]=__builtin_amdgcn_mfma_f32_32x32x16_bf16(PAF(1),VFR(1),o[0],0,0,0), C0,8); \
    KRD(GL,1); GAPB(o[1]=__builtin_amdgcn_mfma_f32_32x32x16_bf16(PAF(1),VFR(5),o[1],0,0,0), C0,12); \
    KRD(GL,2); GAPB(o[0]=__builtin_amdgcn_mfma_f32_32x32x16_bf16(PAF(2),VFR(2),o[0],0,0,0), C1,0); \
    KRD(GL,3); GAPB(o[1]=__builtin_amdgcn_mfma_f32_32x32x16_bf16(PAF(2),VFR(6),o[1],0,0,0), C1,4); \
    GAPB(o[0]=__builtin_amdgcn_mfma_f32_32x32x16_bf16(PAF(3),VFR(3),o[0],0,0,0), C1,8); \
    GAPB(o[1]=__builtin_amdgcn_mfma_f32_32x32x16_bf16(PAF(3),VFR(7),o[1],0,0,0), C1,12); \
    }while(0)
  int t=1;
  #undef CMASK
  #define CMASK(P0,P1,t) do{}while(0)
  for(;t+5<NT;t+=2){
    STEP(pB0,pB1,pA0,pA1,t,true,true,true);     WAIT_BAR(2); RESC(); ROT();
    STEP(pA0,pA1,pB0,pB1,t+1,true,true,true);   WAIT_BAR(2); RESC(); ROT();
  }
  #undef CMASK
  #define CMASK(P0,P1,t) do{}while(0)
  #define ENDW(tt) do{ if((tt)+3<NT){WAIT_BAR(2);} else if((tt)+2<NT){WAIT_BAR(1);} else {WAIT_BAR(0);} }while(0)
  for(;t+1<NT;t+=2){
    STEP(pB0,pB1,pA0,pA1,t,(t+3<NT),(t+1<NT),(t+1<NT));       ENDW(t);   RESC(); ROT();
    STEP(pA0,pA1,pB0,pB1,t+1,(t+4<NT),(t+2<NT),(t+2<NT));     ENDW(t+1); RESC(); ROT();
  }
  STEP(pB0,pB1,pA0,pA1,NT-1,false,false,false); RESC();
  { float sacc=pB0[0]+pB0[1]; _Pragma("unroll") for(int r=2;r<16;++r)sacc+=pB0[r]; _Pragma("unroll") for(int r=0;r<16;++r)sacc+=pB1[r]; l_reg+=sacc;
    pw0=(u32x4){PKW(pB0,0),PKW(pB0,2),PKW(pB0,4),PKW(pB0,6)};pw1=(u32x4){PKW(pB0,8),PKW(pB0,10),PKW(pB0,12),PKW(pB0,14)};pw2=(u32x4){PKW(pB1,0),PKW(pB1,2),PKW(pB1,4),PKW(pB1,6)};pw3=(u32x4){PKW(pB1,8),PKW(pB1,10),PKW(pB1,12),PKW(pB1,14)};
    SBAR(); pv(o,vb0+sl_cur,PAF(0),PAF(1),PAF(2),PAF(3)); }
  #undef PKW
  #undef PAF
  #undef VFR
  #undef PIN
  #undef MX3
  #undef GAPA
  #undef GAPB
  #undef EX
  #undef VRD
  #undef KRD
  #undef STEP
  #undef ENDW
  {auto rr=__builtin_amdgcn_permlane32_swap(__float_as_uint(l_reg),__float_as_uint(l_reg),false,false);l_reg=__uint_as_float(rr[0])+__uint_as_float(rr[1]);}
  if(hi==0)wsf[32+r32]=l_reg;asm volatile("s_waitcnt lgkmcnt(0)":::"memory");
  float rli[16];
  #pragma unroll
  for(int r=0;r<16;++r)rli[r]=__builtin_amdgcn_rcpf(wsf[32+crow(r,hi)]);
  bf16*Ow=O+(rowbase+q0+wid*QBLK)*OP+h*D;
  { bf16*stg=(bf16*)(shm+LDS_OST)+wid*2048;
    #pragma unroll
    for(int r=0;r<16;++r){const int orow=crow(r,hi);
      #pragma unroll
      for(int d0=0;d0<2;++d0)stg[orow*64+d0*32+r32]=__float2bfloat16(o[d0][r]*rli[r]);}
    asm volatile("s_waitcnt lgkmcnt(0)":::"memory");
    #pragma unroll
    for(int i=0;i<4;++i){const int row=i*8+(lane>>3),ch=lane&7; const u32x4 v=*(const u32x4*)(stg+row*64+ch*8); ATTN_STORE16(Ow+(long)row*OP+ch*8,v);} }
  asm volatile("s_waitcnt lgkmcnt(0)\n\ts_barrier":::"memory");
  #undef DMA_K
  #undef DMA_V
  #undef CMASK
  #undef START
  #undef RESC
  #undef ROT
}
#undef SBAR
#undef WAIT_BAR
}
#ifndef MK_PROBE
#define MK_PROBE 0
#endif
#ifndef MK_PTYPE
#define MK_PTYPE 0xff
#endif

struct Args { const float* in[33]; float* out; unsigned char* ws; int ph_lo, ph_hi; };
enum { I_X = 0, I_C, I_WIN, I_BIN, I_WOUT, I_NMG, I_NFG, I_ADAW, I_ADAB, I_LCW, I_LCB, I_LWA, I_LBA, I_LWX, I_LBX, I_LLAM, I_QG, I_KG,
       I_HCW, I_HCB, I_HW1, I_HB1, I_HW2, I_HB2, I_HW3, I_HSF, I_HDEC, I_HSKIP, I_MLG, I_F1, I_F3, I_F2, I_FG };

struct Frame {
    unsigned char* lds; unsigned char* ws; const float* const* in; float* out;
    int tid, lane, wave, G;
};
#define MFMA32(a, b, c) __builtin_amdgcn_mfma_f32_32x32x16_bf16((a), (b), (c), 0, 0, 0)
#define MFMA16(a, b, c) __builtin_amdgcn_mfma_f32_16x16x32_bf16((a), (b), (c), 0, 0, 0)

__device__ __forceinline__ int next_item(unsigned* ctr, unsigned char* lds) {
    volatile unsigned* slot = (volatile unsigned*)(lds + SLOT_OFF);
    __syncthreads();
    if (threadIdx.x == 0) *slot = atomicAdd(ctr, 1u);
    __syncthreads();
    return (int)*slot;
}

__device__ __forceinline__ void transpose_item(const float* W, int K, int N, bf16* WT, int mode, float* scr, int item, int lane) {
    const int nblk = (N + 63) / 64, kb = item / nblk, nb = item % nblk, k0 = 64 * kb, n0 = 64 * nb;
    const int nl0 = 4 * (lane & 15); const bool nok = (n0 + nl0) < N;
    f32x4 v[16];
#pragma unroll
    for (int i = 0; i < 16; ++i) { const int kk = 4 * i + (lane >> 4); v[i] = nok ? *(const f32x4*)(W + (size_t)(k0 + kk) * N + n0 + nl0) : (f32x4){0.f, 0.f, 0.f, 0.f}; }
#pragma unroll
    for (int i = 0; i < 16; ++i) { const int kk = 4 * i + (lane >> 4); float* d = scr + kk * 65 + nl0; d[0] = v[i].x; d[1] = v[i].y; d[2] = v[i].z; d[3] = v[i].w; }
    LDS_WAIT();
    const int c = lane & 7;
#pragma unroll
    for (int j = 0; j < 8; ++j) { const int nl = (lane >> 3) + 8 * j; const int n = n0 + nl; const float* sp = scr + (8 * c) * 65 + nl;
        u32x4 o; o.x = pk2(sp[0 * 65], sp[1 * 65]); o.y = pk2(sp[2 * 65], sp[3 * 65]); o.z = pk2(sp[4 * 65], sp[5 * 65]); o.w = pk2(sp[6 * 65], sp[7 * 65]);
        const int dr = (mode == 0) ? n : ((n >> 7) * 256 + (n & 127) + (mode == 2 ? 128 : 0));
        if (n < N) *(u32x4*)(WT + (size_t)dr * K + k0 + 8 * c) = o; }
    LDS_WAIT();
}

__device__ __forceinline__ void p0_prologue(Frame& F) {
    const int tid = F.tid, lane = F.lane, wave = F.wave;
    const long gt = (long)blockIdx.x * 512 + tid, GT = (long)F.G * 512;
    {
        float* ca = (float*)F.lds;
        float* part = (float*)(F.lds + 32768);
        bool have = false;
        for (int it = blockIdx.x; it < 192; it += F.G) {
            if (!have) { for (int i = tid; i < 8192; i += 512) { const float c = F.in[I_C][i]; ca[i] = c * sigmoidf_(c); } have = true; }
            __syncthreads();
            const int layer = it / 96, col0 = (it % 96) * 128;
            const float* W = F.in[I_ADAW] + (size_t)layer * 2048 * 12288 + col0 + 2 * lane;
            float a00 = 0, a01 = 0, a10 = 0, a11 = 0, a20 = 0, a21 = 0, a30 = 0, a31 = 0;
            const int kb = wave * 256;
#pragma unroll 16
            for (int k = kb; k < kb + 256; ++k) { const f32x2 w = *(const f32x2*)(W + (size_t)k * 12288);
                const float c0 = ca[k], c1 = ca[2048 + k], c2 = ca[4096 + k], c3 = ca[6144 + k];
                a00 += c0 * w.x; a01 += c0 * w.y; a10 += c1 * w.x; a11 += c1 * w.y; a20 += c2 * w.x; a21 += c2 * w.y; a30 += c3 * w.x; a31 += c3 * w.y; }
            float* pp = part + (wave * 4) * 128 + 2 * lane;
            pp[0] = a00; pp[1] = a01; pp[128] = a10; pp[129] = a11; pp[256] = a20; pp[257] = a21; pp[384] = a30; pp[385] = a31;
            __syncthreads();
            { const int b = tid >> 7, col = tid & 127; float s = F.in[I_ADAB][layer * 12288 + col0 + col];
#pragma unroll
              for (int w = 0; w < 8; ++w) s += part[(w * 4 + b) * 128 + col];
              ((float*)(F.ws + WS_MOD))[(layer * 4 + b) * 12288 + col0 + col] = s; }
        }
        __syncthreads();
    }
    {
        bf16* lw = (bf16*)(F.ws + WS_LRUW);
        for (long e = gt; e < 262144; e += GT) { const int k = e & 63, j = (e >> 6) & 63, gate = (e >> 12) & 1, blk = (e >> 13) & 7, dir = (e >> 16) & 1, l = (int)(e >> 17);
            const float* src = gate ? F.in[I_LWX] : F.in[I_LWA];
            lw[e] = (bf16)f2bf(src[((((size_t)(l * 2 + dir) * 8 + blk) * 64 + k) * 64) + j]); }
        float* bp = (float*)(F.ws + WS_BINP);
        for (long e = gt; e < 2 * DINP; e += GT) { const int l = (int)(e / DINP), n = (int)(e % DINP); bp[e] = n < DIN ? F.in[I_BIN][l * DIN + n] : 0.f; }
        for (long e = gt; e < 2L * 240 * 256; e += GT) { const int l = (int)(e / (240 * 256)); const long r = e % (240 * 256);
            *(u32x4*)(F.ws + WS_WIN + (size_t)l * DINP * DM * 2 + (size_t)DIN * DM * 2 + r * 16) = (u32x4){0u, 0u, 0u, 0u}; }
    }
    {
        float* feat = (float*)F.lds; float* h1 = (float*)(F.lds + 2048); float* h2 = (float*)(F.lds + 6144); float* w1s = (float*)(F.lds + 10240); float* w2s = (float*)(F.lds + 14848);
        for (int it = blockIdx.x; it < 512; it += F.G) {
            const int l = it >> 8, pb = it & 255;
            __syncthreads();
            for (int i = tid; i < 17 * 64; i += 512) w1s[i] = F.in[I_HW1][l * 17 * 64 + i];
#pragma unroll
            for (int i = 0; i < 8; ++i) w2s[tid + 512 * i] = F.in[I_HW2][l * 4096 + tid + 512 * i];
            if (tid < 272) { const int p = tid / 17, f = tid % 17; const float pos = (float)(16 * pb + p); float val;
                if (f == 0) val = pos / 4095.0f;
                else { const int bi = (f - 1) & 7; const float band = 1e-4f + (float)bi * ((7.0f - 1e-4f) / 7.0f); const float ang = (6.283185307179586f * pos / 4096.0f) * band;
                       val = (f <= 8) ? cos_rad(ang) : -sin_rad(ang); }
                feat[p * 17 + f] = val; }
            __syncthreads();
            for (int idx = tid; idx < 1024; idx += 512) { const int p = idx >> 6, j = idx & 63; float s = F.in[I_HB1][l * 64 + j];
#pragma unroll
                for (int f = 0; f < 17; ++f) s += feat[p * 17 + f] * w1s[f * 64 + j];
                h1[idx] = sin_rad(F.in[I_HSF][l * 64 + j] * s); }
            __syncthreads();
            for (int idx = tid; idx < 1024; idx += 512) { const int p = idx >> 6, j = idx & 63; float s = F.in[I_HB2][l * 64 + j];
#pragma unroll 16
                for (int i = 0; i < 64; ++i) s += h1[p * 64 + i] * w2s[i * 64 + j];
                h2[idx] = sin_rad(F.in[I_HSF][l * 64 + j] * s); }
            __syncthreads();
            float acc[4][16];
#pragma unroll
            for (int q = 0; q < 4; ++q)
#pragma unroll
                for (int p = 0; p < 16; ++p) acc[q][p] = 0.f;
            const float* w3 = F.in[I_HW3] + (size_t)l * 64 * 2048 + tid;
#pragma unroll 8
            for (int i = 0; i < 64; ++i) { const float w0 = w3[i * 2048], w1 = w3[i * 2048 + 512], w2 = w3[i * 2048 + 1024], w3v = w3[i * 2048 + 1536];
#pragma unroll
                for (int p = 0; p < 16; ++p) { const float hv = h2[p * 64 + i]; acc[0][p] += hv * w0; acc[1][p] += hv * w1; acc[2][p] += hv * w2; acc[3][p] += hv * w3v; } }
#pragma unroll
            for (int q = 0; q < 4; ++q) { const int j = tid + 512 * q; const int o = j >> 10, dir = (j >> 9) & 1, wch = j & 511;
                const float dec = fabsf(F.in[I_HDEC][l * 2048 + j]);
                bf16* base = (bf16*)(F.ws + WS_HYFT) + ((size_t)((l * 2 + o) * 512 + wch)) * 8192;
                float ss = 0.f; float vv[16];
#pragma unroll
                for (int p = 0; p < 16; ++p) { const int pos = 16 * pb + p; const float t = (float)pos / 4095.0f; vv[p] = acc[q][p] * __expf(-t * dec); ss += vv[p] * vv[p]; }
                if (dir == 0) { bf16* fp = base + 4080 - 16 * pb;
                    *(u32x4*)fp = (u32x4){pk2(vv[15], vv[14]), pk2(vv[13], vv[12]), pk2(vv[11], vv[10]), pk2(vv[9], vv[8])};
                    *(u32x4*)(fp + 8) = (u32x4){pk2(vv[7], vv[6]), pk2(vv[5], vv[4]), pk2(vv[3], vv[2]), pk2(vv[1], vv[0])}; }
                else { bf16* bp = base + 4095 + 16 * pb;
                    if (pb > 0) bp[0] = (bf16)f2bf(vv[0]);
                    *(u32x4*)(bp + 1) = (u32x4){pk2(vv[1], vv[2]), pk2(vv[3], vv[4]), pk2(vv[5], vv[6]), pk2(vv[7], vv[8])};
                    *(u32x2*)(bp + 9) = (u32x2){pk2(vv[9], vv[10]), pk2(vv[11], vv[12])};
                    *(unsigned*)(bp + 13) = pk2(vv[13], vv[14]);
                    bp[15] = (bf16)f2bf(vv[15]);
                    if (pb == 0) base[8191] = 0; }
                ((float*)(F.ws + WS_HYPART))[(size_t)(l * 256 + pb) * 2048 + j] = ss; }
        }
        __syncthreads();
    }
    {
        float* scr = (float*)(F.lds + wave * 16640);
        unsigned* tctr = (unsigned*)(F.ws + WS_CTL) + 64 * 30;
        constexpr int I_IN = 32 * 85, I_OUT = 32 * 32, I_W1 = 32 * 88, I_W2 = 88 * 32, PER_L = I_IN + I_OUT + 2 * I_W1 + I_W2;
        for (;;) {
            unsigned base = 0u; if (lane == 0) base = atomicAdd(tctr, 4u);
            base = (unsigned)__builtin_amdgcn_readfirstlane((int)base);
            if (base >= (unsigned)(2 * PER_L)) break;
#pragma unroll 1
            for (int q = 0; q < 4; ++q) { const int it = (int)base + q; if (it >= 2 * PER_L) break;
                const int l = it / PER_L; int r = it % PER_L;
                if (r < I_IN) { transpose_item(F.in[I_WIN] + (size_t)l * DM * DIN, DM, DIN, (bf16*)(F.ws + WS_WIN) + (size_t)l * DINP * DM, 0, scr, r, lane); continue; } r -= I_IN;
                if (r < I_OUT) { transpose_item(F.in[I_WOUT] + (size_t)l * DM * DM, DM, DM, (bf16*)(F.ws + WS_WOUT) + (size_t)l * DM * DM, 0, scr, r, lane); continue; } r -= I_OUT;
                if (r < I_W1) { transpose_item(F.in[I_F1] + (size_t)l * DM * DFF, DM, DFF, (bf16*)(F.ws + WS_W13) + (size_t)l * 2 * DFF * DM, 1, scr, r, lane); continue; } r -= I_W1;
                if (r < I_W1) { transpose_item(F.in[I_F3] + (size_t)l * DM * DFF, DM, DFF, (bf16*)(F.ws + WS_W13) + (size_t)l * 2 * DFF * DM, 2, scr, r, lane); continue; } r -= I_W1;
                transpose_item(F.in[I_F2] + (size_t)l * DFF * DM, DFF, DM, (bf16*)(F.ws + WS_W2) + (size_t)l * DM * DFF, 0, scr, r, lane); }
        }
    }
}

__device__ __forceinline__ void norm_phase(Frame& F, const float* xin, const float* g, const float* sh, const float* sc, bf16* xn) {
    const int gw = blockIdx.x * 8 + F.wave, NGW = F.G * 8, lane = F.lane;
    for (int m = gw; m < MTOK; m += NGW) {
        const int b = m >> 12;
        const f32x4* xr = (const f32x4*)(xin + (size_t)m * DM) + lane;
        f32x4 v[8]; float ss = 0.f;
#pragma unroll
        for (int j = 0; j < 8; ++j) { v[j] = xr[64 * j]; ss += (v[j].x * v[j].x + v[j].y * v[j].y) + (v[j].z * v[j].z + v[j].w * v[j].w); }
        const float rstd = rsqrtf(wave_sum(ss) * (1.0f / DM) + EPS);
#pragma unroll
        for (int j = 0; j < 8; ++j) { const int col = 4 * (lane + 64 * j);
            const f32x4 gv = *(const f32x4*)(g + col), scv = *(const f32x4*)(sc + (size_t)b * 12288 + col), shv = *(const f32x4*)(sh + (size_t)b * 12288 + col);
            const f32x4 o = (v[j] * rstd) * gv * (scv + 1.0f) + shv;
            u32x2 w; w.x = pk2(o.x, o.y); w.y = pk2(o.z, o.w);
            *(u32x2*)(xn + (size_t)m * DM + col) = w; }
    }
}
__device__ __forceinline__ void final_norm_phase(Frame& F, float* x, const float* g) {
    const int gw = blockIdx.x * 8 + F.wave, NGW = F.G * 8, lane = F.lane;
    for (int m = gw; m < MTOK; m += NGW) {
        f32x4* xr = (f32x4*)(x + (size_t)m * DM) + lane;
        f32x4 v[8]; float ss = 0.f;
#pragma unroll
        for (int j = 0; j < 8; ++j) { v[j] = xr[64 * j]; ss += (v[j].x * v[j].x + v[j].y * v[j].y) + (v[j].z * v[j].z + v[j].w * v[j].w); }
        const float rstd = rsqrtf(wave_sum(ss) * (1.0f / DM) + EPS);
#pragma unroll
        for (int j = 0; j < 8; ++j) { const f32x4 gv = *(const f32x4*)(g + 4 * (lane + 64 * j)); xr[64 * j] = (v[j] * rstd) * gv; }
    }
}
__device__ __forceinline__ void hy_scale_reduce(Frame& F) {
    const long gt = (long)blockIdx.x * 512 + F.tid;
    if (gt < 2048) { const int l = (int)(gt >> 10), o = (int)(gt >> 9) & 1, w = (int)gt & 511; const float* pp = (const float*)(F.ws + WS_HYPART) + (size_t)l * 256 * 2048 + o * 1024 + w;
        float s = 0.f; for (int pb = 0; pb < 256; ++pb) s += pp[(size_t)pb * 2048] + pp[(size_t)pb * 2048 + 512];
        ((float*)(F.ws + WS_HYSC))[gt] = rsqrtf(s + EPS); }
}

__device__ __forceinline__ void attn_prep_item(Frame& F, int l, int it) {
    const bf16* proj = (const bf16*)(F.ws + WS_PROJ); bf16* qb = (bf16*)(F.ws + WS_QB); bf16* kb = (bf16*)(F.ws + WS_KB);
#pragma unroll 1
    for (int pi = F.tid; pi < 768; pi += 512) {
        const int tok = pi / 12, hd = pi % 12; const int row = it * 64 + tok; const int pos = row & 4095;
        const bf16* src = proj + (size_t)row * DINP + (hd < 8 ? C_BQ + hd * 64 : (hd < 10 ? C_BK + (hd - 8) * 64 : C_BV + (hd - 10) * 64));
        u32x4 raw[8];
#pragma unroll
        for (int i = 0; i < 8; ++i) raw[i] = *(const u32x4*)(src + 8 * i);
        if (hd >= 10) {
            bf16* vd = (bf16*)(F.ws + WS_VB) + (size_t)row * 128 + (hd - 10) * 64;
#pragma unroll
            for (int i = 0; i < 8; ++i) *(u32x4*)(vd + 8 * i) = raw[i];
            continue; }
        float x[64]; float ss = 0.f;
#pragma unroll
        for (int i = 0; i < 8; ++i) { const unsigned w4[4] = {raw[i].x, raw[i].y, raw[i].z, raw[i].w};
#pragma unroll
            for (int e = 0; e < 4; ++e) { x[8 * i + 2 * e] = bflo(w4[e]); x[8 * i + 2 * e + 1] = bfhi(w4[e]); } }
#pragma unroll
        for (int i = 0; i < 64; ++i) ss += x[i] * x[i];
        const float r = rsqrtf(ss * (1.0f / 64.0f) + EPS);
        const float* g = (hd < 8 ? F.in[I_QG] : F.in[I_KG]) + l * 64;
        const float osc = (hd < 8) ? (0.125f * 1.4426950408889634f) : 1.0f;
#pragma unroll
        for (int i = 0; i < 64; ++i) x[i] = x[i] * r * g[i];
        float o[64];
#pragma unroll
        for (int seg = 0; seg < 2; ++seg) { const float p = seg ? (float)(pos & 63) : (float)(pos >> 6);
#pragma unroll
            for (int i = 0; i < 16; ++i) { const float inv = exp2f(-(float)i * (13.287712379549449f / 16.0f)); const float ang = p * inv; const float cs = cos_rad(ang), sn = sin_rad(ang);
                const float x1 = x[32 * seg + i], x2 = x[32 * seg + 16 + i];
                o[32 * seg + i] = (x1 * cs - x2 * sn) * osc; o[32 * seg + 16 + i] = (x2 * cs + x1 * sn) * osc; } }
        bf16* dst = (hd < 8) ? qb + (size_t)row * 512 + hd * 64 : kb + (size_t)row * 128 + (hd - 8) * 64;
#pragma unroll
        for (int i = 0; i < 8; ++i) *(u32x4*)(dst + 8 * i) = (u32x4){pk2(o[8 * i], o[8 * i + 1]), pk2(o[8 * i + 2], o[8 * i + 3]), pk2(o[8 * i + 4], o[8 * i + 5]), pk2(o[8 * i + 6], o[8 * i + 7])};
    }
}

__device__ __forceinline__ void hy_prep_item(Frame& F, int l, int it) {
    const bf16* proj = (const bf16*)(F.ws + WS_PROJ); bf16* ht = (bf16*)(F.ws + WS_HT);
    const int b = it / 192, rem = it % 192, tt = rem / 24, ct = rem % 24, t0 = tt * 512, c0 = ct * 64, tid = F.tid;
    float* raw = (float*)F.lds;
    u32x4 v[9];
#pragma unroll
    for (int j = 0; j < 9; ++j) { const int idx = tid + 512 * j; const int t = t0 - 1 + (idx >> 3);
        v[j] = (u32x4){0u, 0u, 0u, 0u};
        if (idx < 4112 && t >= 0 && t < SEQ) v[j] = *(const u32x4*)(proj + (size_t)(b * SEQ + t) * DINP + C_CU + c0 + (idx & 7) * 8); }
#pragma unroll
    for (int j = 0; j < 9; ++j) { const int idx = tid + 512 * j; if (idx < 4112) { float* d = raw + (idx >> 3) * 65 + (idx & 7) * 8; const unsigned w4[4] = {v[j].x, v[j].y, v[j].z, v[j].w};
#pragma unroll
        for (int e = 0; e < 4; ++e) { d[2 * e] = bflo(w4[e]); d[2 * e + 1] = bfhi(w4[e]); } } }
    __syncthreads();
    { const int ch = tid >> 3, seg = tid & 7; const int c = c0 + ch;
      const float w0 = F.in[I_HCW][(l * 3 + 0) * 1536 + c], w1 = F.in[I_HCW][(l * 3 + 1) * 1536 + c], w2 = F.in[I_HCW][(l * 3 + 2) * 1536 + c], cb = F.in[I_HCB][l * 1536 + c];
#pragma unroll
      for (int sb = 0; sb < 4; ++sb) { const int ts = 16 * (8 * sb + seg);
          unsigned pk[8];
#pragma unroll
          for (int e = 0; e < 16; e += 2) { const int tr = ts + e + 1;
              const float o0 = cb + w0 * raw[(tr - 1) * 65 + ch] + w1 * raw[tr * 65 + ch] + w2 * raw[(tr + 1) * 65 + ch];
              const float o1 = cb + w0 * raw[tr * 65 + ch] + w1 * raw[(tr + 1) * 65 + ch] + w2 * raw[(tr + 2) * 65 + ch];
              pk[e >> 1] = pk2(o0, o1); }
          u32x4* dst = (u32x4*)(ht + ((size_t)(b * 1536 + c)) * SEQ + t0 + ts);
          dst[0] = (u32x4){pk[0], pk[1], pk[2], pk[3]}; dst[1] = (u32x4){pk[4], pk[5], pk[6], pk[7]}; } }
}

__device__ __forceinline__ void hy_conv_item(Frame& F, int l, int order, int cp) {
    const int tid = F.tid, lane = F.lane, w = F.wave, r32 = lane & 31, hi = lane >> 5;
    unsigned* RVc = (unsigned*)F.lds;
    bf16* U = (bf16*)(F.lds + 65536);
    const int c0 = 2 * cp;
    { const unsigned* src = (const unsigned*)((const bf16*)(F.ws + WS_HYFT) + ((size_t)((l * 2 + order) * 512 + c0)) * 8192);
#pragma unroll
      for (int i0 = 0; i0 < 2048; i0 += 512) { const int i = tid + i0; const int cc = i >> 10, j4 = (i & 1023) * 4;
          const u32x4 a = *(const u32x4*)(src + cc * 4096 + j4); const unsigned nx = (j4 + 4 < 4096) ? src[cc * 4096 + j4 + 4] : 0u;
          *(u32x4*)(RVc + (cc * 2 + 0) * 4096 + j4) = a;
          *(u32x4*)(RVc + (cc * 2 + 1) * 4096 + j4) = (u32x4){__builtin_amdgcn_alignbit(a.y, a.x, 16), __builtin_amdgcn_alignbit(a.z, a.y, 16), __builtin_amdgcn_alignbit(a.w, a.z, 16), __builtin_amdgcn_alignbit(nx, a.w, 16)}; }
      u32x4 uv[8];
#pragma unroll
      for (int q = 0; q < 8; ++q) { const int i = tid + 512 * q; const int cc = i >> 11, b = (i >> 9) & 3, off = i & 511;
          const bf16* sp = (order == 0) ? (const bf16*)(F.ws + WS_HT) + ((size_t)(b * 1536 + c0 + cc)) * SEQ : (const bf16*)(F.ws + WS_Z1T) + ((size_t)(b * 512 + c0 + cc)) * SEQ;
          uv[q] = ((const u32x4*)sp)[off]; }
#pragma unroll
      for (int q = 0; q < 8; ++q) { const int i = tid + 512 * q; const int rowi = i >> 9, off = i & 511;
          *(u32x4*)(U + rowi * 4608 + 8 * off + (off >> 3) * 8) = uv[q]; } }
    if (tid < 32) ((unsigned*)(F.lds + 65536 + 73728))[tid] = 0u;
    __syncthreads();
    const int cc = w >> 2, b = w & 3, c = c0 + cc;
    bf16* Uc = U + (cc * 4 + b) * 4608;
    f32x16 acc[2][2];
#pragma unroll
    for (int a = 0; a < 2; ++a)
#pragma unroll
        for (int q = 0; q < 2; ++q)
#pragma unroll
            for (int r = 0; r < 16; ++r) acc[a][q][r] = 0.f;
    const unsigned lds_rv = (unsigned)(uintptr_t)(RVc + cc * 2 * 4096);
#define HY_RD(DST, ADDR, O) do { asm volatile("ds_read2_b32 %0, %1 offset0:%2 offset1:%3" : "=v"((DST)[0]) : "v"(ADDR), "i"(O), "i"((O) + 1)); \
                                 asm volatile("ds_read2_b32 %0, %1 offset0:%2 offset1:%3" : "=v"((DST)[1]) : "v"(ADDR), "i"((O) + 2), "i"((O) + 3)); } while (0)
#define HY_LDB(DST, DD) do { const int ip0_ = r32 - (DD), ip1_ = 32 + r32 - (DD); const bool ok0_ = (ip0_ >= 0) && (ip0_ < 64), ok1_ = (ip1_ >= 0) && (ip1_ < 64); \
        const bf16* p0_ = ok0_ ? (Uc + 72 * ip0_ + 8 * hi) : ZR; const bf16* p1_ = ok1_ ? (Uc + 72 * ip1_ + 8 * hi) : ZR;        \
        _Pragma("unroll") for (int ks = 0; ks < 4; ++ks) { (DST)[ks][0] = *(const bf16x8*)(p0_ + 16 * ks); (DST)[ks][1] = *(const bf16x8*)(p1_ + 16 * ks); } } while (0)
    u32x2 W[6][2], nW[4][2]; bf16x8 B[4][2], nB[4][2];
    const bf16* ZR = (const bf16*)(F.lds + 65536 + 73728);
    unsigned aaddr;
    { const int s1 = 4095 - (64 * (-63) + 32 + r32 - 8 * hi); aaddr = lds_rv + (unsigned)(s1 & 1) * 16384u + (unsigned)(s1 >> 1) * 4u; }
    HY_RD(W[0], aaddr, 40); HY_RD(W[1], aaddr, 32); HY_RD(W[2], aaddr, 24); HY_RD(W[3], aaddr, 16); HY_RD(W[4], aaddr, 8); HY_RD(W[5], aaddr, 0);
    HY_LDB(B, -63);
#pragma unroll
    for (int i = 0; i < 4; ++i) { nW[i][0] = (u32x2){0u, 0u}; nW[i][1] = (u32x2){0u, 0u}; }
#pragma unroll
    for (int ks = 0; ks < 4; ++ks) { nB[ks][0] = (bf16x8){0, 0, 0, 0, 0, 0, 0, 0}; nB[ks][1] = (bf16x8){0, 0, 0, 0, 0, 0, 0, 0}; }
    asm volatile("s_waitcnt lgkmcnt(0)" : "+v"(W[0][0]), "+v"(W[0][1]), "+v"(W[1][0]), "+v"(W[1][1]), "+v"(W[2][0]), "+v"(W[2][1]), "+v"(W[3][0]), "+v"(W[3][1]), "+v"(W[4][0]), "+v"(W[4][1]), "+v"(W[5][0]), "+v"(W[5][1]),
                                            "+v"(B[0][0]), "+v"(B[0][1]), "+v"(B[1][0]), "+v"(B[1][1]), "+v"(B[2][0]), "+v"(B[2][1]), "+v"(B[3][0]), "+v"(B[3][1]) :: "memory");
#pragma unroll 1
    for (int D = -63; D <= 63; ++D) {
        const bool v0 = (D <= 31), v1 = (D >= -31);
        const unsigned an = aaddr - 128u;
        if (D < 63) { HY_RD(nW[0], an, 24); HY_RD(nW[1], an, 16); HY_RD(nW[2], an, 8); HY_RD(nW[3], an, 0); HY_LDB(nB, D + 1); }
        __builtin_amdgcn_sched_barrier(0);
#pragma unroll
        for (int ks = 0; ks < 4; ++ks) {
            const bf16x8 a0 = __builtin_bit_cast(bf16x8, (u32x4){W[3 - ks][0].x, W[3 - ks][0].y, W[3 - ks][1].x, W[3 - ks][1].y});
            const bf16x8 a1 = __builtin_bit_cast(bf16x8, (u32x4){W[5 - ks][0].x, W[5 - ks][0].y, W[5 - ks][1].x, W[5 - ks][1].y});
            if (v0) { acc[0][0] = MFMA32(a0, B[ks][0], acc[0][0]); acc[1][0] = MFMA32(a1, B[ks][0], acc[1][0]); }
            if (v1) { acc[0][1] = MFMA32(a0, B[ks][1], acc[0][1]); acc[1][1] = MFMA32(a1, B[ks][1], acc[1][1]); } }
        __builtin_amdgcn_sched_barrier(0);
        asm volatile("s_waitcnt lgkmcnt(0)" : "+v"(nW[0][0]), "+v"(nW[0][1]), "+v"(nW[1][0]), "+v"(nW[1][1]), "+v"(nW[2][0]), "+v"(nW[2][1]), "+v"(nW[3][0]), "+v"(nW[3][1]),
                                                "+v"(nB[0][0]), "+v"(nB[0][1]), "+v"(nB[1][0]), "+v"(nB[1][1]), "+v"(nB[2][0]), "+v"(nB[2][1]), "+v"(nB[3][0]), "+v"(nB[3][1]) :: "memory");
        W[0][0] = W[4][0]; W[0][1] = W[4][1]; W[1][0] = W[5][0]; W[1][1] = W[5][1];
#pragma unroll
        for (int i = 0; i < 4; ++i) { W[2 + i][0] = nW[i][0]; W[2 + i][1] = nW[i][1]; }
#pragma unroll
        for (int ks = 0; ks < 4; ++ks) { B[ks][0] = nB[ks][0]; B[ks][1] = nB[ks][1]; }
        aaddr = an;
    }
#undef HY_RD
#undef HY_LDB
    const float scale = ((const float*)(F.ws + WS_HYSC))[(l * 2 + order) * 512 + c], sk = F.in[I_HSKIP][(l * 2 + order) * 512 + c];
#pragma unroll
    for (int jt = 0; jt < 2; ++jt)
#pragma unroll
        for (int itl = 0; itl < 2; ++itl)
            { float uu[16];
#pragma unroll
              for (int r = 0; r < 16; ++r) uu[r] = bf2f(Uc[72 * (32 * itl + r32) + 32 * jt + crow(r, hi)]);
#pragma unroll
              for (int r = 0; r < 16; ++r) Uc[72 * (32 * itl + r32) + 32 * jt + crow(r, hi)] = (bf16)f2bf(acc[jt][itl][r] * scale + sk * uu[r]); }
    LDS_WAIT();
    const bf16* gate = (const bf16*)(F.ws + WS_HT) + ((size_t)(b * 1536 + (order == 0 ? 512 : 1024) + c)) * SEQ;
    bf16* zdst = (bf16*)(F.ws + WS_Z1T) + ((size_t)(b * 512 + c)) * SEQ;
#pragma unroll
    for (int q = 0; q < 8; ++q) { const int t = 8 * lane + 512 * q;
        const u32x4 uv = *(const u32x4*)(Uc + t + (t >> 6) * 8); const u32x4 gv = *(const u32x4*)(gate + t);
        *(u32x4*)(zdst + t) = (u32x4){pk2(bflo(uv.x) * bflo(gv.x), bfhi(uv.x) * bfhi(gv.x)), pk2(bflo(uv.y) * bflo(gv.y), bfhi(uv.y) * bfhi(gv.y)),
                                      pk2(bflo(uv.z) * bflo(gv.z), bfhi(uv.z) * bfhi(gv.z)), pk2(bflo(uv.w) * bflo(gv.w), bfhi(uv.w) * bfhi(gv.w))}; }
}
__device__ __forceinline__ void hy_out_phase(Frame& F) {
    bf16* tile = (bf16*)F.lds;
    const int tid = F.tid;
    for (int it = blockIdx.x; it < 1024; it += F.G) {
        const int b = it >> 8, cb = (it >> 5) & 7, tb = it & 31;
        __syncthreads();
#pragma unroll
        for (int j = 0; j < 2; ++j) { const int idx = tid + 512 * j; const int ch = idx >> 4, t8 = (idx & 15) * 8;
            *(u32x4*)(tile + ch * 136 + t8) = *(const u32x4*)((const bf16*)(F.ws + WS_Z1T) + ((size_t)(b * 512 + 64 * cb + ch)) * SEQ + 128 * tb + t8); }
        __syncthreads();
#pragma unroll
        for (int j = 0; j < 2; ++j) { const int idx = tid + 512 * j; const int t = idx >> 3, c8 = (idx & 7) * 8; unsigned pk[4];
#pragma unroll
            for (int e = 0; e < 4; ++e) pk[e] = (unsigned)tile[(c8 + 2 * e) * 136 + t] | ((unsigned)tile[(c8 + 2 * e + 1) * 136 + t] << 16);
            *(u32x4*)((bf16*)(F.ws + WS_Y) + ((size_t)(b * SEQ + 128 * tb + t)) * DM + 1024 + 64 * cb + c8) = (u32x4){pk[0], pk[1], pk[2], pk[3]}; }
    }
    __syncthreads();
}

__device__ __forceinline__ float gelu_tanh(float x) { const float z = 0.7978845608028654f * (x + 0.044715f * x * x * x); const float t = 1.0f - 2.0f * __builtin_amdgcn_rcpf(__expf(2.0f * z) + 1.0f); return 0.5f * x * (1.0f + t); }
template <int STAGE> __device__ __forceinline__ void lru_item(Frame& F, int l, int it) {
    const bf16* proj = (const bf16*)(F.ws + WS_PROJ); bf16* Y = (bf16*)(F.ws + WS_Y);
    const int tid = F.tid, lane = F.lane, w = F.wave, r16 = lane & 15, q = lane >> 4;
    const int b = it >> 6, chunk = it & 63, t0 = chunk * 64;
    bf16* XC = (bf16*)F.lds;
    bf16* HFL = (bf16*)(F.lds + 66560);
    { const int c8 = (tid & 63) * 8, run = tid >> 6;
      u32x4 rw[11];
#pragma unroll
      for (int j = 0; j < 11; ++j) { const int tt = t0 + 8 * run - 2 + j; rw[j] = (u32x4){0u, 0u, 0u, 0u};
          if (tt >= 0 && tt < SEQ) rw[j] = *(const u32x4*)(proj + (size_t)(b * SEQ + tt) * DINP + C_AX + c8); }
      float wv[4][8], bv8[8];
#pragma unroll
      for (int e = 0; e < 8; ++e) { bv8[e] = F.in[I_LCB][l * 512 + c8 + e];
#pragma unroll
          for (int jj = 0; jj < 4; ++jj) wv[jj][e] = F.in[I_LCW][(l * 4 + jj) * 512 + c8 + e]; }
#pragma unroll
      for (int tk = 0; tk < 8; ++tk) { float o[8];
#pragma unroll
          for (int e = 0; e < 8; ++e) o[e] = bv8[e];
#pragma unroll
          for (int jj = 0; jj < 4; ++jj) { const u32x4 r4 = rw[tk + jj]; const unsigned w4[4] = {r4.x, r4.y, r4.z, r4.w};
#pragma unroll
              for (int e = 0; e < 4; ++e) { o[2 * e] += wv[jj][2 * e] * bflo(w4[e]); o[2 * e + 1] += wv[jj][2 * e + 1] * bfhi(w4[e]); } }
          *(u32x4*)(XC + (8 * run + tk) * 520 + c8) = (u32x4){pk2(o[0], o[1]), pk2(o[2], o[3]), pk2(o[4], o[5]), pk2(o[6], o[7])}; } }
    __syncthreads();
    const int blk = w;
    f32x2* sums = (f32x2*)(F.ws + WS_LRUS);
#pragma unroll 1
    for (int dir = 0; dir < 2; ++dir) {
        bf16x8 Bw[2][4][2]; float bav[4], bxv[4], lamc[4], hc[4], Ap[4];
#pragma unroll
        for (int nt = 0; nt < 4; ++nt) { const int ch = 64 * blk + 16 * nt + r16;
            bav[nt] = F.in[I_LBA][(l * 2 + dir) * 512 + ch]; bxv[nt] = F.in[I_LBX][(l * 2 + dir) * 512 + ch];
            lamc[nt] = -8.0f * log1pf(__expf(-F.in[I_LLAM][(l * 2 + dir) * 512 + ch])); hc[nt] = 0.f; Ap[nt] = 1.f;
#pragma unroll
            for (int gate = 0; gate < 2; ++gate)
#pragma unroll
                for (int ks = 0; ks < 2; ++ks)
                    Bw[gate][nt][ks] = *(const bf16x8*)((const bf16*)(F.ws + WS_LRUW) + ((((size_t)(l * 2 + dir) * 8 + blk) * 2 + gate) * 64 + 16 * nt + r16) * 64 + 32 * ks + 8 * q); }
        if (STAGE == 2) {
            const int cbeg = dir ? chunk + 1 : 0, cend = dir ? 64 : chunk;
#pragma unroll 1
            for (int ci = cbeg; ci < cend; ci += 8) { f32x2 sv[8][4];
#pragma unroll
                for (int u = 0; u < 8; ++u) { const int cu = ci + u; const int cj = dir ? (cend - 1 - (cu - cbeg)) : cu;
#pragma unroll
                    for (int nt = 0; nt < 4; ++nt) sv[u][nt] = (cu < cend) ? sums[((size_t)(b * 64 + cj) * 2 + dir) * 512 + 64 * blk + 16 * nt + r16] : (f32x2){1.f, 0.f}; }
#pragma unroll
                for (int u = 0; u < 8; ++u)
#pragma unroll
                    for (int nt = 0; nt < 4; ++nt) hc[nt] = sv[u][nt].x * hc[nt] + sv[u][nt].y; }
        }
        const int myi = dir ? 3 - q : q;
#pragma unroll 1
        for (int mi = 0; mi < 4; ++mi) { const int mt = dir ? 3 - mi : mi;
            bf16x8 af[2];
#pragma unroll
            for (int ks = 0; ks < 2; ++ks) af[ks] = *(const bf16x8*)(XC + (16 * mt + r16) * 520 + 64 * blk + 32 * ks + 8 * q);
            unsigned short gaw[4][4];
            if (STAGE == 2 && dir == 1) {
#pragma unroll
                for (int nt = 0; nt < 4; ++nt)
#pragma unroll
                    for (int r = 0; r < 4; ++r) gaw[nt][r] = proj[((size_t)b * SEQ + t0 + 16 * mt + 4 * q + r) * DINP + C_AG + 64 * blk + 16 * nt + r16]; }
#pragma unroll
            for (int nt = 0; nt < 4; ++nt) {
                f32x4 ga = (f32x4){0.f, 0.f, 0.f, 0.f}, gx = (f32x4){0.f, 0.f, 0.f, 0.f};
                ga = MFMA16(af[0], Bw[0][nt][0], ga); ga = MFMA16(af[1], Bw[0][nt][1], ga);
                gx = MFMA16(af[0], Bw[1][nt][0], gx); gx = MFMA16(af[1], Bw[1][nt][1], gx);
                float a_[4], u_[4];
#pragma unroll
                for (int r = 0; r < 4; ++r) { const int tok = 16 * mt + 4 * q + r;
                    const float rg = sigmoidf_(ga[r] + bav[nt]), ig = sigmoidf_(gx[r] + bxv[nt]);
                    const float la = lamc[nt] * rg; a_[r] = __expf(la); const float mult = __builtin_amdgcn_sqrtf(fmaxf(1.0f - a_[r] * a_[r], 0.f));
                    u_[r] = mult * ig * bf2f(XC[tok * 520 + 64 * blk + 16 * nt + r16]); }
                float ap[4], up[4];
#pragma unroll
                for (int i = 0; i < 4; ++i) { ap[i] = dir ? a_[3 - i] : a_[i]; up[i] = dir ? u_[3 - i] : u_[i]; }
                const float A = (ap[0] * ap[1]) * (ap[2] * ap[3]); const float U = ((up[0] * ap[1] + up[1]) * ap[2] + up[2]) * ap[3] + up[3];
                float h = hc[nt], hin = 0.f, aprod = 1.f;
#pragma unroll
                for (int i = 0; i < 4; ++i) { const int qs = dir ? 3 - i : i; const float Aq = shl_(A, r16 + 16 * qs), Uq = shl_(U, r16 + 16 * qs);
                    hin = (myi == i) ? h : hin; h = Aq * h + Uq; aprod *= Aq; }
                hc[nt] = h; Ap[nt] *= aprod;
                if (STAGE == 2) {
                    float hh = hin;
#pragma unroll
                    for (int i = 0; i < 4; ++i) { hh = ap[i] * hh + up[i];
                        const int r = dir ? 3 - i : i; const int tok = 16 * mt + 4 * q + r; const int ch = 64 * blk + 16 * nt + r16;
                        if (dir == 0) HFL[tok * 512 + ch] = (bf16)f2bf(hh);
                        else { const size_t row = (size_t)b * SEQ + t0 + tok; const float gav = bf2f(dir ? (i == 0 ? gaw[nt][3] : i == 1 ? gaw[nt][2] : i == 2 ? gaw[nt][1] : gaw[nt][0]) : 0);
                               Y[row * DM + ch] = (bf16)f2bf(gelu_tanh(gav) * (bf2f(HFL[tok * 512 + ch]) + hh)); } }
                }
            }
        }
        if (STAGE == 1) { if (q == 0) {
#pragma unroll
            for (int nt = 0; nt < 4; ++nt) sums[((size_t)(b * 64 + chunk) * 2 + dir) * 512 + 64 * blk + 16 * nt + r16] = (f32x2){Ap[nt], hc[nt]}; } }
        LDS_WAIT();
    }
}

__device__ __forceinline__ void ml_gates(Frame& F, float* G, int b, int h, int n) {
    const int tid = F.tid;
    __syncthreads();
    if (tid < 128) { const float* g = (const float*)(F.ws + WS_GATES) + ((size_t)b * SEQ + 128 * n + tid) * 16;
        G[tid] = g[h]; G[128 + tid] = logsigmoidf_(g[4 + h]); G[256 + tid] = g[8 + h]; G[384 + tid] = logsigmoidf_(g[12 + h]); }
    __syncthreads();
    if (tid < 256) { const int p0 = tid & 127; const bool sfx = tid >= 128; const float* src = G + (sfx ? 384 : 128); float s = 0.f;
#pragma unroll 16
        for (int p = 0; p < 128; ++p) { const float v = src[p]; s += (sfx ? (p >= p0) : (p <= p0)) ? v : 0.f; }
        G[(sfx ? 640 : 512) + p0] = s; }
    __syncthreads();
}
template <bool WITH_K> __device__ __forceinline__ void ml_load_T(Frame& F, bf16* VT, bf16* KTf, bf16* KTb, const float* Ef, const float* Eb, int b, int h, int n) {
    const bf16* proj = (const bf16*)(F.ws + WS_PROJ);
#pragma unroll
    for (int qq = 0; qq < 4; ++qq) { const int chunk = F.tid + 512 * qq; const int p = chunk & 127, cc = chunk >> 7; const size_t row = (size_t)b * SEQ + 128 * n + p;
        const u32x4 vv = *(const u32x4*)(proj + row * DINP + C_DV + 128 * h + 8 * cc);
        const unsigned vw[4] = {vv.x, vv.y, vv.z, vv.w};
#pragma unroll
        for (int e = 0; e < 4; ++e) { VT[(8 * cc + 2 * e) * 136 + p] = (bf16)(vw[e] & 0xffffu); VT[(8 * cc + 2 * e + 1) * 136 + p] = (bf16)(vw[e] >> 16); }
        if (WITH_K) { const u32x4 kv = *(const u32x4*)(proj + row * DINP + C_DK + 128 * h + 8 * cc); const unsigned kw[4] = {kv.x, kv.y, kv.z, kv.w}; const float ef = Ef[p], eb = Eb[p];
#pragma unroll
            for (int e = 0; e < 4; ++e) { const float k0 = bflo(kw[e]), k1 = bfhi(kw[e]);
                KTf[(8 * cc + 2 * e) * 136 + p] = (bf16)f2bf(k0 * ef); KTf[(8 * cc + 2 * e + 1) * 136 + p] = (bf16)f2bf(k1 * ef);
                KTb[(8 * cc + 2 * e) * 136 + p] = (bf16)f2bf(k0 * eb); KTb[(8 * cc + 2 * e + 1) * 136 + p] = (bf16)f2bf(k1 * eb); } } }
}
__device__ __forceinline__ void ml1_item(Frame& F, int it) {
    const int tid = F.tid, lane = F.lane, w = F.wave, r32 = lane & 31, hi = lane >> 5;
    const int b = it >> 7, h = (it >> 5) & 3, n = it & 31;
    bf16* VT = (bf16*)F.lds; bf16* KTf = (bf16*)(F.lds + 34816); bf16* KTb = (bf16*)(F.lds + 69632); float* G = (float*)(F.lds + 104448);
    ml_gates(F, G, b, h, n);
    float* Wd = G + 768; float* Ed = G + 1024; float* MX = G + 1280;
    if (tid < 256) { const int d = tid >> 7, p = tid & 127; Wd[tid] = d == 0 ? (G[512 + 127] - G[512 + p] + G[p]) : (G[640] - G[640 + p] + G[256 + p]); }
    __syncthreads();
    if (tid < 256) { const int d = tid >> 7, p = tid & 127; float mx = -INFINITY;
#pragma unroll 16
        for (int pp = 0; pp < 128; ++pp) mx = fmaxf(mx, Wd[d * 128 + pp]); Ed[tid] = __expf(Wd[tid] - mx); if (p == 0) MX[d] = mx; }
    __syncthreads();
    ml_load_T<true>(F, VT, KTf, KTb, Ed, Ed + 128, b, h, n);
    __syncthreads();
    const int d = w >> 2, vb = w & 3; const bf16* KT = d ? KTb : KTf;
    f32x16 acc[4];
#pragma unroll
    for (int kt = 0; kt < 4; ++kt)
#pragma unroll
        for (int r = 0; r < 16; ++r) acc[kt][r] = 0.f;
#pragma unroll
    for (int ps = 0; ps < 8; ++ps) { const bf16x8 a = *(const bf16x8*)(VT + (32 * vb + r32) * 136 + 16 * ps + 8 * hi);
#pragma unroll
        for (int kt = 0; kt < 4; ++kt) { const bf16x8 bb = *(const bf16x8*)(KT + (32 * kt + r32) * 136 + 16 * ps + 8 * hi); acc[kt] = MFMA32(a, bb, acc[kt]); } }
    const int idx = ((b * 4 + h) * 2 + d) * 32 + (d ? 31 - n : n);
    float* dst = (float*)(F.ws + WS_MLDC) + (size_t)idx * 16384;
#pragma unroll
    for (int kt = 0; kt < 4; ++kt)
#pragma unroll
        for (int r = 0; r < 16; ++r) dst[(32 * vb + crow(r, hi)) * 128 + 32 * kt + r32] = acc[kt][r];
    if (tid < 256) { const int dd = tid >> 7, k = tid & 127; const bf16* K2 = dd ? KTb : KTf; float s = 0.f; for (int p = 0; p < 128; ++p) s += bf2f(K2[k * 136 + p]);
        const int idx2 = ((b * 4 + h) * 2 + dd) * 32 + (dd ? 31 - n : n);
        ((float*)(F.ws + WS_MLDN))[(size_t)idx2 * 128 + k] = s;
        if (k == 0) { float* sc = (float*)(F.ws + WS_MLSC) + (size_t)idx2 * 4; sc[0] = MX[dd]; sc[1] = dd ? G[640] : G[512 + 127]; } }
}
__device__ __forceinline__ void ml2_item(Frame& F, int it) {
    const int tid = F.tid, bhd = it >> 3, part = it & 7, e0 = part * 2048 + tid * 4;
    const float* sc = (const float*)(F.ws + WS_MLSC); float* scw = (float*)(F.ws + WS_MLSC);
    const bool nthr = (part == 0) && (tid < 32);
    float m = 0.f; f32x4 C = (f32x4){0.f, 0.f, 0.f, 0.f}, nv = (f32x4){0.f, 0.f, 0.f, 0.f};
#pragma unroll 1
    for (int cb = 0; cb < 32; cb += 8) {
        float mlo[8], btv[8]; f32x4 dcv[8], dnv[8];
#pragma unroll
        for (int j = 0; j < 8; ++j) { const size_t idx = (size_t)bhd * 32 + cb + j; mlo[j] = sc[idx * 4]; btv[j] = sc[idx * 4 + 1];
            dcv[j] = *(const f32x4*)((const float*)(F.ws + WS_MLDC) + idx * 16384 + e0);
            dnv[j] = nthr ? *(const f32x4*)((const float*)(F.ws + WS_MLDN) + idx * 128 + 4 * tid) : (f32x4){0.f, 0.f, 0.f, 0.f}; }
#pragma unroll
        for (int j = 0; j < 8; ++j) { const size_t idx = (size_t)bhd * 32 + cb + j; const float mloc = mlo[j], bt = btv[j];
            const float mnew = fmaxf(bt + m, mloc), dec = __expf(bt + m - mnew), gn = __expf(mloc - mnew);
            *(u32x2*)((bf16*)(F.ws + WS_MLCT) + idx * 16384 + e0) = (u32x2){pk2(C.x, C.y), pk2(C.z, C.w)};
            if (nthr) *(f32x4*)((float*)(F.ws + WS_MLNP) + idx * 128 + 4 * tid) = nv;
            if (part == 0 && tid == 0) scw[idx * 4 + 2] = m;
            C = C * dec + dcv[j] * gn; nv = nv * dec + dnv[j] * gn;
            m = mnew; }
    }
}
__device__ __forceinline__ void ml3_item(Frame& F, int l, int it) {
    const bf16* proj = (const bf16*)(F.ws + WS_PROJ);
    const int tid = F.tid, lane = F.lane, w = F.wave, r32 = lane & 31, hi = lane >> 5;
    const int b = it >> 7, h = (it >> 5) & 3, n = it & 31;
    bf16* VT = (bf16*)F.lds; bf16* KN = (bf16*)(F.lds + 34816); float* HF = (float*)(F.lds + 69632); float* G = (float*)(F.lds + 135680); float* INV = (float*)(F.lds + 143872);
    ml_gates(F, G, b, h, n);
    const int idx_f = ((b * 4 + h) * 2 + 0) * 32 + n, idx_b = ((b * 4 + h) * 2 + 1) * 32 + (31 - n);
    const float mpf = ((const float*)(F.ws + WS_MLSC))[(size_t)idx_f * 4 + 2], mpb = ((const float*)(F.ws + WS_MLSC))[(size_t)idx_b * 4 + 2];
    if (tid < 128) { G[7 * 128 + tid] = G[tid] - G[512 + tid]; G[11 * 128 + tid] = G[256 + tid] - G[640 + tid]; }
    __syncthreads();
    if (tid < 128) { const int p = tid; float pm = -INFINITY;
#pragma unroll 16
        for (int s = 0; s < 128; ++s) { const float v = G[7 * 128 + s]; pm = fmaxf(pm, (s <= p) ? v : -INFINITY); }
        const float bl = G[512 + p], mint = bl + mpf, mt = fmaxf(mint, bl + pm); G[8 * 128 + p] = __expf(mint - mt); G[6 * 128 + p] = bl - mt; G[9 * 128 + p] = mt; }
    else if (tid < 256) { const int p = tid - 128; float pm = -INFINITY;
#pragma unroll 16
        for (int s = 0; s < 128; ++s) { const float v = G[11 * 128 + s]; pm = fmaxf(pm, (s >= p) ? v : -INFINITY); }
        const float bl = G[640 + p], mint = bl + mpb, mt = fmaxf(mint, bl + pm); G[12 * 128 + p] = __expf(mint - mt); G[10 * 128 + p] = bl - mt; G[13 * 128 + p] = mt; }
    else if (tid < 384) { const int k = tid - 256; G[14 * 128 + k] = ((const float*)(F.ws + WS_MLNP))[(size_t)idx_f * 128 + k]; }
    else { const int k = tid - 384; G[15 * 128 + k] = ((const float*)(F.ws + WS_MLNP))[(size_t)idx_b * 128 + k]; }
    ml_load_T<false>(F, VT, nullptr, nullptr, nullptr, nullptr, b, h, n);
    { u32x4 kv[4];
#pragma unroll
      for (int qq = 0; qq < 4; ++qq) { const int chunk = tid + 512 * qq; const int p = chunk >> 4, cc = chunk & 15; kv[qq] = *(const u32x4*)(proj + ((size_t)b * SEQ + 128 * n + p) * DINP + C_DK + 128 * h + 8 * cc); }
#pragma unroll
      for (int qq = 0; qq < 4; ++qq) { const int chunk = tid + 512 * qq; const int p = chunk >> 4, cc = chunk & 15; *(u32x4*)(KN + p * 136 + 8 * cc) = kv[qq]; } }
    __syncthreads();
    const int lb = w & 3, vh = w >> 2, ll = 32 * lb + r32;
    const float SCALE = 0.08838834764831845f;
    bf16x8 qf[8];
    { const bf16* qp = proj + ((size_t)b * SEQ + 128 * n + ll) * DINP + C_DQ + 128 * h + 8 * hi;
#pragma unroll
      for (int ks = 0; ks < 8; ++ks) qf[ks] = *(const bf16x8*)(qp + 16 * ks); }
#pragma unroll 1
    for (int d = 0; d < 2; ++d) {
        const int idx = d ? idx_b : idx_f;
        const float* RT = G + (d ? 10 : 6) * 128; const float* CF = G + (d ? 11 : 7) * 128; const float* EI = G + (d ? 12 : 8) * 128; const float* MT = G + (d ? 13 : 9) * 128; const float* NP = G + (d ? 15 : 14) * 128;
        const float rt = RT[ll], ei = EI[ll], mt = MT[ll];
        f32x16 O[2];
#pragma unroll
        for (int vt = 0; vt < 2; ++vt)
#pragma unroll
            for (int r = 0; r < 16; ++r) O[vt][r] = 0.f;
        float dsum = 0.f;
        const int st_lo = d ? lb : 0, st_hi = d ? 3 : lb;
#pragma unroll 1
        for (int st = st_lo; st <= st_hi; ++st) {
            f32x16 sacc;
#pragma unroll
            for (int r = 0; r < 16; ++r) sacc[r] = 0.f;
            const bf16* kp = KN + (32 * st + r32) * 136 + 8 * hi;
#pragma unroll
            for (int ks = 0; ks < 8; ++ks) { const bf16x8 kf = *(const bf16x8*)(kp + 16 * ks); sacc = MFMA32(kf, qf[ks], sacc); }
            float P[16];
#pragma unroll
            for (int r = 0; r < 16; ++r) { const int s_ = 32 * st + crow(r, hi); const bool ok = d ? (s_ >= ll) : (s_ <= ll);
                const float pv = ok ? sacc[r] * SCALE * __expf(rt + CF[s_]) : 0.f; P[r] = pv; dsum += pv; }
#pragma unroll
            for (int half = 0; half < 2; ++half) {
                const u32x4 pw = (u32x4){pk2(P[8 * half + 0], P[8 * half + 1]), pk2(P[8 * half + 2], P[8 * half + 3]), pk2(P[8 * half + 4], P[8 * half + 5]), pk2(P[8 * half + 6], P[8 * half + 7])};
                const bf16x8 pa = __builtin_bit_cast(bf16x8, pw);
#pragma unroll
                for (int vt = 0; vt < 2; ++vt) { const bf16* vp = VT + (32 * (2 * vh + vt) + r32) * 136 + 32 * st + 16 * half + 4 * hi;
                    const u32x2 lo = *(const u32x2*)vp, hi2 = *(const u32x2*)(vp + 8);
                    const bf16x8 bv = __builtin_bit_cast(bf16x8, (u32x4){lo.x, lo.y, hi2.x, hi2.y});
                    O[vt] = MFMA32(pa, bv, O[vt]); } } }
        const float qs = ei * SCALE; float dq = 0.f;
#pragma unroll
        for (int ks = 0; ks < 8; ++ks) { const u32x4 qw = __builtin_bit_cast(u32x4, qf[ks]); const unsigned qq[4] = {qw.x, qw.y, qw.z, qw.w}; float qv[8];
#pragma unroll
            for (int e = 0; e < 4; ++e) { qv[2 * e] = bflo(qq[e]); qv[2 * e + 1] = bfhi(qq[e]); }
#pragma unroll
            for (int e = 0; e < 8; ++e) dq += qv[e] * NP[16 * ks + 8 * hi + e];
            const u32x4 sw = (u32x4){pk2(qv[0] * qs, qv[1] * qs), pk2(qv[2] * qs, qv[3] * qs), pk2(qv[4] * qs, qv[5] * qs), pk2(qv[6] * qs, qv[7] * qs)};
            const bf16x8 qp2 = __builtin_bit_cast(bf16x8, sw);
#pragma unroll
            for (int vt = 0; vt < 2; ++vt) { const bf16x8 cf = *(const bf16x8*)((const bf16*)(F.ws + WS_MLCT) + (size_t)idx * 16384 + (32 * (2 * vh + vt) + r32) * 128 + 16 * ks + 8 * hi);
                O[vt] = MFMA32(qp2, cf, O[vt]); } }
        dsum += shx(dsum, 32); dq += shx(dq, 32);
        const float den = dsum + qs * dq;
        const float inv = 1.0f / fmaxf(fabsf(den), __expf(-mt));
        asm volatile("" ::: "memory");
        INV[w * 32 + r32] = inv;
        LDS_WAIT();
#pragma unroll
        for (int vt = 0; vt < 2; ++vt)
#pragma unroll
            for (int r = 0; r < 16; ++r) { float* hp = HF + (32 * lb + crow(r, hi)) * 129 + 32 * (2 * vh + vt) + r32; const float hv_ = O[vt][r] * INV[w * 32 + crow(r, hi)];
                *hp = d ? (*hp + hv_) : hv_; }
        LDS_WAIT();
    }
    __syncthreads();
    { const int p = tid >> 2, part = tid & 3; const size_t row = (size_t)b * SEQ + 128 * n + p;
      float hv[32]; float ss = 0.f;
#pragma unroll
      for (int e = 0; e < 32; ++e) { hv[e] = HF[p * 129 + 32 * part + e]; ss += hv[e] * hv[e]; }
      ss += shx(ss, 1); ss += shx(ss, 2);
      const float rstd = rsqrtf(ss * (1.0f / 128.0f) + EPS);
      const bf16* op = proj + row * DINP + C_DO + 128 * h + 32 * part; const float* gp = F.in[I_MLG] + l * 512 + 128 * h + 32 * part;
      bf16* yp = (bf16*)(F.ws + WS_Y) + row * DM + 1536 + 128 * h + 32 * part;
#pragma unroll
      for (int e8 = 0; e8 < 4; ++e8) { const u32x4 ov = *(const u32x4*)(op + 8 * e8); const unsigned ow[4] = {ov.x, ov.y, ov.z, ov.w}; unsigned pk[4];
#pragma unroll
          for (int e = 0; e < 4; ++e) { const float y0 = hv[8 * e8 + 2 * e] * rstd * gp[8 * e8 + 2 * e] * sigmoidf_(bflo(ow[e])); const float y1 = hv[8 * e8 + 2 * e + 1] * rstd * gp[8 * e8 + 2 * e + 1] * sigmoidf_(bfhi(ow[e])); pk[e] = pk2(y0, y1); }
          *(u32x4*)(yp + 8 * e8) = (u32x4){pk[0], pk[1], pk[2], pk[3]}; } }
}

__device__ __forceinline__ void mixer_phase(Frame& F0, int l, int stage, int rep) {
    unsigned* ctr = (unsigned*)(F0.ws + WS_CTL) + 64 * (1 + (l * 3 + stage) * 2 + rep);
    const int nitems = (stage == 0) ? 1792 : 1024;
    for (;;) {
        const int it = next_item(ctr, F0.lds);
        if (it >= nitems) break;
        Frame F = F0;
        { unsigned zoff = 0u; asm volatile("" : "+s"(zoff)); F.ws = F0.ws + zoff; F.out = F0.out + zoff; F.in = F0.in + zoff; F.tid = lt(); F.lane = F.tid & 63; F.wave = __builtin_amdgcn_readfirstlane(F.tid >> 6); }
#if MK_PROBE
        if (rep == 1) { int ty; if (stage == 0) ty = it < 512 ? 4 : (it < 768 ? 3 : 5); else ty = it < 256 ? 1 : (it < 512 ? 2 : ((stage == 1 && it < 768) ? 3 : 4));
            if (!((MK_PTYPE >> ty) & 1)) continue; }
#endif
        if (stage == 0) {
            if (it < 512) ml1_item(F, it);
            else if (it < 768) lru_item<1>(F, l, it - 512);
            else if (it < 1536) hy_prep_item(F, l, it - 768);
            else attn_prep_item(F, l, it - 1536);
        } else {
            if (it < 256) hy_conv_item(F, l, stage - 1, it);
            else if (it < 512) {
                volatile unsigned* slot = (volatile unsigned*)(F.lds + SLOT_OFF);
                if (F.tid == 0) { unsigned* actr = (unsigned*)(F.ws + WS_CTL) + 64 * (32 + (l * 2 + (stage - 1)) * 8); const unsigned x0 = xb_xcc_id() & 7u; unsigned unit = 0u;
                    for (unsigned k = 0; k < 8; ++k) { const unsigned x = (x0 + k) & 7u; if (__hip_atomic_load(actr + 64 * x, __ATOMIC_RELAXED, __HIP_MEMORY_SCOPE_AGENT) >= 32u) continue;
                        const unsigned a = atomicAdd(actr + 64 * x, 1u); if (a < 32u) { unit = x * 32u + a; break; } }
                    slot[1] = unit; }
                __syncthreads();
                const int un = (int)slot[1]; const int x = un >> 5, a = un & 31; const int b_ = x >> 1, h_ = (x & 1) * 4 + (a >> 3), qb = (a & 7) + (stage == 2 ? 8 : 0);
                attn_body::attn_unit<8>(b_, h_, qb, (const attn_body::bf16*)(F.ws + WS_QB), (const attn_body::bf16*)(F.ws + WS_KB),
                                        (const attn_body::bf16*)(F.ws + WS_VB), (attn_body::bf16*)(F.ws + WS_Y) + 512, (char*)F.lds); }
            else if (stage == 1) { if (it < 768) lru_item<2>(F, l, it - 512); else ml2_item(F, it - 768); }
            else ml3_item(F, l, it - 512);
        }
    }
    __syncthreads();
}

constexpr int N_PHASES = 22;
__global__ void __launch_bounds__(512, 2) fwd_kernel(Args args) {
    extern __shared__ __attribute__((aligned(16))) unsigned char lds[];
    cg::grid_group grid = cg::this_grid();
    volatile LAS unsigned* xst = (volatile LAS unsigned*)((LAS unsigned char*)lds + SLOT_OFF + 16);
    if (threadIdx.x == 0) { xst[0] = 0u; xst[1] = 0u; }
    __syncthreads();
    const XcdBarrier xbar = xcd_barrier_post((unsigned*)(args.ws + WS_CTL) + 4096, xst);
    Frame F0; F0.lds = lds; F0.ws = args.ws; F0.in = args.in; F0.out = args.out;
    F0.tid = threadIdx.x; F0.lane = F0.tid & 63; F0.wave = __builtin_amdgcn_readfirstlane(F0.tid >> 6); F0.G = gridDim.x;
    int ph = args.ph_lo, rep = 0;
#if (MK_PROBE & 8)
#pragma unroll 1
    for (int i = 0; i < 40; ++i) grid.sync();
#endif
#pragma unroll 1
    while (ph < args.ph_hi) {
        Frame F = F0;
        { unsigned zoff = 0u; asm volatile("" : "+s"(zoff)); F.ws = F0.ws + zoff; F.out = F0.out + zoff; F.in = F0.in + zoff; F.tid = lt(); F.lane = F.tid & 63; F.wave = __builtin_amdgcn_readfirstlane(F.tid >> 6); }
        if (ph == 0) p0_prologue(F);
        else if (ph == N_PHASES - 1) final_norm_phase(F, F.out, F.in[I_FG]);
        else {
            const int l = (ph - 1) / 10, k = (ph - 1) % 10;
            const float* mod = (const float*)(F.ws + WS_MOD) + (size_t)l * 4 * 12288;
            if (k == 0 || k == 7) {
                if (ph == 1) hy_scale_reduce(F);
                const float* xin = (ph == 1) ? F.in[I_X] : F.out;
                if (k == 0) norm_phase(F, xin, F.in[I_NMG] + l * DM, mod + 0 * DM, mod + 1 * DM, (bf16*)(F.ws + WS_XN));
                else norm_phase(F, xin, F.in[I_NFG] + l * DM, mod + 3 * DM, mod + 4 * DM, (bf16*)(F.ws + WS_XN));
            } else if (k == 1) {
                pg8::Gemm g{(const pg8::bf16_t*)(F.ws + WS_XN), (const pg8::bf16_t*)(F.ws + WS_WIN) + (size_t)l * DINP * DM, MTOK, DINP, DM};
                pg8::StaticOrder S; S.init(MTOK, DINP, F.G, (int)blockIdx.x);
                pg8::EpiInProj E{(pg8::bf16_t*)(F.ws + WS_PROJ), DINP, (const float*)(F.ws + WS_BINP) + l * DINP, (float*)(F.ws + WS_GATES)};
                pg8::gemm_phase<pg8::EpiInProj, pg8::StaticOrder, true, true>((LAS unsigned char*)lds, g, S, E);
            } else if (k >= 2 && k <= 4) {
                mixer_phase(F, l, k - 2, rep);
            } else if (k == 5) {
                hy_out_phase(F);
            } else if (k == 6) {
                pg8::Gemm g{(const pg8::bf16_t*)(F.ws + WS_Y), (const pg8::bf16_t*)(F.ws + WS_WOUT) + (size_t)l * DM * DM, MTOK, DM, DM};
                pg8::StaticOrder S; S.init(MTOK, DM, F.G, (int)blockIdx.x);
                pg8::EpiResGate E{(l == 0) ? F.in[I_X] : (const float*)F.out, F.out, DM, mod + 2 * DM, 12288};
                pg8::gemm_phase<pg8::EpiResGate, pg8::StaticOrder, true, true>((LAS unsigned char*)lds, g, S, E);
            } else if (k == 8) {
                pg8::Gemm g{(const pg8::bf16_t*)(F.ws + WS_XN), (const pg8::bf16_t*)(F.ws + WS_W13) + (size_t)l * 2 * DFF * DM, MTOK, 2 * DFF, DM};
                pg8::StaticOrder S; S.init(MTOK, 2 * DFF, F.G, (int)blockIdx.x);
                pg8::EpiSwiGLU E{(pg8::bf16_t*)(F.ws + WS_PROJ), DFF};
                pg8::gemm_phase<pg8::EpiSwiGLU, pg8::StaticOrder, true, true>((LAS unsigned char*)lds, g, S, E);
            } else {
                pg8::Gemm g{(const pg8::bf16_t*)(F.ws + WS_PROJ), (const pg8::bf16_t*)(F.ws + WS_W2) + (size_t)l * DM * DFF, MTOK, DM, DFF};
                pg8::StaticOrder S; S.init(MTOK, DM, F.G, (int)blockIdx.x);
                pg8::EpiResGate E{(const float*)F.out, F.out, DM, mod + 5 * DM, 12288};
                pg8::gemm_phase<pg8::EpiResGate, pg8::StaticOrder, true, true>((LAS unsigned char*)lds, g, S, E);
            }
        }
        bool again = false;
#if MK_PROBE
        if (rep == 0) { const int kk = (ph == 0 || ph == N_PHASES - 1) ? -1 : (ph - 1) % 10;
          if ((MK_PROBE & 1) && kk >= 2 && kk <= 4) again = true;
          if ((MK_PROBE & 16) && kk == 2) again = true;
          if ((MK_PROBE & 64) && ph == 0) again = true;
          if ((MK_PROBE & 128) && (kk == 0 || kk == 7)) again = true;
          if ((MK_PROBE & 32) && kk == 3) again = true;
          if ((MK_PROBE & 2) && (kk == 1 || kk == 8)) again = true;
          if ((MK_PROBE & 4) && (kk == 0 || kk == 7 || ph == 0)) again = true; }
#endif
        if (again) rep = 1; else { rep = 0; ++ph; }
        if (ph < args.ph_hi) { if (ph == 1 && rep == 0) grid.sync(); else xcd_barrier(xbar); }
    }
}

#ifndef MK_N_LAUNCHES
#define MK_N_LAUNCHES 1
#endif
extern "C" void kernel_launch(void* const* d_in, const int* in_sizes, int n_in, void* d_out, int out_size, void* d_ws, size_t ws_size, hipStream_t stream) {
    static int grid = 0;
    if (grid == 0) {
        if (n_in != 33 || out_size != MTOK * DM || ws_size < WS_END) { fprintf(stderr, "kernel_launch: unexpected shapes (n_in %d, out %d, ws %zu < %zu)\n", n_in, out_size, ws_size, (size_t)WS_END); grid = -1; return; }
        int dev = 0, cus = 0, per_cu = 0;
        (void)hipGetDevice(&dev); (void)hipDeviceGetAttribute(&cus, hipDeviceAttributeMultiprocessorCount, dev);
        if (hipFuncSetAttribute((const void*)fwd_kernel, hipFuncAttributeMaxDynamicSharedMemorySize, LDS_BYTES) != hipSuccess) { fprintf(stderr, "kernel_launch: hipFuncSetAttribute failed\n"); grid = -1; return; }
        if (hipOccupancyMaxActiveBlocksPerMultiprocessor(&per_cu, (const void*)fwd_kernel, 512, LDS_BYTES) != hipSuccess || per_cu < 1) per_cu = 1;
        (void)hipGetLastError();
        grid = cus * per_cu;
        fprintf(stderr, "kernel_launch: grid %d (cus %d x %d), ws %zu\n", grid, cus, per_cu, ws_size);
    }
    if (grid < 0) return;
    (void)hipMemsetAsync((char*)d_ws + WS_CTL, 0, CTL_BYTES, stream);
    Args a{};
    for (int i = 0; i < 33; ++i) a.in[i] = (const float*)d_in[i];
    a.out = (float*)d_out; a.ws = (unsigned char*)d_ws;
    if (MK_N_LAUNCHES == 1) {
        a.ph_lo = 0; a.ph_hi = N_PHASES;
        void* kargs[] = {&a};
        const hipError_t e = hipLaunchCooperativeKernel((const void*)fwd_kernel, dim3(grid), dim3(512), kargs, LDS_BYTES, stream);
        if (e != hipSuccess) fprintf(stderr, "kernel_launch: cooperative launch failed: %s (grid %d)\n", hipGetErrorString(e), grid);
    } else {
        for (int ph = 0; ph < N_PHASES; ++ph) { a.ph_lo = ph; a.ph_hi = ph + 1; hipLaunchKernelGGL(fwd_kernel, dim3(grid), dim3(512), LDS_BYTES, stream, a); }
    }
}
```

```cpp
#include <hip/hip_runtime.h>
#include <hip/hip_cooperative_groups.h>
#include <hip/hip_bf16.h>
#include <cstdio>
#include <cstdint>
#include <cmath>
namespace cg = cooperative_groups;

#define LAS __attribute__((address_space(3)))
typedef unsigned short bf16;
typedef short bf16x8 __attribute__((ext_vector_type(8)));
typedef float f32x2 __attribute__((ext_vector_type(2)));
typedef float f32x4 __attribute__((ext_vector_type(4)));
typedef float f32x16 __attribute__((ext_vector_type(16)));
typedef unsigned u32x4 __attribute__((ext_vector_type(4)));
typedef unsigned u32x2 __attribute__((ext_vector_type(2)));

constexpr int DM = 2048, NBATCH = 4, SEQ = 4096, MTOK = NBATCH * SEQ, DEPTH = 2, DIN = 5392, DINP = 5632, DFF = 5632;
constexpr int C_AX = 0, C_AG = 512, C_BQ = 1024, C_BK = 1536, C_BV = 1664, C_CU = 1792, C_DQ = 3328, C_DK = 3840, C_DV = 4352, C_DO = 4864, C_GT = 5376;
constexpr float EPS = 1e-6f;

constexpr size_t MiB = (size_t)1 << 20;
constexpr size_t WS_CTL = 0, CTL_BYTES = 1 * MiB;
constexpr size_t WS_MOD = 1 * MiB;
constexpr size_t WS_HYSC = 1 * MiB + 512 * 1024;
constexpr size_t WS_BINP = 1 * MiB + 576 * 1024;
constexpr size_t WS_LRUS = 2 * MiB;
constexpr size_t WS_HYPART = 4 * MiB;
constexpr size_t WS_WIN = 8 * MiB;
constexpr size_t WS_WOUT = 52 * MiB;
constexpr size_t WS_W13 = 68 * MiB;
constexpr size_t WS_W2 = 156 * MiB;
constexpr size_t WS_HYFT = 200 * MiB;
constexpr size_t WS_LRUW = 232 * MiB;
constexpr size_t WS_MLDN = 233 * MiB;
constexpr size_t WS_MLNP = 233 * MiB + 512 * 1024;
constexpr size_t WS_MLSC = 234 * MiB;
constexpr size_t WS_GATES = 235 * MiB;
constexpr size_t WS_XN = 240 * MiB;
constexpr size_t WS_MLDC = WS_XN;
constexpr size_t WS_PROJ = 304 * MiB;
constexpr size_t WS_Y = 480 * MiB;
constexpr size_t WS_QB = 544 * MiB;
constexpr size_t WS_KB = 560 * MiB;
constexpr size_t WS_VB = 564 * MiB;
constexpr size_t WS_HT = 568 * MiB;
constexpr size_t WS_Z1T = 616 * MiB;
constexpr size_t WS_MLCT = 632 * MiB;
constexpr size_t WS_END = 664 * MiB;

constexpr int LDS_BYTES = 147456;
constexpr int SLOT_OFF = LDS_BYTES - 64;

__device__ __forceinline__ unsigned f2bf(float f) { unsigned u = __builtin_bit_cast(unsigned, f); return (u + 0x7fffu + ((u >> 16) & 1u)) >> 16; }
__device__ __forceinline__ unsigned pk2(float lo, float hi) { return f2bf(lo) | (f2bf(hi) << 16); }
__device__ __forceinline__ float bf2f(unsigned h) { return __builtin_bit_cast(float, h << 16); }
__device__ __forceinline__ float bflo(unsigned w) { return __builtin_bit_cast(float, w << 16); }
__device__ __forceinline__ float bfhi(unsigned w) { return __builtin_bit_cast(float, w & 0xffff0000u); }
__device__ __forceinline__ int lt() { int t = threadIdx.x; asm volatile("" : "+v"(t)); return t; }
__device__ __forceinline__ float shx(float v, int m) { const int l = lt() & 63; return __builtin_bit_cast(float, __builtin_amdgcn_ds_bpermute((l ^ m) << 2, __builtin_bit_cast(int, v))); }
__device__ __forceinline__ float shl_(float v, int src) { return __builtin_bit_cast(float, __builtin_amdgcn_ds_bpermute(src << 2, __builtin_bit_cast(int, v))); }
__device__ __forceinline__ float wave_sum(float v) {
#pragma unroll
    for (int o = 1; o < 64; o <<= 1) v += shx(v, o);
    return v;
}
__device__ __forceinline__ float sigmoidf_(float x) { return __builtin_amdgcn_rcpf(1.0f + __expf(-x)); }
__device__ __forceinline__ float sin_rad(float x) { return __builtin_amdgcn_sinf(x * 0.15915494309189535f); }
__device__ __forceinline__ float cos_rad(float x) { return __builtin_amdgcn_cosf(x * 0.15915494309189535f); }
__device__ __forceinline__ float logsigmoidf_(float x) { return fminf(x, 0.f) - log1pf(__expf(-fabsf(x))); }
__device__ __forceinline__ int crow(int r, int hi) { return (r & 3) + 8 * (r >> 2) + 4 * hi; }
#define LDS_WAIT() asm volatile("s_waitcnt lgkmcnt(0)" ::: "memory")


#define XB_TMO      128
#define XB_XCNT(j)  (256  + 64 * (j))
#define XB_XSUB(j)  (1280 + 64 * (j))
#define XB_XGEN(j)  (2304 + 64 * (j))
#define XB_TOP      3328
#define XB_TOPGEN   3392
#define XCD_BAR_WORDS 3456
#define XB_SPIN_CAP (1u << 18)

__device__ __forceinline__ unsigned xb_ld(unsigned* p)              { return __hip_atomic_load(p, __ATOMIC_RELAXED, __HIP_MEMORY_SCOPE_AGENT); }
__device__ __forceinline__ unsigned xb_add(unsigned* p, unsigned v) { return __hip_atomic_fetch_add(p, v, __ATOMIC_RELAXED, __HIP_MEMORY_SCOPE_AGENT); }
__device__ __forceinline__ unsigned xb_xcc_id() { return (unsigned)__builtin_amdgcn_s_getreg((3 << 11) | 20) & 0xFu; }
#define XB_SPIN(cond, bar) do { unsigned _sp = 0; while (cond) { __builtin_amdgcn_s_sleep(1); \
    if ((++_sp & 255u) == 0u) { if (xb_ld(&(bar)[XB_TMO])) break; if (_sp > XB_SPIN_CAP) { atomicAdd(&(bar)[XB_TMO], 1u); break; } } } } while (0)

struct XcdBarrier {
    unsigned* bar; unsigned x;
    volatile LAS unsigned* st;
};

__device__ __forceinline__ XcdBarrier xcd_barrier_post(unsigned* bar, volatile LAS unsigned* st) {
    XcdBarrier b; b.bar = bar; b.x = xb_xcc_id(); b.st = st;
    if (threadIdx.x == 0) (void)xb_add(&bar[XB_XCNT(b.x)], 1u);
    return b;
}
__device__ __forceinline__ void xcd_barrier_complete(unsigned* bar, unsigned x, unsigned& nloc, unsigned& nx) {
    const unsigned G = gridDim.x * gridDim.y * gridDim.z;
    unsigned sum, cnt, mine, sp = 0u;
    for (;;) {
        sum = 0u; cnt = 0u; mine = 0u;
#pragma unroll 1
        for (unsigned j = 0; j < 16; ++j) { const unsigned c = xb_ld(&bar[XB_XCNT(j)]); sum += c; cnt += (c > 0u) ? 1u : 0u; mine = (j == x) ? c : mine; }
        if (sum == G) break;
        __builtin_amdgcn_s_sleep(1);
        if ((++sp & 255u) == 0u) { if (xb_ld(&bar[XB_TMO])) break; if (sp > XB_SPIN_CAP) { atomicAdd(&bar[XB_TMO], 1u); break; } }
    }
    nloc = mine > 0u ? mine : 1u; nx = cnt > 0u ? cnt : 1u;
}

__device__ __forceinline__ void xcd_barrier(const XcdBarrier& b) {
    asm volatile("s_waitcnt vmcnt(0)" ::: "memory");
    __syncthreads();
    if (threadIdx.x == 0) {
        unsigned zo_ = 0u; asm volatile("" : "+s"(zo_));
        unsigned* bar = b.bar + zo_;
        __builtin_amdgcn_s_waitcnt(0);
        unsigned nloc = b.st[0], nx = b.st[1];
        if (nloc == 0u) { xcd_barrier_complete(bar, b.x, nloc, nx); b.st[0] = nloc; b.st[1] = nx; }
        const unsigned old = xb_add(&bar[XB_XSUB(b.x)], 1u);
        const unsigned gen = old / nloc;
        if (old + 1u == (gen + 1u) * nloc) {
            __builtin_amdgcn_fence(__ATOMIC_RELEASE, "agent");
            asm volatile("s_waitcnt vmcnt(0)" ::: "memory");
            const unsigned og = xb_add(&bar[XB_TOP], 1u);
            const unsigned tg = og / nx;
            if (og + 1u == (tg + 1u) * nx) xb_add(&bar[XB_TOPGEN], 1u);
            else XB_SPIN(xb_ld(&bar[XB_TOPGEN]) == tg, bar);
            __builtin_amdgcn_fence(__ATOMIC_ACQUIRE, "agent");
            xb_add(&bar[XB_XGEN(b.x)], 1u);
            asm volatile("s_waitcnt vmcnt(0)" ::: "memory");
        } else {
            XB_SPIN(xb_ld(&bar[XB_XGEN(b.x)]) == gen, bar);
            __builtin_amdgcn_fence(__ATOMIC_ACQUIRE, "agent");
            asm volatile("s_waitcnt vmcnt(0)" ::: "memory");
        }
    }
    __syncthreads();
}
namespace pg8 {
#define PG8_LAS __attribute__((address_space(3)))
typedef unsigned short bf16_t;
typedef short bf16x8 __attribute__((ext_vector_type(8)));
typedef float f32x4 __attribute__((ext_vector_type(4)));
typedef unsigned u32x4 __attribute__((ext_vector_type(4)));
constexpr int BM = 256, BK = 64, HALF = 128, HTB = HALF * BK * 2  , STAGE_BYTES = 8 * HTB, NXCD = 8, WGM = 8;

__host__ __device__ __forceinline__ int lds_byte(int r, int c) { const int st = (r >> 4) * 2 + (c >> 5), rr = r & 15, cc = c & 31, ob = rr * 64 + cc * 2; return st * 1024 + (ob ^ (((ob >> 9) & 1) << 5)); }
__host__ __device__ __forceinline__ void stage_rc(int b, int& R, int& C) { const int st = b / 1024, sb = b % 1024, swz = sb ^ (((sb >> 9) & 1) << 5); R = (st >> 1) * 16 + swz / 64; C = (st & 1) * 32 + (swz % 64) / 2; }
__host__ __device__ __forceinline__ int perm32(int rho) { const int n = rho >> 4, i = rho & 15; return 8 * (i >> 2) + 4 * n + (i & 3); }

struct Unit { int pm, pn; };
struct Gemm { const bf16_t* A; const bf16_t* Bt; int M, N, K; };

struct StaticOrder {
    int nM, nN, nwg, G, c;
    __host__ __device__ void init(int M, int N, int G_, int c_) { nM = M / BM; nN = N / BM; nwg = nM * nN; G = G_; c = c_; }
    __host__ __device__ bool next(int i, Unit& u) const {
        const long L = (long)i * G + c; if (L >= nwg) return false;
        int wgid = (int)L; { const int q = nwg / NXCD, r = nwg % NXCD, xcd = wgid % NXCD, off = wgid / NXCD; wgid = (xcd < r ? xcd * (q + 1) : r * (q + 1) + (xcd - r) * q) + off; }
        const int nig = WGM * nN, gid = wgid / nig, fm = gid * WGM, gsz = (nM - fm) < WGM ? (nM - fm) : WGM;
        u.pm = fm + ((wgid % nig) % gsz); u.pn = (wgid % nig) / gsz; return true;
    }
    __device__ __forceinline__ void a_ready(const Unit&) const {}
    __device__ __forceinline__ void done(const Unit&) const {}
};

__device__ __forceinline__ unsigned cvt_pk_bf16(float lo, float hi) { unsigned r; asm volatile("v_cvt_pk_bf16_f32 %0, %1, %2" : "=v"(r) : "v"(lo), "v"(hi)); return r; }

struct EpiInProj {
    static constexpr bool PERM = true, AFTER_DRAIN = false;
    bf16_t* O; int ldc; const float* bias; float* gates;
    __device__ __forceinline__ void operator()(const f32x4 (&acc)[2][2][4][2], const Unit& u, int wr, int wc, int fr, int fq) const {
        const int row0 = u.pm * BM + wr * 64 + fr; const int col0 = u.pn * BM + wc * 32 + 8 * fq;
        f32x4 bv[2][2];
#pragma unroll
        for (int bj = 0; bj < 2; ++bj)
#pragma unroll
            for (int n = 0; n < 2; ++n) bv[bj][n] = *(const f32x4*)(bias + col0 + bj * HALF + 4 * n);
        const bool gate_lane = (u.pn == 21) && (wc == 0) && (fq < 2);
#pragma unroll
        for (int ai = 0; ai < 2; ++ai)
#pragma unroll
            for (int m = 0; m < 4; ++m) { const int row = row0 + ai * HALF + m * 16; bf16_t* rowp = O + (size_t)row * ldc + col0;
#pragma unroll
                for (int bj = 0; bj < 2; ++bj) { const f32x4 v0 = acc[ai][bj][m][0] + bv[bj][0], v1 = acc[ai][bj][m][1] + bv[bj][1];
                    u32x4 w; w.x = cvt_pk_bf16(v0[0], v0[1]); w.y = cvt_pk_bf16(v0[2], v0[3]); w.z = cvt_pk_bf16(v1[0], v1[1]); w.w = cvt_pk_bf16(v1[2], v1[3]);
                    *(u32x4*)(rowp + bj * HALF) = w;
                    if (bj == 0 && gate_lane) { float* gp = gates + (size_t)row * 16 + 8 * fq; *(f32x4*)gp = v0; *(f32x4*)(gp + 4) = v1; } } }
    }
};
struct EpiResGate {
    static constexpr bool PERM = false, AFTER_DRAIN = false;
    const float* base; float* out; int ldc; const float* g; int ldg;
    __device__ __forceinline__ void operator()(const f32x4 (&acc)[2][2][4][2], const Unit& u, int wr, int wc, int fr, int fq) const {
        const int col0 = u.pn * BM + wc * 32 + 4 * fq; const int b = (u.pm * BM) >> 12;
        f32x4 gv[2][2];
#pragma unroll
        for (int bj = 0; bj < 2; ++bj)
#pragma unroll
            for (int n = 0; n < 2; ++n) gv[bj][n] = *(const f32x4*)(g + (size_t)b * ldg + col0 + bj * HALF + n * 16);
#pragma unroll
        for (int ai = 0; ai < 2; ++ai) {
            f32x4 bs[4][2][2];
#pragma unroll
            for (int m = 0; m < 4; ++m) { const int r = u.pm * BM + ai * HALF + wr * 64 + m * 16 + fr; const size_t off = (size_t)r * ldc + col0;
#pragma unroll
                for (int bj = 0; bj < 2; ++bj)
#pragma unroll
                    for (int n = 0; n < 2; ++n) bs[m][bj][n] = *(const f32x4*)(base + off + bj * HALF + n * 16); }
#pragma unroll
            for (int m = 0; m < 4; ++m) { const int r = u.pm * BM + ai * HALF + wr * 64 + m * 16 + fr; const size_t off = (size_t)r * ldc + col0;
#pragma unroll
                for (int bj = 0; bj < 2; ++bj)
#pragma unroll
                    for (int n = 0; n < 2; ++n) *(f32x4*)(out + off + bj * HALF + n * 16) = bs[m][bj][n] + gv[bj][n] * acc[ai][bj][m][n]; }
        }
    }
};
struct EpiSwiGLU {
    static constexpr bool PERM = true, AFTER_DRAIN = false;
    bf16_t* O; int ldc;
    __device__ __forceinline__ float silu(float x) const { return x * __builtin_amdgcn_rcpf(1.0f + __expf(-x)); }
    __device__ __forceinline__ void operator()(const f32x4 (&acc)[2][2][4][2], const Unit& u, int wr, int wc, int fr, int fq) const {
        const int row0 = u.pm * BM + wr * 64 + fr; const int col0 = u.pn * HALF + wc * 32 + 8 * fq;
#pragma unroll
        for (int ai = 0; ai < 2; ++ai)
#pragma unroll
            for (int m = 0; m < 4; ++m) { const int row = row0 + ai * HALF + m * 16;
                const f32x4 a0 = acc[ai][0][m][0], a1 = acc[ai][0][m][1], b0 = acc[ai][1][m][0], b1 = acc[ai][1][m][1];
                u32x4 w;
                w.x = cvt_pk_bf16(silu(a0[0]) * b0[0], silu(a0[1]) * b0[1]); w.y = cvt_pk_bf16(silu(a0[2]) * b0[2], silu(a0[3]) * b0[3]);
                w.z = cvt_pk_bf16(silu(a1[0]) * b1[0], silu(a1[1]) * b1[1]); w.w = cvt_pk_bf16(silu(a1[2]) * b1[2], silu(a1[3]) * b1[3]);
                *(u32x4*)(O + (size_t)row * ldc + col0) = w; }
    }
};

template <class Epi, class Sched, bool ALIGN_EPI = false, bool SP2 = false>
__device__ __forceinline__ void gemm_phase(PG8_LAS unsigned char* lds, const Gemm g, const Sched& S, const Epi& E) {
    const int tid = lt(), wid = __builtin_amdgcn_readfirstlane(tid >> 6), lane = tid & 63, wr = wid >> 2, wc = wid & 3, fr = lane & 15, fq = lane >> 4;
    const int K = g.K, nt = K / BK;
    unsigned voffA[2], voffB[2];
#pragma unroll
    for (int i = 0; i < 2; ++i) { int R, C; stage_rc(tid * 16 + i * 8192, R, C); const int Rb = Epi::PERM ? ((R & ~31) + perm32(R & 31)) : R;
        voffA[i] = (unsigned)(R * K + C) * 2u; voffB[i] = (unsigned)(Rb * K + C) * 2u; }
    const size_t kstep = (size_t)(BK * 2);
    const size_t hstep = (size_t)HALF * K * 2;
    const size_t tstep = 2 * hstep;
    const unsigned ldsw = (unsigned)wid * 1024u;
    const int aoff = lds_byte(wr * 64 + fr, fq * 8), boff = lds_byte(wc * 32 + fr, fq * 8);
#define PG8_SA(b, h) (((b) * 2 + (h)) * HTB)
#define PG8_SB(b, h) ((4 + (b) * 2 + (h)) * HTB)
#define PG8_STAGE(bufoff, gbase, voff) do { _Pragma("unroll") for (int _i = 0; _i < 2; ++_i) \
        __builtin_amdgcn_global_load_lds((const unsigned*)((const char*)(gbase) + (voff)[_i]), (PG8_LAS unsigned*)(lds + (bufoff) + ldsw + _i * 8192), 16, 0, 0); } while (0)
#define PG8_LDA(dst, b, h) do { _Pragma("unroll") for (int m = 0; m < 4; ++m) _Pragma("unroll") for (int k = 0; k < 2; ++k) dst[m][k] = *(const PG8_LAS bf16x8*)(lds + PG8_SA(b, h) + aoff + m * 2048 + k * 1024); } while (0)
#define PG8_LDB(dst, b, h) do { _Pragma("unroll") for (int n = 0; n < 2; ++n) _Pragma("unroll") for (int k = 0; k < 2; ++k) dst[n][k] = *(const PG8_LAS bf16x8*)(lds + PG8_SB(b, h) + boff + n * 2048 + k * 1024); } while (0)
#define PG8_MMA(ai, bj, At, Bt) do { __builtin_amdgcn_s_setprio(1); _Pragma("unroll") for (int m = 0; m < 4; ++m) _Pragma("unroll") for (int n = 0; n < 2; ++n) _Pragma("unroll") for (int k = 0; k < 2; ++k) \
        acc[ai][bj][m][n] = __builtin_amdgcn_mfma_f32_16x16x32_bf16(Bt[n][k], At[m][k], acc[ai][bj][m][n], 0, 0, 0); __builtin_amdgcn_s_setprio(0); } while (0)
#define PG8_WAIT_V(n) asm volatile("s_waitcnt vmcnt(" #n ")" ::: "memory")
#define PG8_WAIT_L(n) asm volatile("s_waitcnt lgkmcnt(" #n ")" ::: "memory")
#define PG8_BAR __builtin_amdgcn_s_barrier()
#define PG8_SCHED __builtin_amdgcn_sched_barrier(0)
    Unit cur, nxt; int ui = 0;
    if (!S.next(0, cur)) return;
    f32x4 acc[2][2][4][2];
#pragma unroll
    for (int a = 0; a < 2; ++a)
#pragma unroll
        for (int b = 0; b < 2; ++b)
#pragma unroll
            for (int m = 0; m < 4; ++m)
#pragma unroll
                for (int n = 0; n < 2; ++n) acc[a][b][m][n] = (f32x4){0.f, 0.f, 0.f, 0.f};
    bf16x8 At[4][2], B0[2][2], B1[2][2];
    const char* cA = (const char*)g.A + (size_t)cur.pm * tstep; const char* cB = (const char*)g.Bt + (size_t)cur.pn * tstep;
    S.a_ready(cur);
    if constexpr (SP2) {
        PG8_STAGE(PG8_SB(0, 0), cB, voffB); PG8_STAGE(PG8_SB(0, 1), cB + hstep, voffB); PG8_STAGE(PG8_SA(0, 0), cA, voffA); PG8_STAGE(PG8_SA(0, 1), cA + hstep, voffA);
        if (wr == 1) PG8_BAR;
        PG8_WAIT_V(2); PG8_BAR;
        PG8_STAGE(PG8_SB(1, 0), cB + kstep, voffB); PG8_STAGE(PG8_SA(1, 0), cA + kstep, voffA); PG8_STAGE(PG8_SB(1, 1), cB + hstep + kstep, voffB);
        PG8_WAIT_V(6); PG8_BAR;
    } else {
        PG8_STAGE(PG8_SB(0, 0), cB, voffB); PG8_STAGE(PG8_SA(0, 0), cA, voffA); PG8_STAGE(PG8_SB(0, 1), cB + hstep, voffB); PG8_STAGE(PG8_SA(0, 1), cA + hstep, voffA);
        if (wr == 1) PG8_BAR;
        PG8_WAIT_V(4); PG8_BAR;
        PG8_STAGE(PG8_SB(1, 0), cB + kstep, voffB); PG8_STAGE(PG8_SA(1, 0), cA + kstep, voffA); PG8_STAGE(PG8_SB(1, 1), cB + hstep + kstep, voffB);
        PG8_WAIT_V(6); PG8_BAR;
    }
    for (;;) {
        const bool has_next = S.next(ui + 1, nxt);
        const char* nA = has_next ? (const char*)g.A + (size_t)nxt.pm * tstep : cA; const char* nB = has_next ? (const char*)g.Bt + (size_t)nxt.pn * tstep : cB;
        for (int t = 0; t < nt; t += 2) {
            const bool last = (t == nt - 2);
            const char* a1 = cA + (size_t)(t + 1) * kstep;
            const char* a2 = last ? nA : cA + (size_t)(t + 2) * kstep; const char* b2 = last ? nB : cB + (size_t)(t + 2) * kstep;
            const char* a3 = a2 + kstep; const char* b3 = b2 + kstep;
            if (last && has_next) S.a_ready(nxt);
            if constexpr (SP2) {
            PG8_LDB(B0, 0, 0); PG8_LDB(B1, 0, 1); PG8_SCHED; PG8_LDA(At, 0, 0); PG8_STAGE(PG8_SA(1, 1), a1 + hstep, voffA);
            PG8_WAIT_V(8); PG8_WAIT_L(0); PG8_BAR; PG8_MMA(0, 0, At, B0); PG8_MMA(0, 1, At, B1); PG8_BAR; PG8_SCHED;
            PG8_LDA(At, 0, 1); PG8_STAGE(PG8_SB(0, 0), b2, voffB); PG8_STAGE(PG8_SB(0, 1), b2 + hstep, voffB); PG8_STAGE(PG8_SA(0, 0), a2, voffA);
            PG8_WAIT_V(8); PG8_WAIT_L(0); PG8_BAR; PG8_MMA(1, 0, At, B0); PG8_MMA(1, 1, At, B1); PG8_BAR; PG8_SCHED;
            PG8_LDB(B0, 1, 0); PG8_LDB(B1, 1, 1); PG8_SCHED; PG8_LDA(At, 1, 0); PG8_STAGE(PG8_SA(0, 1), a2 + hstep, voffA);
            PG8_WAIT_V(8); PG8_WAIT_L(0); PG8_BAR; PG8_MMA(0, 0, At, B0); PG8_MMA(0, 1, At, B1); PG8_BAR; PG8_SCHED;
            PG8_LDA(At, 1, 1); PG8_STAGE(PG8_SB(1, 0), b3, voffB); PG8_STAGE(PG8_SB(1, 1), b3 + hstep, voffB); PG8_STAGE(PG8_SA(1, 0), a3, voffA);
            PG8_WAIT_V(8); PG8_WAIT_L(0); PG8_BAR; PG8_MMA(1, 0, At, B0); PG8_MMA(1, 1, At, B1); PG8_BAR; PG8_SCHED;
            } else {
            PG8_LDB(B0, 0, 0); PG8_SCHED; PG8_LDA(At, 0, 0); PG8_STAGE(PG8_SA(1, 1), a1 + hstep, voffA);
            PG8_WAIT_L(8); PG8_BAR; PG8_WAIT_L(0); PG8_MMA(0, 0, At, B0); PG8_BAR; PG8_SCHED;
            PG8_LDB(B1, 0, 1); PG8_STAGE(PG8_SB(0, 0), b2, voffB);
            PG8_BAR; PG8_WAIT_L(0); PG8_MMA(0, 1, At, B1); PG8_BAR;
            PG8_LDA(At, 0, 1); PG8_STAGE(PG8_SA(0, 0), a2, voffA);
            PG8_BAR; PG8_WAIT_L(0); PG8_MMA(1, 0, At, B0); PG8_BAR; PG8_SCHED;
            PG8_STAGE(PG8_SB(0, 1), b2 + hstep, voffB);
            PG8_WAIT_V(6); PG8_BAR; PG8_MMA(1, 1, At, B1); PG8_BAR;
            PG8_LDB(B0, 1, 0); PG8_SCHED; PG8_LDA(At, 1, 0); PG8_STAGE(PG8_SA(0, 1), a2 + hstep, voffA);
            PG8_WAIT_L(8); PG8_BAR; PG8_WAIT_L(0); PG8_MMA(0, 0, At, B0); PG8_BAR; PG8_SCHED;
            PG8_LDB(B1, 1, 1); PG8_STAGE(PG8_SB(1, 0), b3, voffB);
            PG8_BAR; PG8_WAIT_L(0); PG8_MMA(0, 1, At, B1); PG8_BAR;
            PG8_LDA(At, 1, 1); PG8_STAGE(PG8_SA(1, 0), a3, voffA);
            PG8_BAR; PG8_WAIT_L(0); PG8_MMA(1, 0, At, B0); PG8_BAR; PG8_SCHED;
            PG8_STAGE(PG8_SB(1, 1), b3 + hstep, voffB);
            PG8_WAIT_V(6); PG8_BAR; PG8_MMA(1, 1, At, B1); PG8_BAR;
            }
        }
        if constexpr (ALIGN_EPI) { if (wr == 0) PG8_BAR; }
        if constexpr (!Epi::AFTER_DRAIN) { E(acc, cur, wr, wc, fr, fq); S.done(cur); }
        if (!has_next) break;
#pragma unroll
        for (int a = 0; a < 2; ++a)
#pragma unroll
            for (int b = 0; b < 2; ++b)
#pragma unroll
                for (int m = 0; m < 4; ++m)
#pragma unroll
                    for (int n = 0; n < 2; ++n) acc[a][b][m][n] = (f32x4){0.f, 0.f, 0.f, 0.f};
        cur = nxt; cA = nA; cB = nB; ++ui;
        if constexpr (ALIGN_EPI) { if (wr == 1) PG8_BAR; }
    }
    PG8_WAIT_V(0);
    if constexpr (!ALIGN_EPI) { if (wr == 0) PG8_BAR; }
    PG8_BAR;
    if constexpr (Epi::AFTER_DRAIN) { E.fused(acc, cur, wr, wc, fr, fq, lds, wid, lane); S.done(cur); }
#undef PG8_SA
#undef PG8_SB
#undef PG8_STAGE
#undef PG8_LDA
#undef PG8_LDB
#undef PG8_MMA
#undef PG8_WAIT_V
#undef PG8_WAIT_L
#undef PG8_BAR
#undef PG8_SCHED
}
}
namespace attn_body {
using bf16=__hip_bfloat16;
using bf16x8=__attribute__((ext_vector_type(8)))short;
using s16x4=__attribute__((ext_vector_type(4)))short;
using f32x16=__attribute__((ext_vector_type(16)))float;
using u32x4=__attribute__((ext_vector_type(4)))unsigned;
constexpr int BATCH=4,NHEAD=8,SEQ=4096,D=64,QP=512,KP=128,VP=128,OP=2048,GQ=4;
constexpr int NW=8,QBLK=32,QB=QBLK*NW,KVBLK=64,NQB=SEQ/QB;
constexpr int ATTN_UNIT_ROWS=QB;
__device__ __forceinline__ int crow(int r,int hi){return (r&3)+8*(r>>2)+4*hi;}
#define SBAR() __builtin_amdgcn_sched_barrier(0)
__device__ __forceinline__ void cmask(f32x16&p0,f32x16&p1,int jb,int qrel,int hi){
  const float NEG=-INFINITY; int kb=64*jb+4*hi;
  #pragma unroll
  for(int r=0;r<16;++r){int kv=kb+(r&3)+8*(r>>2); if(kv>qrel)p0[r]=NEG; if(kv+32>qrel)p1[r]=NEG;}
}

constexpr int NSLOT=3, SLOTB=8192;
constexpr int LDS_K=0, LDS_V=NSLOT*SLOTB, LDS_WS=2*NSLOT*SLOTB, LDS_OST=LDS_WS+NW*64*4, LDS_BYTES=LDS_OST+NW*4096;
constexpr float C2=0.125f*1.4426950408889634f;
__device__ __forceinline__ void glds16(const void*gsrc,unsigned lds_dst){unsigned keep;
  asm volatile("s_mov_b32 %0, m0\n\ts_mov_b32 m0, %2\n\ts_nop 0\n\tglobal_load_lds_dwordx4 %1, off\n\ts_mov_b32 m0, %0":"=&s"(keep):"v"(gsrc),"s"(lds_dst):"memory");}
__device__ __forceinline__ float max3f(float a,float b,float c){float r;asm("v_max3_f32 %0, %1, %2, %3":"=v"(r):"v"(a),"v"(b),"v"(c));return r;}
__device__ __forceinline__ float max2f(float a,float b){float r;asm("v_max_f32_e32 %0, %1, %2":"=v"(r):"v"(a),"v"(b));return r;}
__device__ __forceinline__ float fadd_s(float a,float b){float r;asm("v_add_f32_e32 %0, %1, %2":"=v"(r):"v"(a),"v"(b));return r;}
__device__ __forceinline__ float fsub_s(float a,float b){float r;asm("v_sub_f32_e32 %0, %1, %2":"=v"(r):"v"(a),"v"(b));return r;}
typedef float f32x2_t __attribute__((ext_vector_type(2))); typedef __bf16 bf16x2_t __attribute__((ext_vector_type(2)));
__device__ __forceinline__ unsigned cvtpk_s(float lo,float hi){f32x2_t v={lo,hi};bf16x2_t b=__builtin_convertvector(v,bf16x2_t);return __builtin_bit_cast(unsigned,b);}
#define WAIT_BAR(N) asm volatile("s_waitcnt vmcnt(" #N ") lgkmcnt(0)\n\ts_barrier":::"memory")

__device__ __forceinline__ void qkt(f32x16&p0,f32x16&p1,const char*Kslot,const bf16x8*qr,const f32x16&negm,int r32,int hi){
  const char*kb=Kslot+hi*1024+r32*16;
  #pragma unroll
  for(int d0=0;d0<4;++d0){
    const bf16x8 b0=*reinterpret_cast<const bf16x8*>(kb+d0*2048);
    const bf16x8 b1=*reinterpret_cast<const bf16x8*>(kb+d0*2048+512);
    if(d0==0){p0=__builtin_amdgcn_mfma_f32_32x32x16_bf16(b0,qr[0],negm,0,0,0);p1=__builtin_amdgcn_mfma_f32_32x32x16_bf16(b1,qr[0],negm,0,0,0);}
    else{p0=__builtin_amdgcn_mfma_f32_32x32x16_bf16(b0,qr[d0],p0,0,0,0);p1=__builtin_amdgcn_mfma_f32_32x32x16_bf16(b1,qr[d0],p1,0,0,0);}}
}
typedef __attribute__((address_space(3))) const char* lds_cptr;
typedef short v4i16_t __attribute__((ext_vector_type(4)));
__device__ __forceinline__ void kload8(bf16x8*kf,lds_cptr kp){
  kf[0]=*(const __attribute__((address_space(3))) bf16x8*)(kp);      kf[1]=*(const __attribute__((address_space(3))) bf16x8*)(kp+512);
  kf[2]=*(const __attribute__((address_space(3))) bf16x8*)(kp+2048); kf[3]=*(const __attribute__((address_space(3))) bf16x8*)(kp+2560);
  kf[4]=*(const __attribute__((address_space(3))) bf16x8*)(kp+4096); kf[5]=*(const __attribute__((address_space(3))) bf16x8*)(kp+4608);
  kf[6]=*(const __attribute__((address_space(3))) bf16x8*)(kp+6144); kf[7]=*(const __attribute__((address_space(3))) bf16x8*)(kp+6656);
}
__device__ __forceinline__ void kload2(bf16x8*kf,lds_cptr kp,int j){ kf[2*j]=*(const __attribute__((address_space(3))) bf16x8*)(kp+j*2048); kf[2*j+1]=*(const __attribute__((address_space(3))) bf16x8*)(kp+j*2048+512); }
__device__ __forceinline__ s16x4 vtr(lds_cptr p){ return __builtin_bit_cast(s16x4,__builtin_amdgcn_ds_read_tr16_b64_v4i16((__attribute__((address_space(3))) v4i16_t*)p)); }
__device__ __forceinline__ float rowmax(const f32x16&p0,const f32x16&p1){
  float a=max3f(p0[0],p0[1],p1[0]),b=max3f(p0[2],p0[3],p1[1]);a=max3f(a,p1[2],p1[3]);
  #pragma unroll
  for(int r=4;r<16;r+=4){a=max3f(a,p0[r],p0[r+1]);b=max3f(b,p0[r+2],p0[r+3]);a=max3f(a,p1[r],p1[r+1]);b=max3f(b,p1[r+2],p1[r+3]);}
  const float m=max2f(a,b);
  auto rr=__builtin_amdgcn_permlane32_swap(__float_as_uint(m),__float_as_uint(m),false,false);
  return max2f(__uint_as_float(rr[0]),__uint_as_float(rr[1]));
}
__device__ __forceinline__ void pv(f32x16*o,int vb,bf16x8 pa0,bf16x8 pa1,bf16x8 pa2,bf16x8 pa3){
  #pragma unroll
  for(int d0=0;d0<2;++d0){s16x4 lo[4],hi[4];
    #pragma unroll
    for(int ks=0;ks<4;++ks){
      asm volatile("ds_read_b64_tr_b16 %0,%1 offset:%c2":"=&v"(lo[ks]):"v"(vb),"i"(d0*4096+ks*1024):"memory");
      asm volatile("ds_read_b64_tr_b16 %0,%1 offset:%c2":"=&v"(hi[ks]):"v"(vb),"i"(d0*4096+ks*1024+512):"memory");}
    asm volatile("s_waitcnt lgkmcnt(0)":::"memory");SBAR();
    #define PK(k) (bf16x8){lo[k][0],lo[k][1],lo[k][2],lo[k][3],hi[k][0],hi[k][1],hi[k][2],hi[k][3]}
    o[d0]=__builtin_amdgcn_mfma_f32_32x32x16_bf16(pa0,PK(0),o[d0],0,0,0);
    o[d0]=__builtin_amdgcn_mfma_f32_32x32x16_bf16(pa1,PK(1),o[d0],0,0,0);
    o[d0]=__builtin_amdgcn_mfma_f32_32x32x16_bf16(pa2,PK(2),o[d0],0,0,0);
    o[d0]=__builtin_amdgcn_mfma_f32_32x32x16_bf16(pa3,PK(3),o[d0],0,0,0);
    #undef PK
  }
}

#ifndef ATTN_STORE16
#define ATTN_STORE16(p,v) (*(u32x4*)(p)=(v))
#endif
template<int THRL> __device__ __forceinline__ void attn_unit(int b,int h,int qb,const bf16*Q,const bf16*__restrict__ K,const bf16*__restrict__ V,bf16*O,char*shm){
  const int tid=lt(),lane=tid&63,r32=lane&31,hi=lane>>5; const int wid=__builtin_amdgcn_readfirstlane(tid>>6);
  const long rowbase=(long)b*SEQ; const int q0=qb*QB;
  const bf16*Qw=Q+(rowbase+q0+wid*QBLK)*QP+h*D;
  const bf16*Kh=K+rowbase*KP+(h/GQ)*D,*Vh=V+rowbase*VP+(h/GQ)*D;
  const unsigned lds0=(unsigned)(uintptr_t)shm;
  float*wsf=(float*)(shm+LDS_WS)+wid*64;
  const bf16*ksrc=Kh+(long)lane*KP+wid*8;
  const bf16*vsrc=Vh+(long)(16*(wid&3)+(lane>>2))*VP+(wid>>2)*32+(lane&3)*8;
  const unsigned kdst=lds0+LDS_K+wid*1024, vdst=lds0+LDS_V+wid*1024;
  #define DMA_K(t,slot) glds16(ksrc+(long)(t)*KVBLK*KP,(unsigned)__builtin_amdgcn_readfirstlane(kdst+(slot)))
  #define DMA_V(t,slot) glds16(vsrc+(long)(t)*KVBLK*VP,(unsigned)__builtin_amdgcn_readfirstlane(vdst+(slot)))
  const int vb0=(int)(lds0+LDS_V)+((lane>>4)&1)*32+(lane&3)*8+(4*hi+((lane&15)>>2))*64;
  const char*Kbase=shm+LDS_K; bf16x8 kf[8];
  const lds_cptr shm3=(lds_cptr)shm; const lds_cptr kp0=shm3+LDS_K+hi*1024+r32*16; const lds_cptr vp0=shm3+LDS_V+((lane>>4)&1)*32+(lane&3)*8+(4*hi+((lane&15)>>2))*64;
  const int NT=SEQ/KVBLK;
  DMA_K(0,0);DMA_V(0,0);DMA_K(1,SLOTB);
  bf16x8 qr[4];
  #pragma unroll
  for(int d0=0;d0<4;++d0)qr[d0]=*reinterpret_cast<const bf16x8*>(&Qw[(long)r32*QP+d0*16+hi*8]);
  float mhat=0.f,l_reg=0.f;f32x16 o[2];o[0]=f32x16{};o[1]=f32x16{};f32x16 negm=f32x16{};asm volatile("":"+v"(negm));
  const int qrel=wid*QBLK+r32;
  #define CMASK(P0,P1,t) do{}while(0)
  bool resc=false;
  #define START(P0,P1) do{ const float rm=rowmax(P0,P1); resc=false; \
    { const float dl=rm; mhat=fadd_s(mhat,dl); \
      _Pragma("unroll") for(int r=0;r<16;++r){P0[r]=fsub_s(P0[r],dl);P1[r]=fsub_s(P1[r],dl);} \
      _Pragma("unroll") for(int r=0;r<16;++r)negm[r]=-mhat; asm volatile("":"+v"(negm)); } \
    _Pragma("unroll") for(int r=0;r<16;++r)P0[r]=__builtin_amdgcn_exp2f(P0[r]); }while(0)
  #define RESC() do{ if(resc){ asm volatile("s_waitcnt lgkmcnt(0)":::"memory"); \
      _Pragma("unroll") for(int d_=0;d_<2;++d_) _Pragma("unroll") for(int r=0;r<16;++r)o[d_][r]*=wsf[crow(r,hi)]; } }while(0)
  f32x16 pA0,pA1,pB0,pB1;
  int sl_prev=0,sl_cur=0,sl_next=SLOTB;
  #define ROT() do{sl_prev=sl_cur;sl_cur=sl_next;sl_next=(sl_next==(NSLOT-1)*SLOTB)?0:sl_next+SLOTB;}while(0)
  DMA_K(2,2*SLOTB);
  WAIT_BAR(3);
  qkt(pA0,pA1,Kbase,qr,negm,r32,hi);asm volatile("s_nop 15\n\ts_nop 7":"+v"(pA0),"+v"(pA1));CMASK(pA0,pA1,0);
  START(pA0,pA1);
  _Pragma("unroll") for(int r=0;r<16;++r)pA1[r]=__builtin_amdgcn_exp2f(pA1[r]);
  WAIT_BAR(0);
  DMA_K(3,0);DMA_V(1,SLOTB);
  ROT();
  kload8(kf,kp0+sl_cur);
  WAIT_BAR(2);
  s16x4 vlo[8],vhi[8]; u32x4 pw0,pw1,pw2,pw3;
  #define PKW(P,B) cvtpk_s(P[B],P[B+1])
  #define PAF(k) __builtin_bit_cast(bf16x8,pw##k)
  #define VFR(i) (bf16x8){vlo[i][0],vlo[i][1],vlo[i][2],vlo[i][3],vhi[i][0],vhi[i][1],vhi[i][2],vhi[i][3]}
  #define PIN(x) asm volatile("":"+v"(x))
  #define MX3(a,b,c) __builtin_fmaxf(__builtin_fmaxf((a),(b)),(c))
  #define GAPA(MF,A0,A1,A2,A3,W0,W1,PW) do{ MF; sacc+=A0; sacc+=A1; sacc+=A2; sacc+=A3; PIN(sacc); W0; W1; PIN(PW); SBAR(); }while(0)
  #define EX(v) __builtin_amdgcn_exp2f(v)
  #define GAPB(MF,X,B) do{ MF; X[B]=EX(X[B]); X[B+1]=EX(X[B+1]); X[B+2]=EX(X[B+2]); X[B+3]=EX(X[B+3]); PIN(X); SBAR(); }while(0)
  #define VRD(i) do{ vlo[i]=vtr(vp_+(((i)>>2)*4096+((i)&3)*1024)); vhi[i]=vtr(vp_+(((i)>>2)*4096+((i)&3)*1024+512)); }while(0)
  #define KRD(G,j) do{ if(G){ kload2(kf,kp0+sl_next,j); SBAR(); } }while(0)
  #define STEP(C0,C1,P0,P1,t,GK,GV,GL) do{ SBAR(); \
    const lds_cptr vp_=vp0+sl_prev; \
    VRD(0); SBAR(); float sacc=(P0[0]+P0[1]); \
    GAPA(C0=__builtin_amdgcn_mfma_f32_32x32x16_bf16(kf[0],qr[0],negm,0,0,0), P0[2],P0[3],P0[4],P0[5],     pw0[0]=PKW(P0,0), pw0[1]=PKW(P0,2), pw0); \
    VRD(4); SBAR(); GAPA(C1=__builtin_amdgcn_mfma_f32_32x32x16_bf16(kf[1],qr[0],negm,0,0,0), P0[6],P0[7],P0[8],P0[9],     pw0[2]=PKW(P0,4), pw0[3]=PKW(P0,6), pw0); \
    VRD(1); SBAR(); GAPA(C0=__builtin_amdgcn_mfma_f32_32x32x16_bf16(kf[2],qr[1],C0,0,0,0),   P0[10],P0[11],P0[12],P0[13], pw1[0]=PKW(P0,8), pw1[1]=PKW(P0,10), pw1); \
    VRD(5); SBAR(); GAPA(C1=__builtin_amdgcn_mfma_f32_32x32x16_bf16(kf[3],qr[1],C1,0,0,0),   P0[14],P0[15],P1[0],P1[1],   pw1[2]=PKW(P0,12),pw1[3]=PKW(P0,14), pw1); \
    VRD(2); SBAR(); GAPA(C0=__builtin_amdgcn_mfma_f32_32x32x16_bf16(kf[4],qr[2],C0,0,0,0),   P1[2],P1[3],P1[4],P1[5],     pw2[0]=PKW(P1,0), pw2[1]=PKW(P1,2), pw2); \
    VRD(6); SBAR(); GAPA(C1=__builtin_amdgcn_mfma_f32_32x32x16_bf16(kf[5],qr[2],C1,0,0,0),   P1[6],P1[7],P1[8],P1[9],     pw2[2]=PKW(P1,4), pw2[3]=PKW(P1,6), pw2); \
    VRD(3); SBAR(); GAPA(C0=__builtin_amdgcn_mfma_f32_32x32x16_bf16(kf[6],qr[3],C0,0,0,0),   P1[10],P1[11],P1[12],P1[13], pw3[0]=PKW(P1,8), pw3[1]=PKW(P1,10), pw3); \
    VRD(7); SBAR(); GAPA(C1=__builtin_amdgcn_mfma_f32_32x32x16_bf16(kf[7],qr[3],C1,0,0,0),   P1[14],P1[15],0.f,0.f,       pw3[2]=PKW(P1,12),pw3[3]=PKW(P1,14), pw3); \
    l_reg+=sacc; \
    if(GK){DMA_K((t)+3,sl_cur);} if(GV){DMA_V((t)+1,sl_next);} \
    CMASK(C0,C1,t); \
    { float a=MX3(C0[0],C0[1],C1[0]),b=MX3(C0[2],C0[3],C1[1]); a=MX3(a,C1[2],C1[3]); \
      _Pragma("unroll") for(int r=4;r<16;r+=4){a=MX3(a,C0[r],C0[r+1]);b=MX3(b,C0[r+2],C0[r+3]);a=MX3(a,C1[r],C1[r+1]);b=MX3(b,C1[r+2],C1[r+3]);} \
      float rm=__builtin_fmaxf(a,b); { auto rr=__builtin_amdgcn_permlane32_swap(__float_as_uint(rm),__float_as_uint(rm),false,false); rm=__builtin_fmaxf(__uint_as_float(rr[0]),__uint_as_float(rr[1])); } \
      resc=false; \
      if(__builtin_expect(__any(rm>(float)THRL),0)){ const float dl=__builtin_fmaxf(rm,0.f); mhat+=dl; \
        _Pragma("unroll") for(int r=0;r<16;++r){C0[r]-=dl;C1[r]-=dl;} \
        _Pragma("unroll") for(int r=0;r<16;++r)negm[r]=-mhat; asm volatile("":"+v"(negm)); \
        const float f=__builtin_amdgcn_exp2f(-dl); l_reg*=f; if(hi==0)wsf[r32]=f; resc=true; } } \
    SBAR(); \
    GAPB(o[0]=__builtin_amdgcn_mfma_f32_32x32x16_bf16(PAF(0),VFR(0),o[0],0,0,0), C0,0); \
    GAPB(o[1]=__builtin_amdgcn_mfma_f32_32x32x16_bf16(PAF(0),VFR(4),o[1],0,0,0), C0,4); \
    KRD(GL,0); GAPB(o[0]=__builtin_amdgcn_mfma_f32_32x32x16_bf16(PAF(1),VFR(1),o[0],0,0,0), C0,8); \
    KRD(GL,1); GAPB(o[1]=__builtin_amdgcn_mfma_f32_32x32x16_bf16(PAF(1),VFR(5),o[1],0,0,0), C0,12); \
    KRD(GL,2); GAPB(o[0]=__builtin_amdgcn_mfma_f32_32x32x16_bf16(PAF(2),VFR(2),o[0],0,0,0), C1,0); \
    KRD(GL,3); GAPB(o[1]=__builtin_amdgcn_mfma_f32_32x32x16_bf16(PAF(2),VFR(6),o[1],0,0,0), C1,4); \
    GAPB(o[0]=__builtin_amdgcn_mfma_f32_32x32x16_bf16(PAF(3),VFR(3),o[0],0,0,0), C1,8); \
    GAPB(o[1]=__builtin_amdgcn_mfma_f32_32x32x16_bf16(PAF(3),VFR(7),o[1],0,0,0), C1,12); \
    }while(0)
  int t=1;
  #undef CMASK
  #define CMASK(P0,P1,t) do{}while(0)
  for(;t+5<NT;t+=2){
    STEP(pB0,pB1,pA0,pA1,t,true,true,true);     WAIT_BAR(2); RESC(); ROT();
    STEP(pA0,pA1,pB0,pB1,t+1,true,true,true);   WAIT_BAR(2); RESC(); ROT();
  }
  #undef CMASK
  #define CMASK(P0,P1,t) do{}while(0)
  #define ENDW(tt) do{ if((tt)+3<NT){WAIT_BAR(2);} else if((tt)+2<NT){WAIT_BAR(1);} else {WAIT_BAR(0);} }while(0)
  for(;t+1<NT;t+=2){
    STEP(pB0,pB1,pA0,pA1,t,(t+3<NT),(t+1<NT),(t+1<NT));       ENDW(t);   RESC(); ROT();
    STEP(pA0,pA1,pB0,pB1,t+1,(t+4<NT),(t+2<NT),(t+2<NT));     ENDW(t+1); RESC(); ROT();
  }
  STEP(pB0,pB1,pA0,pA1,NT-1,false,false,false); RESC();
  { float sacc=pB0[0]+pB0[1]; _Pragma("unroll") for(int r=2;r<16;++r)sacc+=pB0[r]; _Pragma("unroll") for(int r=0;r<16;++r)sacc+=pB1[r]; l_reg+=sacc;
    pw0=(u32x4){PKW(pB0,0),PKW(pB0,2),PKW(pB0,4),PKW(pB0,6)};pw1=(u32x4){PKW(pB0,8),PKW(pB0,10),PKW(pB0,12),PKW(pB0,14)};pw2=(u32x4){PKW(pB1,0),PKW(pB1,2),PKW(pB1,4),PKW(pB1,6)};pw3=(u32x4){PKW(pB1,8),PKW(pB1,10),PKW(pB1,12),PKW(pB1,14)};
    SBAR(); pv(o,vb0+sl_cur,PAF(0),PAF(1),PAF(2),PAF(3)); }
  #undef PKW
  #undef PAF
  #undef VFR
  #undef PIN
  #undef MX3
  #undef GAPA
  #undef GAPB
  #undef EX
  #undef VRD
  #undef KRD
  #undef STEP
  #undef ENDW
  {auto rr=__builtin_amdgcn_permlane32_swap(__float_as_uint(l_reg),__float_as_uint(l_reg),false,false);l_reg=__uint_as_float(rr[0])+__uint_as_float(rr[1]);}
  if(hi==0)wsf[32+r32]=l_reg;asm volatile("s_waitcnt lgkmcnt(0)":::"memory");
  float rli[16];
  #pragma unroll
  for(int r=0;r<16;++r)rli[r]=__builtin_amdgcn_rcpf(wsf[32+crow(r,hi)]);
  bf16*Ow=O+(rowbase+q0+wid*QBLK)*OP+h*D;
  { bf16*stg=(bf16*)(shm+LDS_OST)+wid*2048;
    #pragma unroll
    for(int r=0;r<16;++r){const int orow=crow(r,hi);
      #pragma unroll
      for(int d0=0;d0<2;++d0)stg[orow*64+d0*32+r32]=__float2bfloat16(o[d0][r]*rli[r]);}
    asm volatile("s_waitcnt lgkmcnt(0)":::"memory");
    #pragma unroll
    for(int i=0;i<4;++i){const int row=i*8+(lane>>3),ch=lane&7; const u32x4 v=*(const u32x4*)(stg+row*64+ch*8); ATTN_STORE16(Ow+(long)row*OP+ch*8,v);} }
  asm volatile("s_waitcnt lgkmcnt(0)\n\ts_barrier":::"memory");
  #undef DMA_K
  #undef DMA_V
  #undef CMASK
  #undef START
  #undef RESC
  #undef ROT
}
#undef SBAR
#undef WAIT_BAR
}
#ifndef MK_PROBE
#define MK_PROBE 0
#endif
#ifndef MK_PTYPE
#define MK_PTYPE 0xff
#endif

struct Args { const float* in[33]; float* out; unsigned char* ws; int ph_lo, ph_hi; };
enum { I_X = 0, I_C, I_WIN, I_BIN, I_WOUT, I_NMG, I_NFG, I_ADAW, I_ADAB, I_LCW, I_LCB, I_LWA, I_LBA, I_LWX, I_LBX, I_LLAM, I_QG, I_KG,
       I_HCW, I_HCB, I_HW1, I_HB1, I_HW2, I_HB2, I_HW3, I_HSF, I_HDEC, I_HSKIP, I_MLG, I_F1, I_F3, I_F2, I_FG };

struct Frame {
    unsigned char* lds; unsigned char* ws; const float* const* in; float* out;
    int tid, lane, wave, G;
};
#define MFMA32(a, b, c) __builtin_amdgcn_mfma_f32_32x32x16_bf16((a), (b), (c), 0, 0, 0)
#define MFMA16(a, b, c) __builtin_amdgcn_mfma_f32_16x16x32_bf16((a), (b), (c), 0, 0, 0)

__device__ __forceinline__ int next_item(unsigned* ctr, unsigned char* lds) {
    volatile unsigned* slot = (volatile unsigned*)(lds + SLOT_OFF);
    __syncthreads();
    if (threadIdx.x == 0) *slot = atomicAdd(ctr, 1u);
    __syncthreads();
    return (int)*slot;
}

__device__ __forceinline__ void transpose_item(const float* W, int K, int N, bf16* WT, int mode, float* scr, int item, int lane) {
    const int nblk = (N + 63) / 64, kb = item / nblk, nb = item % nblk, k0 = 64 * kb, n0 = 64 * nb;
    const int nl0 = 4 * (lane & 15); const bool nok = (n0 + nl0) < N;
    f32x4 v[16];
#pragma unroll
    for (int i = 0; i < 16; ++i) { const int kk = 4 * i + (lane >> 4); v[i] = nok ? *(const f32x4*)(W + (size_t)(k0 + kk) * N + n0 + nl0) : (f32x4){0.f, 0.f, 0.f, 0.f}; }
#pragma unroll
    for (int i = 0; i < 16; ++i) { const int kk = 4 * i + (lane >> 4); float* d = scr + kk * 65 + nl0; d[0] = v[i].x; d[1] = v[i].y; d[2] = v[i].z; d[3] = v[i].w; }
    LDS_WAIT();
    const int c = lane & 7;
#pragma unroll
    for (int j = 0; j < 8; ++j) { const int nl = (lane >> 3) + 8 * j; const int n = n0 + nl; const float* sp = scr + (8 * c) * 65 + nl;
        u32x4 o; o.x = pk2(sp[0 * 65], sp[1 * 65]); o.y = pk2(sp[2 * 65], sp[3 * 65]); o.z = pk2(sp[4 * 65], sp[5 * 65]); o.w = pk2(sp[6 * 65], sp[7 * 65]);
        const int dr = (mode == 0) ? n : ((n >> 7) * 256 + (n & 127) + (mode == 2 ? 128 : 0));
        if (n < N) *(u32x4*)(WT + (size_t)dr * K + k0 + 8 * c) = o; }
    LDS_WAIT();
}

__device__ __forceinline__ void p0_prologue(Frame& F) {
    const int tid = F.tid, lane = F.lane, wave = F.wave;
    const long gt = (long)blockIdx.x * 512 + tid, GT = (long)F.G * 512;
    {
        float* ca = (float*)F.lds;
        float* part = (float*)(F.lds + 32768);
        bool have = false;
        for (int it = blockIdx.x; it < 192; it += F.G) {
            if (!have) { for (int i = tid; i < 8192; i += 512) { const float c = F.in[I_C][i]; ca[i] = c * sigmoidf_(c); } have = true; }
            __syncthreads();
            const int layer = it / 96, col0 = (it % 96) * 128;
            const float* W = F.in[I_ADAW] + (size_t)layer * 2048 * 12288 + col0 + 2 * lane;
            float a00 = 0, a01 = 0, a10 = 0, a11 = 0, a20 = 0, a21 = 0, a30 = 0, a31 = 0;
            const int kb = wave * 256;
#pragma unroll 16
            for (int k = kb; k < kb + 256; ++k) { const f32x2 w = *(const f32x2*)(W + (size_t)k * 12288);
                const float c0 = ca[k], c1 = ca[2048 + k], c2 = ca[4096 + k], c3 = ca[6144 + k];
                a00 += c0 * w.x; a01 += c0 * w.y; a10 += c1 * w.x; a11 += c1 * w.y; a20 += c2 * w.x; a21 += c2 * w.y; a30 += c3 * w.x; a31 += c3 * w.y; }
            float* pp = part + (wave * 4) * 128 + 2 * lane;
            pp[0] = a00; pp[1] = a01; pp[128] = a10; pp[129] = a11; pp[256] = a20; pp[257] = a21; pp[384] = a30; pp[385] = a31;
            __syncthreads();
            { const int b = tid >> 7, col = tid & 127; float s = F.in[I_ADAB][layer * 12288 + col0 + col];
#pragma unroll
              for (int w = 0; w < 8; ++w) s += part[(w * 4 + b) * 128 + col];
              ((float*)(F.ws + WS_MOD))[(layer * 4 + b) * 12288 + col0 + col] = s; }
        }
        __syncthreads();
    }
    {
        bf16* lw = (bf16*)(F.ws + WS_LRUW);
        for (long e = gt; e < 262144; e += GT) { const int k = e & 63, j = (e >> 6) & 63, gate = (e >> 12) & 1, blk = (e >> 13) & 7, dir = (e >> 16) & 1, l = (int)(e >> 17);
            const float* src = gate ? F.in[I_LWX] : F.in[I_LWA];
            lw[e] = (bf16)f2bf(src[((((size_t)(l * 2 + dir) * 8 + blk) * 64 + k) * 64) + j]); }
        float* bp = (float*)(F.ws + WS_BINP);
        for (long e = gt; e < 2 * DINP; e += GT) { const int l = (int)(e / DINP), n = (int)(e % DINP); bp[e] = n < DIN ? F.in[I_BIN][l * DIN + n] : 0.f; }
        for (long e = gt; e < 2L * 240 * 256; e += GT) { const int l = (int)(e / (240 * 256)); const long r = e % (240 * 256);
            *(u32x4*)(F.ws + WS_WIN + (size_t)l * DINP * DM * 2 + (size_t)DIN * DM * 2 + r * 16) = (u32x4){0u, 0u, 0u, 0u}; }
    }
    {
        float* feat = (float*)F.lds; float* h1 = (float*)(F.lds + 2048); float* h2 = (float*)(F.lds + 6144); float* w1s = (float*)(F.lds + 10240); float* w2s = (float*)(F.lds + 14848);
        for (int it = blockIdx.x; it < 512; it += F.G) {
            const int l = it >> 8, pb = it & 255;
            __syncthreads();
            for (int i = tid; i < 17 * 64; i += 512) w1s[i] = F.in[I_HW1][l * 17 * 64 + i];
#pragma unroll
            for (int i = 0; i < 8; ++i) w2s[tid + 512 * i] = F.in[I_HW2][l * 4096 + tid + 512 * i];
            if (tid < 272) { const int p = tid / 17, f = tid % 17; const float pos = (float)(16 * pb + p); float val;
                if (f == 0) val = pos / 4095.0f;
                else { const int bi = (f - 1) & 7; const float band = 1e-4f + (float)bi * ((7.0f - 1e-4f) / 7.0f); const float ang = (6.283185307179586f * pos / 4096.0f) * band;
                       val = (f <= 8) ? cos_rad(ang) : -sin_rad(ang); }
                feat[p * 17 + f] = val; }
            __syncthreads();
            for (int idx = tid; idx < 1024; idx += 512) { const int p = idx >> 6, j = idx & 63; float s = F.in[I_HB1][l * 64 + j];
#pragma unroll
                for (int f = 0; f < 17; ++f) s += feat[p * 17 + f] * w1s[f * 64 + j];
                h1[idx] = sin_rad(F.in[I_HSF][l * 64 + j] * s); }
            __syncthreads();
            for (int idx = tid; idx < 1024; idx += 512) { const int p = idx >> 6, j = idx & 63; float s = F.in[I_HB2][l * 64 + j];
#pragma unroll 16
                for (int i = 0; i < 64; ++i) s += h1[p * 64 + i] * w2s[i * 64 + j];
                h2[idx] = sin_rad(F.in[I_HSF][l * 64 + j] * s); }
            __syncthreads();
            float acc[4][16];
#pragma unroll
            for (int q = 0; q < 4; ++q)
#pragma unroll
                for (int p = 0; p < 16; ++p) acc[q][p] = 0.f;
            const float* w3 = F.in[I_HW3] + (size_t)l * 64 * 2048 + tid;
#pragma unroll 8
            for (int i = 0; i < 64; ++i) { const float w0 = w3[i * 2048], w1 = w3[i * 2048 + 512], w2 = w3[i * 2048 + 1024], w3v = w3[i * 2048 + 1536];
#pragma unroll
                for (int p = 0; p < 16; ++p) { const float hv = h2[p * 64 + i]; acc[0][p] += hv * w0; acc[1][p] += hv * w1; acc[2][p] += hv * w2; acc[3][p] += hv * w3v; } }
#pragma unroll
            for (int q = 0; q < 4; ++q) { const int j = tid + 512 * q; const int o = j >> 10, dir = (j >> 9) & 1, wch = j & 511;
                const float dec = fabsf(F.in[I_HDEC][l * 2048 + j]);
                bf16* base = (bf16*)(F.ws + WS_HYFT) + ((size_t)((l * 2 + o) * 512 + wch)) * 8192;
                float ss = 0.f; float vv[16];
#pragma unroll
                for (int p = 0; p < 16; ++p) { const int pos = 16 * pb + p; const float t = (float)pos / 4095.0f; vv[p] = acc[q][p] * __expf(-t * dec); ss += vv[p] * vv[p]; }
                if (dir == 0) { bf16* fp = base + 4080 - 16 * pb;
                    *(u32x4*)fp = (u32x4){pk2(vv[15], vv[14]), pk2(vv[13], vv[12]), pk2(vv[11], vv[10]), pk2(vv[9], vv[8])};
                    *(u32x4*)(fp + 8) = (u32x4){pk2(vv[7], vv[6]), pk2(vv[5], vv[4]), pk2(vv[3], vv[2]), pk2(vv[1], vv[0])}; }
                else { bf16* bp = base + 4095 + 16 * pb;
                    if (pb > 0) bp[0] = (bf16)f2bf(vv[0]);
                    *(u32x4*)(bp + 1) = (u32x4){pk2(vv[1], vv[2]), pk2(vv[3], vv[4]), pk2(vv[5], vv[6]), pk2(vv[7], vv[8])};
                    *(u32x2*)(bp + 9) = (u32x2){pk2(vv[9], vv[10]), pk2(vv[11], vv[12])};
                    *(unsigned*)(bp + 13) = pk2(vv[13], vv[14]);
                    bp[15] = (bf16)f2bf(vv[15]);
                    if (pb == 0) base[8191] = 0; }
                ((float*)(F.ws + WS_HYPART))[(size_t)(l * 256 + pb) * 2048 + j] = ss; }
        }
        __syncthreads();
    }
    {
        float* scr = (float*)(F.lds + wave * 16640);
        unsigned* tctr = (unsigned*)(F.ws + WS_CTL) + 64 * 30;
        constexpr int I_IN = 32 * 85, I_OUT = 32 * 32, I_W1 = 32 * 88, I_W2 = 88 * 32, PER_L = I_IN + I_OUT + 2 * I_W1 + I_W2;
        for (;;) {
            unsigned base = 0u; if (lane == 0) base = atomicAdd(tctr, 4u);
            base = (unsigned)__builtin_amdgcn_readfirstlane((int)base);
            if (base >= (unsigned)(2 * PER_L)) break;
#pragma unroll 1
            for (int q = 0; q < 4; ++q) { const int it = (int)base + q; if (it >= 2 * PER_L) break;
                const int l = it / PER_L; int r = it % PER_L;
                if (r < I_IN) { transpose_item(F.in[I_WIN] + (size_t)l * DM * DIN, DM, DIN, (bf16*)(F.ws + WS_WIN) + (size_t)l * DINP * DM, 0, scr, r, lane); continue; } r -= I_IN;
                if (r < I_OUT) { transpose_item(F.in[I_WOUT] + (size_t)l * DM * DM, DM, DM, (bf16*)(F.ws + WS_WOUT) + (size_t)l * DM * DM, 0, scr, r, lane); continue; } r -= I_OUT;
                if (r < I_W1) { transpose_item(F.in[I_F1] + (size_t)l * DM * DFF, DM, DFF, (bf16*)(F.ws + WS_W13) + (size_t)l * 2 * DFF * DM, 1, scr, r, lane); continue; } r -= I_W1;
                if (r < I_W1) { transpose_item(F.in[I_F3] + (size_t)l * DM * DFF, DM, DFF, (bf16*)(F.ws + WS_W13) + (size_t)l * 2 * DFF * DM, 2, scr, r, lane); continue; } r -= I_W1;
                transpose_item(F.in[I_F2] + (size_t)l * DFF * DM, DFF, DM, (bf16*)(F.ws + WS_W2) + (size_t)l * DM * DFF, 0, scr, r, lane); }
        }
    }
}

__device__ __forceinline__ void norm_phase(Frame& F, const float* xin, const float* g, const float* sh, const float* sc, bf16* xn) {
    const int gw = blockIdx.x * 8 + F.wave, NGW = F.G * 8, lane = F.lane;
    for (int m = gw; m < MTOK; m += NGW) {
        const int b = m >> 12;
        const f32x4* xr = (const f32x4*)(xin + (size_t)m * DM) + lane;
        f32x4 v[8]; float ss = 0.f;
#pragma unroll
        for (int j = 0; j < 8; ++j) { v[j] = xr[64 * j]; ss += (v[j].x * v[j].x + v[j].y * v[j].y) + (v[j].z * v[j].z + v[j].w * v[j].w); }
        const float rstd = rsqrtf(wave_sum(ss) * (1.0f / DM) + EPS);
        f32x4 gvv[8], scvv[8], shvv[8];
#pragma unroll
        for (int j = 0; j < 8; ++j) { const int col = 4 * (lane + 64 * j);
            gvv[j] = *(const f32x4*)(g + col); scvv[j] = *(const f32x4*)(sc + (size_t)b * 12288 + col); shvv[j] = *(const f32x4*)(sh + (size_t)b * 12288 + col); }
#pragma unroll
        for (int j = 0; j < 8; ++j) { const int col = 4 * (lane + 64 * j);
            const f32x4 gv = gvv[j], scv = scvv[j], shv = shvv[j];
            const f32x4 o = (v[j] * rstd) * gv * (scv + 1.0f) + shv;
            u32x2 w; w.x = pk2(o.x, o.y); w.y = pk2(o.z, o.w);
            *(u32x2*)(xn + (size_t)m * DM + col) = w; }
    }
}
__device__ __forceinline__ void final_norm_phase(Frame& F, float* x, const float* g) {
    const int gw = blockIdx.x * 8 + F.wave, NGW = F.G * 8, lane = F.lane;
    for (int m = gw; m < MTOK; m += NGW) {
        f32x4* xr = (f32x4*)(x + (size_t)m * DM) + lane;
        f32x4 v[8]; float ss = 0.f;
#pragma unroll
        for (int j = 0; j < 8; ++j) { v[j] = xr[64 * j]; ss += (v[j].x * v[j].x + v[j].y * v[j].y) + (v[j].z * v[j].z + v[j].w * v[j].w); }
        const float rstd = rsqrtf(wave_sum(ss) * (1.0f / DM) + EPS);
        f32x4 gvv[8];
#pragma unroll
        for (int j = 0; j < 8; ++j) gvv[j] = *(const f32x4*)(g + 4 * (lane + 64 * j));
#pragma unroll
        for (int j = 0; j < 8; ++j) xr[64 * j] = (v[j] * rstd) * gvv[j];
    }
}
__device__ __forceinline__ void hy_scale_reduce(Frame& F) {
    const long gt = (long)blockIdx.x * 512 + F.tid;
    if (gt < 2048) { const int l = (int)(gt >> 10), o = (int)(gt >> 9) & 1, w = (int)gt & 511; const float* pp = (const float*)(F.ws + WS_HYPART) + (size_t)l * 256 * 2048 + o * 1024 + w;
        float s = 0.f; for (int pb = 0; pb < 256; ++pb) s += pp[(size_t)pb * 2048] + pp[(size_t)pb * 2048 + 512];
        ((float*)(F.ws + WS_HYSC))[gt] = rsqrtf(s + EPS); }
}

__device__ __forceinline__ void attn_prep_item(Frame& F, int l, int it) {
    const bf16* proj = (const bf16*)(F.ws + WS_PROJ); bf16* qb = (bf16*)(F.ws + WS_QB); bf16* kb = (bf16*)(F.ws + WS_KB);
#pragma unroll 1
    for (int pi = F.tid; pi < 768; pi += 512) {
        const int tok = pi / 12, hd = pi % 12; const int row = it * 64 + tok; const int pos = row & 4095;
        const bf16* src = proj + (size_t)row * DINP + (hd < 8 ? C_BQ + hd * 64 : (hd < 10 ? C_BK + (hd - 8) * 64 : C_BV + (hd - 10) * 64));
        u32x4 raw[8];
#pragma unroll
        for (int i = 0; i < 8; ++i) raw[i] = *(const u32x4*)(src + 8 * i);
        if (hd >= 10) {
            bf16* vd = (bf16*)(F.ws + WS_VB) + (size_t)row * 128 + (hd - 10) * 64;
#pragma unroll
            for (int i = 0; i < 8; ++i) *(u32x4*)(vd + 8 * i) = raw[i];
            continue; }
        float x[64]; float ss = 0.f;
#pragma unroll
        for (int i = 0; i < 8; ++i) { const unsigned w4[4] = {raw[i].x, raw[i].y, raw[i].z, raw[i].w};
#pragma unroll
            for (int e = 0; e < 4; ++e) { x[8 * i + 2 * e] = bflo(w4[e]); x[8 * i + 2 * e + 1] = bfhi(w4[e]); } }
#pragma unroll
        for (int i = 0; i < 64; ++i) ss += x[i] * x[i];
        const float r = rsqrtf(ss * (1.0f / 64.0f) + EPS);
        const float* g = (hd < 8 ? F.in[I_QG] : F.in[I_KG]) + l * 64;
        const float osc = (hd < 8) ? (0.125f * 1.4426950408889634f) : 1.0f;
#pragma unroll
        for (int i = 0; i < 64; ++i) x[i] = x[i] * r * g[i];
        float o[64];
#pragma unroll
        for (int seg = 0; seg < 2; ++seg) { const float p = seg ? (float)(pos & 63) : (float)(pos >> 6);
#pragma unroll
            for (int i = 0; i < 16; ++i) { const float inv = exp2f(-(float)i * (13.287712379549449f / 16.0f)); const float ang = p * inv; const float cs = cos_rad(ang), sn = sin_rad(ang);
                const float x1 = x[32 * seg + i], x2 = x[32 * seg + 16 + i];
                o[32 * seg + i] = (x1 * cs - x2 * sn) * osc; o[32 * seg + 16 + i] = (x2 * cs + x1 * sn) * osc; } }
        bf16* dst = (hd < 8) ? qb + (size_t)row * 512 + hd * 64 : kb + (size_t)row * 128 + (hd - 8) * 64;
#pragma unroll
        for (int i = 0; i < 8; ++i) *(u32x4*)(dst + 8 * i) = (u32x4){pk2(o[8 * i], o[8 * i + 1]), pk2(o[8 * i + 2], o[8 * i + 3]), pk2(o[8 * i + 4], o[8 * i + 5]), pk2(o[8 * i + 6], o[8 * i + 7])};
    }
}

__device__ __forceinline__ void hy_prep_item(Frame& F, int l, int it) {
    const bf16* proj = (const bf16*)(F.ws + WS_PROJ); bf16* ht = (bf16*)(F.ws + WS_HT);
    const int b = it / 192, rem = it % 192, tt = rem / 24, ct = rem % 24, t0 = tt * 512, c0 = ct * 64, tid = F.tid;
    float* raw = (float*)F.lds;
    u32x4 v[9];
#pragma unroll
    for (int j = 0; j < 9; ++j) { const int idx = tid + 512 * j; const int t = t0 - 1 + (idx >> 3);
        v[j] = (u32x4){0u, 0u, 0u, 0u};
        if (idx < 4112 && t >= 0 && t < SEQ) v[j] = *(const u32x4*)(proj + (size_t)(b * SEQ + t) * DINP + C_CU + c0 + (idx & 7) * 8); }
#pragma unroll
    for (int j = 0; j < 9; ++j) { const int idx = tid + 512 * j; if (idx < 4112) { float* d = raw + (idx >> 3) * 65 + (idx & 7) * 8; const unsigned w4[4] = {v[j].x, v[j].y, v[j].z, v[j].w};
#pragma unroll
        for (int e = 0; e < 4; ++e) { d[2 * e] = bflo(w4[e]); d[2 * e + 1] = bfhi(w4[e]); } } }
    __syncthreads();
    { const int ch = tid >> 3, seg = tid & 7; const int c = c0 + ch;
      const float w0 = F.in[I_HCW][(l * 3 + 0) * 1536 + c], w1 = F.in[I_HCW][(l * 3 + 1) * 1536 + c], w2 = F.in[I_HCW][(l * 3 + 2) * 1536 + c], cb = F.in[I_HCB][l * 1536 + c];
#pragma unroll
      for (int sb = 0; sb < 4; ++sb) { const int ts = 16 * (8 * sb + seg);
          unsigned pk[8];
#pragma unroll
          for (int e = 0; e < 16; e += 2) { const int tr = ts + e + 1;
              const float o0 = cb + w0 * raw[(tr - 1) * 65 + ch] + w1 * raw[tr * 65 + ch] + w2 * raw[(tr + 1) * 65 + ch];
              const float o1 = cb + w0 * raw[tr * 65 + ch] + w1 * raw[(tr + 1) * 65 + ch] + w2 * raw[(tr + 2) * 65 + ch];
              pk[e >> 1] = pk2(o0, o1); }
          u32x4* dst = (u32x4*)(ht + ((size_t)(b * 1536 + c)) * SEQ + t0 + ts);
          dst[0] = (u32x4){pk[0], pk[1], pk[2], pk[3]}; dst[1] = (u32x4){pk[4], pk[5], pk[6], pk[7]}; } }
}

__device__ __forceinline__ void hy_conv_item(Frame& F, int l, int order, int cp) {
    const int tid = F.tid, lane = F.lane, w = F.wave, r32 = lane & 31, hi = lane >> 5;
    unsigned* RVc = (unsigned*)F.lds;
    bf16* U = (bf16*)(F.lds + 65536);
    const int c0 = 2 * cp;
    { const unsigned* src = (const unsigned*)((const bf16*)(F.ws + WS_HYFT) + ((size_t)((l * 2 + order) * 512 + c0)) * 8192);
#pragma unroll
      for (int i0 = 0; i0 < 2048; i0 += 512) { const int i = tid + i0; const int cc = i >> 10, j4 = (i & 1023) * 4;
          const u32x4 a = *(const u32x4*)(src + cc * 4096 + j4); const unsigned nx = (j4 + 4 < 4096) ? src[cc * 4096 + j4 + 4] : 0u;
          *(u32x4*)(RVc + (cc * 2 + 0) * 4096 + j4) = a;
          *(u32x4*)(RVc + (cc * 2 + 1) * 4096 + j4) = (u32x4){__builtin_amdgcn_alignbit(a.y, a.x, 16), __builtin_amdgcn_alignbit(a.z, a.y, 16), __builtin_amdgcn_alignbit(a.w, a.z, 16), __builtin_amdgcn_alignbit(nx, a.w, 16)}; }
      u32x4 uv[8];
#pragma unroll
      for (int q = 0; q < 8; ++q) { const int i = tid + 512 * q; const int cc = i >> 11, b = (i >> 9) & 3, off = i & 511;
          const bf16* sp = (order == 0) ? (const bf16*)(F.ws + WS_HT) + ((size_t)(b * 1536 + c0 + cc)) * SEQ : (const bf16*)(F.ws + WS_Z1T) + ((size_t)(b * 512 + c0 + cc)) * SEQ;
          uv[q] = ((const u32x4*)sp)[off]; }
#pragma unroll
      for (int q = 0; q < 8; ++q) { const int i = tid + 512 * q; const int rowi = i >> 9, off = i & 511;
          *(u32x4*)(U + rowi * 4608 + 8 * off + (off >> 3) * 8) = uv[q]; } }
    if (tid < 32) ((unsigned*)(F.lds + 65536 + 73728))[tid] = 0u;
    __syncthreads();
    const int cc = w >> 2, b = w & 3, c = c0 + cc;
    bf16* Uc = U + (cc * 4 + b) * 4608;
    f32x16 acc[2][2];
#pragma unroll
    for (int a = 0; a < 2; ++a)
#pragma unroll
        for (int q = 0; q < 2; ++q)
#pragma unroll
            for (int r = 0; r < 16; ++r) acc[a][q][r] = 0.f;
    const unsigned lds_rv = (unsigned)(uintptr_t)(RVc + cc * 2 * 4096);
#define HY_RD(DST, ADDR, O) do { asm volatile("ds_read2_b32 %0, %1 offset0:%2 offset1:%3" : "=v"((DST)[0]) : "v"(ADDR), "i"(O), "i"((O) + 1)); \
                                 asm volatile("ds_read2_b32 %0, %1 offset0:%2 offset1:%3" : "=v"((DST)[1]) : "v"(ADDR), "i"((O) + 2), "i"((O) + 3)); } while (0)
#define HY_LDB(DST, DD) do { const int ip0_ = r32 - (DD), ip1_ = 32 + r32 - (DD); const bool ok0_ = (ip0_ >= 0) && (ip0_ < 64), ok1_ = (ip1_ >= 0) && (ip1_ < 64); \
        const bf16* p0_ = ok0_ ? (Uc + 72 * ip0_ + 8 * hi) : ZR; const bf16* p1_ = ok1_ ? (Uc + 72 * ip1_ + 8 * hi) : ZR;        \
        _Pragma("unroll") for (int ks = 0; ks < 4; ++ks) { (DST)[ks][0] = *(const bf16x8*)(p0_ + 16 * ks); (DST)[ks][1] = *(const bf16x8*)(p1_ + 16 * ks); } } while (0)
    u32x2 W[6][2], nW[4][2]; bf16x8 B[4][2], nB[4][2];
    const bf16* ZR = (const bf16*)(F.lds + 65536 + 73728);
    unsigned aaddr;
    { const int s1 = 4095 - (64 * (-63) + 32 + r32 - 8 * hi); aaddr = lds_rv + (unsigned)(s1 & 1) * 16384u + (unsigned)(s1 >> 1) * 4u; }
    HY_RD(W[0], aaddr, 40); HY_RD(W[1], aaddr, 32); HY_RD(W[2], aaddr, 24); HY_RD(W[3], aaddr, 16); HY_RD(W[4], aaddr, 8); HY_RD(W[5], aaddr, 0);
    HY_LDB(B, -63);
#pragma unroll
    for (int i = 0; i < 4; ++i) { nW[i][0] = (u32x2){0u, 0u}; nW[i][1] = (u32x2){0u, 0u}; }
#pragma unroll
    for (int ks = 0; ks < 4; ++ks) { nB[ks][0] = (bf16x8){0, 0, 0, 0, 0, 0, 0, 0}; nB[ks][1] = (bf16x8){0, 0, 0, 0, 0, 0, 0, 0}; }
    asm volatile("s_waitcnt lgkmcnt(0)" : "+v"(W[0][0]), "+v"(W[0][1]), "+v"(W[1][0]), "+v"(W[1][1]), "+v"(W[2][0]), "+v"(W[2][1]), "+v"(W[3][0]), "+v"(W[3][1]), "+v"(W[4][0]), "+v"(W[4][1]), "+v"(W[5][0]), "+v"(W[5][1]),
                                            "+v"(B[0][0]), "+v"(B[0][1]), "+v"(B[1][0]), "+v"(B[1][1]), "+v"(B[2][0]), "+v"(B[2][1]), "+v"(B[3][0]), "+v"(B[3][1]) :: "memory");
#pragma unroll 1
    for (int D = -63; D <= 63; ++D) {
        const bool v0 = (D <= 31), v1 = (D >= -31);
        const unsigned an = aaddr - 128u;
        if (D < 63) { HY_RD(nW[0], an, 24); HY_RD(nW[1], an, 16); HY_RD(nW[2], an, 8); HY_RD(nW[3], an, 0); HY_LDB(nB, D + 1); }
        __builtin_amdgcn_sched_barrier(0);
#pragma unroll
        for (int ks = 0; ks < 4; ++ks) {
            const bf16x8 a0 = __builtin_bit_cast(bf16x8, (u32x4){W[3 - ks][0].x, W[3 - ks][0].y, W[3 - ks][1].x, W[3 - ks][1].y});
            const bf16x8 a1 = __builtin_bit_cast(bf16x8, (u32x4){W[5 - ks][0].x, W[5 - ks][0].y, W[5 - ks][1].x, W[5 - ks][1].y});
            if (v0) { acc[0][0] = MFMA32(a0, B[ks][0], acc[0][0]); acc[1][0] = MFMA32(a1, B[ks][0], acc[1][0]); }
            if (v1) { acc[0][1] = MFMA32(a0, B[ks][1], acc[0][1]); acc[1][1] = MFMA32(a1, B[ks][1], acc[1][1]); } }
        __builtin_amdgcn_sched_barrier(0);
        asm volatile("s_waitcnt lgkmcnt(0)" : "+v"(nW[0][0]), "+v"(nW[0][1]), "+v"(nW[1][0]), "+v"(nW[1][1]), "+v"(nW[2][0]), "+v"(nW[2][1]), "+v"(nW[3][0]), "+v"(nW[3][1]),
                                                "+v"(nB[0][0]), "+v"(nB[0][1]), "+v"(nB[1][0]), "+v"(nB[1][1]), "+v"(nB[2][0]), "+v"(nB[2][1]), "+v"(nB[3][0]), "+v"(nB[3][1]) :: "memory");
        W[0][0] = W[4][0]; W[0][1] = W[4][1]; W[1][0] = W[5][0]; W[1][1] = W[5][1];
#pragma unroll
        for (int i = 0; i < 4; ++i) { W[2 + i][0] = nW[i][0]; W[2 + i][1] = nW[i][1]; }
#pragma unroll
        for (int ks = 0; ks < 4; ++ks) { B[ks][0] = nB[ks][0]; B[ks][1] = nB[ks][1]; }
        aaddr = an;
    }
#undef HY_RD
#undef HY_LDB
    const float scale = ((const float*)(F.ws + WS_HYSC))[(l * 2 + order) * 512 + c], sk = F.in[I_HSKIP][(l * 2 + order) * 512 + c];
#pragma unroll
    for (int jt = 0; jt < 2; ++jt)
#pragma unroll
        for (int itl = 0; itl < 2; ++itl)
            { float uu[16];
#pragma unroll
              for (int r = 0; r < 16; ++r) uu[r] = bf2f(Uc[72 * (32 * itl + r32) + 32 * jt + crow(r, hi)]);
#pragma unroll
              for (int r = 0; r < 16; ++r) Uc[72 * (32 * itl + r32) + 32 * jt + crow(r, hi)] = (bf16)f2bf(acc[jt][itl][r] * scale + sk * uu[r]); }
    LDS_WAIT();
    const bf16* gate = (const bf16*)(F.ws + WS_HT) + ((size_t)(b * 1536 + (order == 0 ? 512 : 1024) + c)) * SEQ;
    bf16* zdst = (bf16*)(F.ws + WS_Z1T) + ((size_t)(b * 512 + c)) * SEQ;
    u32x4 gvs[8];
#pragma unroll
    for (int q = 0; q < 8; ++q) gvs[q] = *(const u32x4*)(gate + 8 * lane + 512 * q);
#pragma unroll
    for (int q = 0; q < 8; ++q) { const int t = 8 * lane + 512 * q;
        const u32x4 uv = *(const u32x4*)(Uc + t + (t >> 6) * 8); const u32x4 gv = gvs[q];
        *(u32x4*)(zdst + t) = (u32x4){pk2(bflo(uv.x) * bflo(gv.x), bfhi(uv.x) * bfhi(gv.x)), pk2(bflo(uv.y) * bflo(gv.y), bfhi(uv.y) * bfhi(gv.y)),
                                      pk2(bflo(uv.z) * bflo(gv.z), bfhi(uv.z) * bfhi(gv.z)), pk2(bflo(uv.w) * bflo(gv.w), bfhi(uv.w) * bfhi(gv.w))}; }
}
__device__ __forceinline__ void hy_out_phase(Frame& F) {
    bf16* tile = (bf16*)F.lds;
    const int tid = F.tid;
    for (int it = blockIdx.x; it < 1024; it += F.G) {
        const int b = it >> 8, cb = (it >> 5) & 7, tb = it & 31;
        __syncthreads();
#pragma unroll
        for (int j = 0; j < 2; ++j) { const int idx = tid + 512 * j; const int ch = idx >> 4, t8 = (idx & 15) * 8;
            *(u32x4*)(tile + ch * 136 + t8) = *(const u32x4*)((const bf16*)(F.ws + WS_Z1T) + ((size_t)(b * 512 + 64 * cb + ch)) * SEQ + 128 * tb + t8); }
        __syncthreads();
#pragma unroll
        for (int j = 0; j < 2; ++j) { const int idx = tid + 512 * j; const int t = idx >> 3, c8 = (idx & 7) * 8; unsigned pk[4];
#pragma unroll
            for (int e = 0; e < 4; ++e) pk[e] = (unsigned)tile[(c8 + 2 * e) * 136 + t] | ((unsigned)tile[(c8 + 2 * e + 1) * 136 + t] << 16);
            *(u32x4*)((bf16*)(F.ws + WS_Y) + ((size_t)(b * SEQ + 128 * tb + t)) * DM + 1024 + 64 * cb + c8) = (u32x4){pk[0], pk[1], pk[2], pk[3]}; }
    }
    __syncthreads();
}

__device__ __forceinline__ float gelu_tanh(float x) { const float z = 0.7978845608028654f * (x + 0.044715f * x * x * x); const float t = 1.0f - 2.0f * __builtin_amdgcn_rcpf(__expf(2.0f * z) + 1.0f); return 0.5f * x * (1.0f + t); }
template <int STAGE> __device__ __forceinline__ void lru_item(Frame& F, int l, int it) {
    const bf16* proj = (const bf16*)(F.ws + WS_PROJ); bf16* Y = (bf16*)(F.ws + WS_Y);
    const int tid = F.tid, lane = F.lane, w = F.wave, r16 = lane & 15, q = lane >> 4;
    const int b = it >> 6, chunk = it & 63, t0 = chunk * 64;
    bf16* XC = (bf16*)F.lds;
    bf16* HFL = (bf16*)(F.lds + 66560);
    { const int c8 = (tid & 63) * 8, run = tid >> 6;
      u32x4 rw[11];
#pragma unroll
      for (int j = 0; j < 11; ++j) { const int tt = t0 + 8 * run - 2 + j; rw[j] = (u32x4){0u, 0u, 0u, 0u};
          if (tt >= 0 && tt < SEQ) rw[j] = *(const u32x4*)(proj + (size_t)(b * SEQ + tt) * DINP + C_AX + c8); }
      float wv[4][8], bv8[8];
#pragma unroll
      for (int e = 0; e < 8; ++e) { bv8[e] = F.in[I_LCB][l * 512 + c8 + e];
#pragma unroll
          for (int jj = 0; jj < 4; ++jj) wv[jj][e] = F.in[I_LCW][(l * 4 + jj) * 512 + c8 + e]; }
#pragma unroll
      for (int tk = 0; tk < 8; ++tk) { float o[8];
#pragma unroll
          for (int e = 0; e < 8; ++e) o[e] = bv8[e];
#pragma unroll
          for (int jj = 0; jj < 4; ++jj) { const u32x4 r4 = rw[tk + jj]; const unsigned w4[4] = {r4.x, r4.y, r4.z, r4.w};
#pragma unroll
              for (int e = 0; e < 4; ++e) { o[2 * e] += wv[jj][2 * e] * bflo(w4[e]); o[2 * e + 1] += wv[jj][2 * e + 1] * bfhi(w4[e]); } }
          *(u32x4*)(XC + (8 * run + tk) * 520 + c8) = (u32x4){pk2(o[0], o[1]), pk2(o[2], o[3]), pk2(o[4], o[5]), pk2(o[6], o[7])}; } }
    __syncthreads();
    const int blk = w;
    f32x2* sums = (f32x2*)(F.ws + WS_LRUS);
#pragma unroll 1
    for (int dir = 0; dir < 2; ++dir) {
        bf16x8 Bw[2][4][2]; float bav[4], bxv[4], lamc[4], hc[4], Ap[4];
#pragma unroll
        for (int nt = 0; nt < 4; ++nt) { const int ch = 64 * blk + 16 * nt + r16;
            bav[nt] = F.in[I_LBA][(l * 2 + dir) * 512 + ch]; bxv[nt] = F.in[I_LBX][(l * 2 + dir) * 512 + ch];
            lamc[nt] = -8.0f * log1pf(__expf(-F.in[I_LLAM][(l * 2 + dir) * 512 + ch])); hc[nt] = 0.f; Ap[nt] = 1.f;
#pragma unroll
            for (int gate = 0; gate < 2; ++gate)
#pragma unroll
                for (int ks = 0; ks < 2; ++ks)
                    Bw[gate][nt][ks] = *(const bf16x8*)((const bf16*)(F.ws + WS_LRUW) + ((((size_t)(l * 2 + dir) * 8 + blk) * 2 + gate) * 64 + 16 * nt + r16) * 64 + 32 * ks + 8 * q); }
        if (STAGE == 2) {
            const int cbeg = dir ? chunk + 1 : 0, cend = dir ? 64 : chunk;
#pragma unroll 1
            for (int ci = cbeg; ci < cend; ci += 8) { f32x2 sv[8][4];
#pragma unroll
                for (int u = 0; u < 8; ++u) { const int cu = ci + u; const int cj = dir ? (cend - 1 - (cu - cbeg)) : cu;
#pragma unroll
                    for (int nt = 0; nt < 4; ++nt) sv[u][nt] = (cu < cend) ? sums[((size_t)(b * 64 + cj) * 2 + dir) * 512 + 64 * blk + 16 * nt + r16] : (f32x2){1.f, 0.f}; }
#pragma unroll
                for (int u = 0; u < 8; ++u)
#pragma unroll
                    for (int nt = 0; nt < 4; ++nt) hc[nt] = sv[u][nt].x * hc[nt] + sv[u][nt].y; }
        }
        const int myi = dir ? 3 - q : q;
#pragma unroll 1
        for (int mi = 0; mi < 4; ++mi) { const int mt = dir ? 3 - mi : mi;
            bf16x8 af[2];
#pragma unroll
            for (int ks = 0; ks < 2; ++ks) af[ks] = *(const bf16x8*)(XC + (16 * mt + r16) * 520 + 64 * blk + 32 * ks + 8 * q);
            unsigned short gaw[4][4];
            if (STAGE == 2 && dir == 1) {
#pragma unroll
                for (int nt = 0; nt < 4; ++nt)
#pragma unroll
                    for (int r = 0; r < 4; ++r) gaw[nt][r] = proj[((size_t)b * SEQ + t0 + 16 * mt + 4 * q + r) * DINP + C_AG + 64 * blk + 16 * nt + r16]; }
#pragma unroll
            for (int nt = 0; nt < 4; ++nt) {
                f32x4 ga = (f32x4){0.f, 0.f, 0.f, 0.f}, gx = (f32x4){0.f, 0.f, 0.f, 0.f};
                ga = MFMA16(af[0], Bw[0][nt][0], ga); ga = MFMA16(af[1], Bw[0][nt][1], ga);
                gx = MFMA16(af[0], Bw[1][nt][0], gx); gx = MFMA16(af[1], Bw[1][nt][1], gx);
                float a_[4], u_[4];
#pragma unroll
                for (int r = 0; r < 4; ++r) { const int tok = 16 * mt + 4 * q + r;
                    const float rg = sigmoidf_(ga[r] + bav[nt]), ig = sigmoidf_(gx[r] + bxv[nt]);
                    const float la = lamc[nt] * rg; a_[r] = __expf(la); const float mult = __builtin_amdgcn_sqrtf(fmaxf(1.0f - a_[r] * a_[r], 0.f));
                    u_[r] = mult * ig * bf2f(XC[tok * 520 + 64 * blk + 16 * nt + r16]); }
                float ap[4], up[4];
#pragma unroll
                for (int i = 0; i < 4; ++i) { ap[i] = dir ? a_[3 - i] : a_[i]; up[i] = dir ? u_[3 - i] : u_[i]; }
                const float A = (ap[0] * ap[1]) * (ap[2] * ap[3]); const float U = ((up[0] * ap[1] + up[1]) * ap[2] + up[2]) * ap[3] + up[3];
                float h = hc[nt], hin = 0.f, aprod = 1.f;
#pragma unroll
                for (int i = 0; i < 4; ++i) { const int qs = dir ? 3 - i : i; const float Aq = shl_(A, r16 + 16 * qs), Uq = shl_(U, r16 + 16 * qs);
                    hin = (myi == i) ? h : hin; h = Aq * h + Uq; aprod *= Aq; }
                hc[nt] = h; Ap[nt] *= aprod;
                if (STAGE == 2) {
                    float hh = hin;
#pragma unroll
                    for (int i = 0; i < 4; ++i) { hh = ap[i] * hh + up[i];
                        const int r = dir ? 3 - i : i; const int tok = 16 * mt + 4 * q + r; const int ch = 64 * blk + 16 * nt + r16;
                        if (dir == 0) HFL[tok * 512 + ch] = (bf16)f2bf(hh);
                        else { const size_t row = (size_t)b * SEQ + t0 + tok; const float gav = bf2f(dir ? (i == 0 ? gaw[nt][3] : i == 1 ? gaw[nt][2] : i == 2 ? gaw[nt][1] : gaw[nt][0]) : 0);
                               Y[row * DM + ch] = (bf16)f2bf(gelu_tanh(gav) * (bf2f(HFL[tok * 512 + ch]) + hh)); } }
                }
            }
        }
        if (STAGE == 1) { if (q == 0) {
#pragma unroll
            for (int nt = 0; nt < 4; ++nt) sums[((size_t)(b * 64 + chunk) * 2 + dir) * 512 + 64 * blk + 16 * nt + r16] = (f32x2){Ap[nt], hc[nt]}; } }
        LDS_WAIT();
    }
}

__device__ __forceinline__ void ml_gates(Frame& F, float* G, int b, int h, int n) {
    const int tid = F.tid;
    __syncthreads();
    if (tid < 128) { const float* g = (const float*)(F.ws + WS_GATES) + ((size_t)b * SEQ + 128 * n + tid) * 16;
        G[tid] = g[h]; G[128 + tid] = logsigmoidf_(g[4 + h]); G[256 + tid] = g[8 + h]; G[384 + tid] = logsigmoidf_(g[12 + h]); }
    __syncthreads();
    if (tid < 256) { const int p0 = tid & 127; const bool sfx = tid >= 128; const float* src = G + (sfx ? 384 : 128); float s = 0.f;
#pragma unroll 16
        for (int p = 0; p < 128; ++p) { const float v = src[p]; s += (sfx ? (p >= p0) : (p <= p0)) ? v : 0.f; }
        G[(sfx ? 640 : 512) + p0] = s; }
    __syncthreads();
}
template <bool WITH_K> __device__ __forceinline__ void ml_load_T(Frame& F, bf16* VT, bf16* KTf, bf16* KTb, const float* Ef, const float* Eb, int b, int h, int n) {
    const bf16* proj = (const bf16*)(F.ws + WS_PROJ);
#pragma unroll
    for (int qq = 0; qq < 4; ++qq) { const int chunk = F.tid + 512 * qq; const int p = chunk & 127, cc = chunk >> 7; const size_t row = (size_t)b * SEQ + 128 * n + p;
        const u32x4 vv = *(const u32x4*)(proj + row * DINP + C_DV + 128 * h + 8 * cc);
        const unsigned vw[4] = {vv.x, vv.y, vv.z, vv.w};
#pragma unroll
        for (int e = 0; e < 4; ++e) { VT[(8 * cc + 2 * e) * 136 + p] = (bf16)(vw[e] & 0xffffu); VT[(8 * cc + 2 * e + 1) * 136 + p] = (bf16)(vw[e] >> 16); }
        if (WITH_K) { const u32x4 kv = *(const u32x4*)(proj + row * DINP + C_DK + 128 * h + 8 * cc); const unsigned kw[4] = {kv.x, kv.y, kv.z, kv.w}; const float ef = Ef[p], eb = Eb[p];
#pragma unroll
            for (int e = 0; e < 4; ++e) { const float k0 = bflo(kw[e]), k1 = bfhi(kw[e]);
                KTf[(8 * cc + 2 * e) * 136 + p] = (bf16)f2bf(k0 * ef); KTf[(8 * cc + 2 * e + 1) * 136 + p] = (bf16)f2bf(k1 * ef);
                KTb[(8 * cc + 2 * e) * 136 + p] = (bf16)f2bf(k0 * eb); KTb[(8 * cc + 2 * e + 1) * 136 + p] = (bf16)f2bf(k1 * eb); } } }
}
__device__ __forceinline__ void ml1_item(Frame& F, int it) {
    const int tid = F.tid, lane = F.lane, w = F.wave, r32 = lane & 31, hi = lane >> 5;
    const int b = it >> 7, h = (it >> 5) & 3, n = it & 31;
    bf16* VT = (bf16*)F.lds; bf16* KTf = (bf16*)(F.lds + 34816); bf16* KTb = (bf16*)(F.lds + 69632); float* G = (float*)(F.lds + 104448);
    ml_gates(F, G, b, h, n);
    float* Wd = G + 768; float* Ed = G + 1024; float* MX = G + 1280;
    if (tid < 256) { const int d = tid >> 7, p = tid & 127; Wd[tid] = d == 0 ? (G[512 + 127] - G[512 + p] + G[p]) : (G[640] - G[640 + p] + G[256 + p]); }
    __syncthreads();
    if (tid < 256) { const int d = tid >> 7, p = tid & 127; float mx = -INFINITY;
#pragma unroll 16
        for (int pp = 0; pp < 128; ++pp) mx = fmaxf(mx, Wd[d * 128 + pp]); Ed[tid] = __expf(Wd[tid] - mx); if (p == 0) MX[d] = mx; }
    __syncthreads();
    ml_load_T<true>(F, VT, KTf, KTb, Ed, Ed + 128, b, h, n);
    __syncthreads();
    const int d = w >> 2, vb = w & 3; const bf16* KT = d ? KTb : KTf;
    f32x16 acc[4];
#pragma unroll
    for (int kt = 0; kt < 4; ++kt)
#pragma unroll
        for (int r = 0; r < 16; ++r) acc[kt][r] = 0.f;
#pragma unroll
    for (int ps = 0; ps < 8; ++ps) { const bf16x8 a = *(const bf16x8*)(VT + (32 * vb + r32) * 136 + 16 * ps + 8 * hi);
#pragma unroll
        for (int kt = 0; kt < 4; ++kt) { const bf16x8 bb = *(const bf16x8*)(KT + (32 * kt + r32) * 136 + 16 * ps + 8 * hi); acc[kt] = MFMA32(a, bb, acc[kt]); } }
    const int idx = ((b * 4 + h) * 2 + d) * 32 + (d ? 31 - n : n);
    float* dst = (float*)(F.ws + WS_MLDC) + (size_t)idx * 16384;
#pragma unroll
    for (int kt = 0; kt < 4; ++kt)
#pragma unroll
        for (int r = 0; r < 16; ++r) dst[(32 * vb + crow(r, hi)) * 128 + 32 * kt + r32] = acc[kt][r];
    if (tid < 256) { const int dd = tid >> 7, k = tid & 127; const bf16* K2 = dd ? KTb : KTf; float s = 0.f; for (int p = 0; p < 128; ++p) s += bf2f(K2[k * 136 + p]);
        const int idx2 = ((b * 4 + h) * 2 + dd) * 32 + (dd ? 31 - n : n);
        ((float*)(F.ws + WS_MLDN))[(size_t)idx2 * 128 + k] = s;
        if (k == 0) { float* sc = (float*)(F.ws + WS_MLSC) + (size_t)idx2 * 4; sc[0] = MX[dd]; sc[1] = dd ? G[640] : G[512 + 127]; } }
}
__device__ __forceinline__ void ml2_item(Frame& F, int it) {
    const int tid = F.tid, bhd = it >> 3, part = it & 7, e0 = part * 2048 + tid * 4;
    const float* sc = (const float*)(F.ws + WS_MLSC); float* scw = (float*)(F.ws + WS_MLSC);
    const bool nthr = (part == 0) && (tid < 32);
    float m = 0.f; f32x4 C = (f32x4){0.f, 0.f, 0.f, 0.f}, nv = (f32x4){0.f, 0.f, 0.f, 0.f};
#pragma unroll 1
    for (int cb = 0; cb < 32; cb += 8) {
        float mlo[8], btv[8]; f32x4 dcv[8], dnv[8];
#pragma unroll
        for (int j = 0; j < 8; ++j) { const size_t idx = (size_t)bhd * 32 + cb + j; mlo[j] = sc[idx * 4]; btv[j] = sc[idx * 4 + 1];
            dcv[j] = *(const f32x4*)((const float*)(F.ws + WS_MLDC) + idx * 16384 + e0);
            dnv[j] = nthr ? *(const f32x4*)((const float*)(F.ws + WS_MLDN) + idx * 128 + 4 * tid) : (f32x4){0.f, 0.f, 0.f, 0.f}; }
#pragma unroll
        for (int j = 0; j < 8; ++j) { const size_t idx = (size_t)bhd * 32 + cb + j; const float mloc = mlo[j], bt = btv[j];
            const float mnew = fmaxf(bt + m, mloc), dec = __expf(bt + m - mnew), gn = __expf(mloc - mnew);
            *(u32x2*)((bf16*)(F.ws + WS_MLCT) + idx * 16384 + e0) = (u32x2){pk2(C.x, C.y), pk2(C.z, C.w)};
            if (nthr) *(f32x4*)((float*)(F.ws + WS_MLNP) + idx * 128 + 4 * tid) = nv;
            if (part == 0 && tid == 0) scw[idx * 4 + 2] = m;
            C = C * dec + dcv[j] * gn; nv = nv * dec + dnv[j] * gn;
            m = mnew; }
    }
}
__device__ __forceinline__ void ml3_item(Frame& F, int l, int it) {
    const bf16* proj = (const bf16*)(F.ws + WS_PROJ);
    const int tid = F.tid, lane = F.lane, w = F.wave, r32 = lane & 31, hi = lane >> 5;
    const int b = it >> 7, h = (it >> 5) & 3, n = it & 31;
    bf16* VT = (bf16*)F.lds; bf16* KN = (bf16*)(F.lds + 34816); float* HF = (float*)(F.lds + 69632); float* G = (float*)(F.lds + 135680); float* INV = (float*)(F.lds + 143872);
    ml_gates(F, G, b, h, n);
    const int idx_f = ((b * 4 + h) * 2 + 0) * 32 + n, idx_b = ((b * 4 + h) * 2 + 1) * 32 + (31 - n);
    const float mpf = ((const float*)(F.ws + WS_MLSC))[(size_t)idx_f * 4 + 2], mpb = ((const float*)(F.ws + WS_MLSC))[(size_t)idx_b * 4 + 2];
    if (tid < 128) { G[7 * 128 + tid] = G[tid] - G[512 + tid]; G[11 * 128 + tid] = G[256 + tid] - G[640 + tid]; }
    __syncthreads();
    if (tid < 128) { const int p = tid; float pm = -INFINITY;
#pragma unroll 16
        for (int s = 0; s < 128; ++s) { const float v = G[7 * 128 + s]; pm = fmaxf(pm, (s <= p) ? v : -INFINITY); }
        const float bl = G[512 + p], mint = bl + mpf, mt = fmaxf(mint, bl + pm); G[8 * 128 + p] = __expf(mint - mt); G[6 * 128 + p] = bl - mt; G[9 * 128 + p] = mt; }
    else if (tid < 256) { const int p = tid - 128; float pm = -INFINITY;
#pragma unroll 16
        for (int s = 0; s < 128; ++s) { const float v = G[11 * 128 + s]; pm = fmaxf(pm, (s >= p) ? v : -INFINITY); }
        const float bl = G[640 + p], mint = bl + mpb, mt = fmaxf(mint, bl + pm); G[12 * 128 + p] = __expf(mint - mt); G[10 * 128 + p] = bl - mt; G[13 * 128 + p] = mt; }
    else if (tid < 384) { const int k = tid - 256; G[14 * 128 + k] = ((const float*)(F.ws + WS_MLNP))[(size_t)idx_f * 128 + k]; }
    else { const int k = tid - 384; G[15 * 128 + k] = ((const float*)(F.ws + WS_MLNP))[(size_t)idx_b * 128 + k]; }
    ml_load_T<false>(F, VT, nullptr, nullptr, nullptr, nullptr, b, h, n);
    { u32x4 kv[4];
#pragma unroll
      for (int qq = 0; qq < 4; ++qq) { const int chunk = tid + 512 * qq; const int p = chunk >> 4, cc = chunk & 15; kv[qq] = *(const u32x4*)(proj + ((size_t)b * SEQ + 128 * n + p) * DINP + C_DK + 128 * h + 8 * cc); }
#pragma unroll
      for (int qq = 0; qq < 4; ++qq) { const int chunk = tid + 512 * qq; const int p = chunk >> 4, cc = chunk & 15; *(u32x4*)(KN + p * 136 + 8 * cc) = kv[qq]; } }
    __syncthreads();
    const int lb = w & 3, vh = w >> 2, ll = 32 * lb + r32;
    const float SCALE = 0.08838834764831845f;
    bf16x8 qf[8];
    { const bf16* qp = proj + ((size_t)b * SEQ + 128 * n + ll) * DINP + C_DQ + 128 * h + 8 * hi;
#pragma unroll
      for (int ks = 0; ks < 8; ++ks) qf[ks] = *(const bf16x8*)(qp + 16 * ks); }
#pragma unroll 1
    for (int d = 0; d < 2; ++d) {
        const int idx = d ? idx_b : idx_f;
        const float* RT = G + (d ? 10 : 6) * 128; const float* CF = G + (d ? 11 : 7) * 128; const float* EI = G + (d ? 12 : 8) * 128; const float* MT = G + (d ? 13 : 9) * 128; const float* NP = G + (d ? 15 : 14) * 128;
        const float rt = RT[ll], ei = EI[ll], mt = MT[ll];
        f32x16 O[2];
#pragma unroll
        for (int vt = 0; vt < 2; ++vt)
#pragma unroll
            for (int r = 0; r < 16; ++r) O[vt][r] = 0.f;
        float dsum = 0.f;
        const int st_lo = d ? lb : 0, st_hi = d ? 3 : lb;
#pragma unroll 1
        for (int st = st_lo; st <= st_hi; ++st) {
            f32x16 sacc;
#pragma unroll
            for (int r = 0; r < 16; ++r) sacc[r] = 0.f;
            const bf16* kp = KN + (32 * st + r32) * 136 + 8 * hi;
#pragma unroll
            for (int ks = 0; ks < 8; ++ks) { const bf16x8 kf = *(const bf16x8*)(kp + 16 * ks); sacc = MFMA32(kf, qf[ks], sacc); }
            float P[16];
#pragma unroll
            for (int r = 0; r < 16; ++r) { const int s_ = 32 * st + crow(r, hi); const bool ok = d ? (s_ >= ll) : (s_ <= ll);
                const float pv = ok ? sacc[r] * SCALE * __expf(rt + CF[s_]) : 0.f; P[r] = pv; dsum += pv; }
#pragma unroll
            for (int half = 0; half < 2; ++half) {
                const u32x4 pw = (u32x4){pk2(P[8 * half + 0], P[8 * half + 1]), pk2(P[8 * half + 2], P[8 * half + 3]), pk2(P[8 * half + 4], P[8 * half + 5]), pk2(P[8 * half + 6], P[8 * half + 7])};
                const bf16x8 pa = __builtin_bit_cast(bf16x8, pw);
#pragma unroll
                for (int vt = 0; vt < 2; ++vt) { const bf16* vp = VT + (32 * (2 * vh + vt) + r32) * 136 + 32 * st + 16 * half + 4 * hi;
                    const u32x2 lo = *(const u32x2*)vp, hi2 = *(const u32x2*)(vp + 8);
                    const bf16x8 bv = __builtin_bit_cast(bf16x8, (u32x4){lo.x, lo.y, hi2.x, hi2.y});
                    O[vt] = MFMA32(pa, bv, O[vt]); } } }
        const float qs = ei * SCALE; float dq = 0.f;
#pragma unroll
        for (int ks = 0; ks < 8; ++ks) { const u32x4 qw = __builtin_bit_cast(u32x4, qf[ks]); const unsigned qq[4] = {qw.x, qw.y, qw.z, qw.w}; float qv[8];
#pragma unroll
            for (int e = 0; e < 4; ++e) { qv[2 * e] = bflo(qq[e]); qv[2 * e + 1] = bfhi(qq[e]); }
#pragma unroll
            for (int e = 0; e < 8; ++e) dq += qv[e] * NP[16 * ks + 8 * hi + e];
            const u32x4 sw = (u32x4){pk2(qv[0] * qs, qv[1] * qs), pk2(qv[2] * qs, qv[3] * qs), pk2(qv[4] * qs, qv[5] * qs), pk2(qv[6] * qs, qv[7] * qs)};
            const bf16x8 qp2 = __builtin_bit_cast(bf16x8, sw);
#pragma unroll
            for (int vt = 0; vt < 2; ++vt) { const bf16x8 cf = *(const bf16x8*)((const bf16*)(F.ws + WS_MLCT) + (size_t)idx * 16384 + (32 * (2 * vh + vt) + r32) * 128 + 16 * ks + 8 * hi);
                O[vt] = MFMA32(qp2, cf, O[vt]); } }
        dsum += shx(dsum, 32); dq += shx(dq, 32);
        const float den = dsum + qs * dq;
        const float inv = 1.0f / fmaxf(fabsf(den), __expf(-mt));
        asm volatile("" ::: "memory");
        INV[w * 32 + r32] = inv;
        LDS_WAIT();
#pragma unroll
        for (int vt = 0; vt < 2; ++vt)
#pragma unroll
            for (int r = 0; r < 16; ++r) { float* hp = HF + (32 * lb + crow(r, hi)) * 129 + 32 * (2 * vh + vt) + r32; const float hv_ = O[vt][r] * INV[w * 32 + crow(r, hi)];
                *hp = d ? (*hp + hv_) : hv_; }
        LDS_WAIT();
    }
    __syncthreads();
    { const int p = tid >> 2, part = tid & 3; const size_t row = (size_t)b * SEQ + 128 * n + p;
      float hv[32]; float ss = 0.f;
#pragma unroll
      for (int e = 0; e < 32; ++e) { hv[e] = HF[p * 129 + 32 * part + e]; ss += hv[e] * hv[e]; }
      ss += shx(ss, 1); ss += shx(ss, 2);
      const float rstd = rsqrtf(ss * (1.0f / 128.0f) + EPS);
      const bf16* op = proj + row * DINP + C_DO + 128 * h + 32 * part; const float* gp = F.in[I_MLG] + l * 512 + 128 * h + 32 * part;
      bf16* yp = (bf16*)(F.ws + WS_Y) + row * DM + 1536 + 128 * h + 32 * part;
#pragma unroll
      for (int e8 = 0; e8 < 4; ++e8) { const u32x4 ov = *(const u32x4*)(op + 8 * e8); const unsigned ow[4] = {ov.x, ov.y, ov.z, ov.w}; unsigned pk[4];
#pragma unroll
          for (int e = 0; e < 4; ++e) { const float y0 = hv[8 * e8 + 2 * e] * rstd * gp[8 * e8 + 2 * e] * sigmoidf_(bflo(ow[e])); const float y1 = hv[8 * e8 + 2 * e + 1] * rstd * gp[8 * e8 + 2 * e + 1] * sigmoidf_(bfhi(ow[e])); pk[e] = pk2(y0, y1); }
          *(u32x4*)(yp + 8 * e8) = (u32x4){pk[0], pk[1], pk[2], pk[3]}; } }
}

__device__ __forceinline__ void mixer_phase(Frame& F0, int l, int stage, int rep) {
    unsigned* ctr = (unsigned*)(F0.ws + WS_CTL) + 64 * (1 + (l * 3 + stage) * 2 + rep);
    const int nitems = (stage == 0) ? 1792 : 1024;
    for (;;) {
        const int it = next_item(ctr, F0.lds);
        if (it >= nitems) break;
        Frame F = F0;
        { unsigned zoff = 0u; asm volatile("" : "+s"(zoff)); F.ws = F0.ws + zoff; F.out = F0.out + zoff; F.in = F0.in + zoff; F.tid = lt(); F.lane = F.tid & 63; F.wave = __builtin_amdgcn_readfirstlane(F.tid >> 6); }
#if MK_PROBE
        if (rep == 1) { int ty; if (stage == 0) ty = it < 512 ? 4 : (it < 768 ? 3 : 5); else ty = it < 256 ? 1 : (it < 512 ? 2 : ((stage == 1 && it < 768) ? 3 : 4));
            if (!((MK_PTYPE >> ty) & 1)) continue; }
#endif
        if (stage == 0) {
            if (it < 512) ml1_item(F, it);
            else if (it < 768) lru_item<1>(F, l, it - 512);
            else if (it < 1536) hy_prep_item(F, l, it - 768);
            else attn_prep_item(F, l, it - 1536);
        } else {
            if (it < 256) hy_conv_item(F, l, stage - 1, it);
            else if (it < 512) {
                volatile unsigned* slot = (volatile unsigned*)(F.lds + SLOT_OFF);
                if (F.tid == 0) { unsigned* actr = (unsigned*)(F.ws + WS_CTL) + 64 * (32 + (l * 2 + (stage - 1)) * 8); const unsigned x0 = xb_xcc_id() & 7u; unsigned unit = 0u;
                    for (unsigned k = 0; k < 8; ++k) { const unsigned x = (x0 + k) & 7u; if (__hip_atomic_load(actr + 64 * x, __ATOMIC_RELAXED, __HIP_MEMORY_SCOPE_AGENT) >= 32u) continue;
                        const unsigned a = atomicAdd(actr + 64 * x, 1u); if (a < 32u) { unit = x * 32u + a; break; } }
                    slot[1] = unit; }
                __syncthreads();
                const int un = (int)slot[1]; const int x = un >> 5, a = un & 31; const int b_ = x >> 1, h_ = (x & 1) * 4 + (a >> 3), qb = (a & 7) + (stage == 2 ? 8 : 0);
                attn_body::attn_unit<8>(b_, h_, qb, (const attn_body::bf16*)(F.ws + WS_QB), (const attn_body::bf16*)(F.ws + WS_KB),
                                        (const attn_body::bf16*)(F.ws + WS_VB), (attn_body::bf16*)(F.ws + WS_Y) + 512, (char*)F.lds); }
            else if (stage == 1) { if (it < 768) lru_item<2>(F, l, it - 512); else ml2_item(F, it - 768); }
            else ml3_item(F, l, it - 512);
        }
    }
    __syncthreads();
}

constexpr int N_PHASES = 22;
__global__ void __launch_bounds__(512, 2) fwd_kernel(Args args) {
    extern __shared__ __attribute__((aligned(16))) unsigned char lds[];
    cg::grid_group grid = cg::this_grid();
    volatile LAS unsigned* xst = (volatile LAS unsigned*)((LAS unsigned char*)lds + SLOT_OFF + 16);
    if (threadIdx.x == 0) { xst[0] = 0u; xst[1] = 0u; }
    __syncthreads();
    const XcdBarrier xbar = xcd_barrier_post((unsigned*)(args.ws + WS_CTL) + 4096, xst);
    Frame F0; F0.lds = lds; F0.ws = args.ws; F0.in = args.in; F0.out = args.out;
    F0.tid = threadIdx.x; F0.lane = F0.tid & 63; F0.wave = __builtin_amdgcn_readfirstlane(F0.tid >> 6); F0.G = gridDim.x;
    int ph = args.ph_lo, rep = 0;
#if (MK_PROBE & 8)
#pragma unroll 1
    for (int i = 0; i < 40; ++i) grid.sync();
#endif
#pragma unroll 1
    while (ph < args.ph_hi) {
        Frame F = F0;
        { unsigned zoff = 0u; asm volatile("" : "+s"(zoff)); F.ws = F0.ws + zoff; F.out = F0.out + zoff; F.in = F0.in + zoff; F.tid = lt(); F.lane = F.tid & 63; F.wave = __builtin_amdgcn_readfirstlane(F.tid >> 6); }
        if (ph == 0) p0_prologue(F);
        else if (ph == N_PHASES - 1) final_norm_phase(F, F.out, F.in[I_FG]);
        else {
            const int l = (ph - 1) / 10, k = (ph - 1) % 10;
            const float* mod = (const float*)(F.ws + WS_MOD) + (size_t)l * 4 * 12288;
            if (k == 0 || k == 7) {
                if (ph == 1) hy_scale_reduce(F);
                const float* xin = (ph == 1) ? F.in[I_X] : F.out;
                if (k == 0) norm_phase(F, xin, F.in[I_NMG] + l * DM, mod + 0 * DM, mod + 1 * DM, (bf16*)(F.ws + WS_XN));
                else norm_phase(F, xin, F.in[I_NFG] + l * DM, mod + 3 * DM, mod + 4 * DM, (bf16*)(F.ws + WS_XN));
            } else if (k == 1) {
                pg8::Gemm g{(const pg8::bf16_t*)(F.ws + WS_XN), (const pg8::bf16_t*)(F.ws + WS_WIN) + (size_t)l * DINP * DM, MTOK, DINP, DM};
                pg8::StaticOrder S; S.init(MTOK, DINP, F.G, (int)blockIdx.x);
                pg8::EpiInProj E{(pg8::bf16_t*)(F.ws + WS_PROJ), DINP, (const float*)(F.ws + WS_BINP) + l * DINP, (float*)(F.ws + WS_GATES)};
                pg8::gemm_phase<pg8::EpiInProj, pg8::StaticOrder, true, true>((LAS unsigned char*)lds, g, S, E);
            } else if (k >= 2 && k <= 4) {
                mixer_phase(F, l, k - 2, rep);
            } else if (k == 5) {
                hy_out_phase(F);
            } else if (k == 6) {
                pg8::Gemm g{(const pg8::bf16_t*)(F.ws + WS_Y), (const pg8::bf16_t*)(F.ws + WS_WOUT) + (size_t)l * DM * DM, MTOK, DM, DM};
                pg8::StaticOrder S; S.init(MTOK, DM, F.G, (int)blockIdx.x);
                pg8::EpiResGate E{(l == 0) ? F.in[I_X] : (const float*)F.out, F.out, DM, mod + 2 * DM, 12288};
                pg8::gemm_phase<pg8::EpiResGate, pg8::StaticOrder, true, true>((LAS unsigned char*)lds, g, S, E);
            } else if (k == 8) {
                pg8::Gemm g{(const pg8::bf16_t*)(F.ws + WS_XN), (const pg8::bf16_t*)(F.ws + WS_W13) + (size_t)l * 2 * DFF * DM, MTOK, 2 * DFF, DM};
                pg8::StaticOrder S; S.init(MTOK, 2 * DFF, F.G, (int)blockIdx.x);
                pg8::EpiSwiGLU E{(pg8::bf16_t*)(F.ws + WS_PROJ), DFF};
                pg8::gemm_phase<pg8::EpiSwiGLU, pg8::StaticOrder, true, true>((LAS unsigned char*)lds, g, S, E);
            } else {
                pg8::Gemm g{(const pg8::bf16_t*)(F.ws + WS_PROJ), (const pg8::bf16_t*)(F.ws + WS_W2) + (size_t)l * DM * DFF, MTOK, DM, DFF};
                pg8::StaticOrder S; S.init(MTOK, DM, F.G, (int)blockIdx.x);
                pg8::EpiResGate E{(const float*)F.out, F.out, DM, mod + 5 * DM, 12288};
                pg8::gemm_phase<pg8::EpiResGate, pg8::StaticOrder, true, true>((LAS unsigned char*)lds, g, S, E);
            }
        }
        bool again = false;
#if MK_PROBE
        if (rep == 0) { const int kk = (ph == 0 || ph == N_PHASES - 1) ? -1 : (ph - 1) % 10;
          if ((MK_PROBE & 1) && kk >= 2 && kk <= 4) again = true;
          if ((MK_PROBE & 16) && kk == 2) again = true;
          if ((MK_PROBE & 64) && ph == 0) again = true;
          if ((MK_PROBE & 128) && (kk == 0 || kk == 7)) again = true;
          if ((MK_PROBE & 32) && kk == 3) again = true;
          if ((MK_PROBE & 2) && (kk == 1 || kk == 8)) again = true;
          if ((MK_PROBE & 4) && (kk == 0 || kk == 7 || ph == 0)) again = true; }
#endif
        if (again) rep = 1; else { rep = 0; ++ph; }
        if (ph < args.ph_hi) { if (ph == 1 && rep == 0) grid.sync(); else xcd_barrier(xbar); }
    }
}

#ifndef MK_N_LAUNCHES
#define MK_N_LAUNCHES 1
#endif
extern "C" void kernel_launch(void* const* d_in, const int* in_sizes, int n_in, void* d_out, int out_size, void* d_ws, size_t ws_size, hipStream_t stream) {
    static int grid = 0;
    if (grid == 0) {
        if (n_in != 33 || out_size != MTOK * DM || ws_size < WS_END) { fprintf(stderr, "kernel_launch: unexpected shapes (n_in %d, out %d, ws %zu < %zu)\n", n_in, out_size, ws_size, (size_t)WS_END); grid = -1; return; }
        int dev = 0, cus = 0, per_cu = 0;
        (void)hipGetDevice(&dev); (void)hipDeviceGetAttribute(&cus, hipDeviceAttributeMultiprocessorCount, dev);
        if (hipFuncSetAttribute((const void*)fwd_kernel, hipFuncAttributeMaxDynamicSharedMemorySize, LDS_BYTES) != hipSuccess) { fprintf(stderr, "kernel_launch: hipFuncSetAttribute failed\n"); grid = -1; return; }
        if (hipOccupancyMaxActiveBlocksPerMultiprocessor(&per_cu, (const void*)fwd_kernel, 512, LDS_BYTES) != hipSuccess || per_cu < 1) per_cu = 1;
        (void)hipGetLastError();
        grid = cus * per_cu;
        fprintf(stderr, "kernel_launch: grid %d (cus %d x %d), ws %zu\n", grid, cus, per_cu, ws_size);
    }
    if (grid < 0) return;
    (void)hipMemsetAsync((char*)d_ws + WS_CTL, 0, CTL_BYTES, stream);
    Args a{};
    for (int i = 0; i < 33; ++i) a.in[i] = (const float*)d_in[i];
    a.out = (float*)d_out; a.ws = (unsigned char*)d_ws;
    if (MK_N_LAUNCHES == 1) {
        a.ph_lo = 0; a.ph_hi = N_PHASES;
        void* kargs[] = {&a};
        const hipError_t e = hipLaunchCooperativeKernel((const void*)fwd_kernel, dim3(grid), dim3(512), kargs, LDS_BYTES, stream);
        if (e != hipSuccess) fprintf(stderr, "kernel_launch: cooperative launch failed: %s (grid %d)\n", hipGetErrorString(e), grid);
    } else {
        for (int ph = 0; ph < N_PHASES; ++ph) { a.ph_lo = ph; a.ph_hi = ph + 1; hipLaunchKernelGGL(fwd_kernel, dim3(grid), dim3(512), LDS_BYTES, stream, a); }
    }
}
```

```cpp
#include <hip/hip_runtime.h>
#include <hip/hip_cooperative_groups.h>
#include <hip/hip_bf16.h>
#include <cstdio>
#include <cstdint>
#include <cmath>
namespace cg = cooperative_groups;

#define LAS __attribute__((address_space(3)))
typedef unsigned short bf16;
typedef short bf16x8 __attribute__((ext_vector_type(8)));
typedef float f32x2 __attribute__((ext_vector_type(2)));
typedef float f32x4 __attribute__((ext_vector_type(4)));
typedef float f32x16 __attribute__((ext_vector_type(16)));
typedef unsigned u32x4 __attribute__((ext_vector_type(4)));
typedef unsigned u32x2 __attribute__((ext_vector_type(2)));

constexpr int DM = 2048, NBATCH = 4, SEQ = 4096, MTOK = NBATCH * SEQ, DEPTH = 2, DIN = 5392, DINP = 5632, DFF = 5632;
constexpr int C_AX = 0, C_AG = 512, C_BQ = 1024, C_BK = 1536, C_BV = 1664, C_CU = 1792, C_DQ = 3328, C_DK = 3840, C_DV = 4352, C_DO = 4864, C_GT = 5376;
constexpr float EPS = 1e-6f;

constexpr size_t MiB = (size_t)1 << 20;
constexpr size_t WS_CTL = 0, CTL_BYTES = 1 * MiB;
constexpr size_t WS_MOD = 1 * MiB;
constexpr size_t WS_HYSC = 1 * MiB + 512 * 1024;
constexpr size_t WS_BINP = 1 * MiB + 576 * 1024;
constexpr size_t WS_LRUS = 2 * MiB;
constexpr size_t WS_HYPART = 4 * MiB;
constexpr size_t WS_WIN = 8 * MiB;
constexpr size_t WS_WOUT = 52 * MiB;
constexpr size_t WS_W13 = 68 * MiB;
constexpr size_t WS_W2 = 156 * MiB;
constexpr size_t WS_HYFT = 200 * MiB;
constexpr size_t WS_LRUW = 232 * MiB;
constexpr size_t WS_MLDN = 233 * MiB;
constexpr size_t WS_MLNP = 233 * MiB + 512 * 1024;
constexpr size_t WS_MLSC = 234 * MiB;
constexpr size_t WS_GATES = 235 * MiB;
constexpr size_t WS_XN = 240 * MiB;
constexpr size_t WS_MLDC = WS_XN;
constexpr size_t WS_PROJ = 304 * MiB;
constexpr size_t WS_Y = 480 * MiB;
constexpr size_t WS_QB = 544 * MiB;
constexpr size_t WS_KB = 560 * MiB;
constexpr size_t WS_VB = 564 * MiB;
constexpr size_t WS_HT = 568 * MiB;
constexpr size_t WS_Z1T = 616 * MiB;
constexpr size_t WS_MLCT = 632 * MiB;
constexpr size_t WS_END = 664 * MiB;

constexpr int LDS_BYTES = 147456;
constexpr int SLOT_OFF = LDS_BYTES - 64;

__device__ __forceinline__ unsigned f2bf(float f) { unsigned u = __builtin_bit_cast(unsigned, f); return (u + 0x7fffu + ((u >> 16) & 1u)) >> 16; }
__device__ __forceinline__ unsigned pk2(float lo, float hi) { return f2bf(lo) | (f2bf(hi) << 16); }
__device__ __forceinline__ float bf2f(unsigned h) { return __builtin_bit_cast(float, h << 16); }
__device__ __forceinline__ float bflo(unsigned w) { return __builtin_bit_cast(float, w << 16); }
__device__ __forceinline__ float bfhi(unsigned w) { return __builtin_bit_cast(float, w & 0xffff0000u); }
__device__ __forceinline__ int lt() { int t = threadIdx.x; asm volatile("" : "+v"(t)); return t; }
__device__ __forceinline__ float shx(float v, int m) { const int l = lt() & 63; return __builtin_bit_cast(float, __builtin_amdgcn_ds_bpermute((l ^ m) << 2, __builtin_bit_cast(int, v))); }
__device__ __forceinline__ float shl_(float v, int src) { return __builtin_bit_cast(float, __builtin_amdgcn_ds_bpermute(src << 2, __builtin_bit_cast(int, v))); }
__device__ __forceinline__ float wave_sum(float v) {
#pragma unroll
    for (int o = 1; o < 64; o <<= 1) v += shx(v, o);
    return v;
}
__device__ __forceinline__ float sigmoidf_(float x) { return __builtin_amdgcn_rcpf(1.0f + __expf(-x)); }
__device__ __forceinline__ float sin_rad(float x) { return __builtin_amdgcn_sinf(x * 0.15915494309189535f); }
__device__ __forceinline__ float cos_rad(float x) { return __builtin_amdgcn_cosf(x * 0.15915494309189535f); }
__device__ __forceinline__ float logsigmoidf_(float x) { return fminf(x, 0.f) - log1pf(__expf(-fabsf(x))); }
__device__ __forceinline__ int crow(int r, int hi) { return (r & 3) + 8 * (r >> 2) + 4 * hi; }
#define LDS_WAIT() asm volatile("s_waitcnt lgkmcnt(0)" ::: "memory")


#define XB_TMO      128
#define XB_XCNT(j)  (256  + 64 * (j))
#define XB_XSUB(j)  (1280 + 64 * (j))
#define XB_XGEN(j)  (2304 + 64 * (j))
#define XB_TOP      3328
#define XB_TOPGEN   3392
#define XCD_BAR_WORDS 3456
#define XB_SPIN_CAP (1u << 18)

__device__ __forceinline__ unsigned xb_ld(unsigned* p)              { return __hip_atomic_load(p, __ATOMIC_RELAXED, __HIP_MEMORY_SCOPE_AGENT); }
__device__ __forceinline__ unsigned xb_add(unsigned* p, unsigned v) { return __hip_atomic_fetch_add(p, v, __ATOMIC_RELAXED, __HIP_MEMORY_SCOPE_AGENT); }
__device__ __forceinline__ unsigned xb_xcc_id() { return (unsigned)__builtin_amdgcn_s_getreg((3 << 11) | 20) & 0xFu; }
#define XB_SPIN(cond, bar) do { unsigned _sp = 0; while (cond) { __builtin_amdgcn_s_sleep(1); \
    if ((++_sp & 255u) == 0u) { if (xb_ld(&(bar)[XB_TMO])) break; if (_sp > XB_SPIN_CAP) { atomicAdd(&(bar)[XB_TMO], 1u); break; } } } } while (0)

struct XcdBarrier {
    unsigned* bar; unsigned x;
    volatile LAS unsigned* st;
};

__device__ __forceinline__ XcdBarrier xcd_barrier_post(unsigned* bar, volatile LAS unsigned* st) {
    XcdBarrier b; b.bar = bar; b.x = xb_xcc_id(); b.st = st;
    if (threadIdx.x == 0) (void)xb_add(&bar[XB_XCNT(b.x)], 1u);
    return b;
}
__device__ __forceinline__ void xcd_barrier_complete(unsigned* bar, unsigned x, unsigned& nloc, unsigned& nx) {
    const unsigned G = gridDim.x * gridDim.y * gridDim.z;
    unsigned sum, cnt, mine, sp = 0u;
    for (;;) {
        sum = 0u; cnt = 0u; mine = 0u;
#pragma unroll 1
        for (unsigned j = 0; j < 16; ++j) { const unsigned c = xb_ld(&bar[XB_XCNT(j)]); sum += c; cnt += (c > 0u) ? 1u : 0u; mine = (j == x) ? c : mine; }
        if (sum == G) break;
        __builtin_amdgcn_s_sleep(1);
        if ((++sp & 255u) == 0u) { if (xb_ld(&bar[XB_TMO])) break; if (sp > XB_SPIN_CAP) { atomicAdd(&bar[XB_TMO], 1u); break; } }
    }
    nloc = mine > 0u ? mine : 1u; nx = cnt > 0u ? cnt : 1u;
}

__device__ __forceinline__ void xcd_barrier(const XcdBarrier& b) {
    asm volatile("s_waitcnt vmcnt(0)" ::: "memory");
    __syncthreads();
    if (threadIdx.x == 0) {
        unsigned zo_ = 0u; asm volatile("" : "+s"(zo_));
        unsigned* bar = b.bar + zo_;
        __builtin_amdgcn_s_waitcnt(0);
        unsigned nloc = b.st[0], nx = b.st[1];
        if (nloc == 0u) { xcd_barrier_complete(bar, b.x, nloc, nx); b.st[0] = nloc; b.st[1] = nx; }
        const unsigned old = xb_add(&bar[XB_XSUB(b.x)], 1u);
        const unsigned gen = old / nloc;
        if (old + 1u == (gen + 1u) * nloc) {
            __builtin_amdgcn_fence(__ATOMIC_RELEASE, "agent");
            asm volatile("s_waitcnt vmcnt(0)" ::: "memory");
            const unsigned og = xb_add(&bar[XB_TOP], 1u);
            const unsigned tg = og / nx;
            if (og + 1u == (tg + 1u) * nx) xb_add(&bar[XB_TOPGEN], 1u);
            else XB_SPIN(xb_ld(&bar[XB_TOPGEN]) == tg, bar);
            __builtin_amdgcn_fence(__ATOMIC_ACQUIRE, "agent");
            xb_add(&bar[XB_XGEN(b.x)], 1u);
            asm volatile("s_waitcnt vmcnt(0)" ::: "memory");
        } else {
            XB_SPIN(xb_ld(&bar[XB_XGEN(b.x)]) == gen, bar);
            __builtin_amdgcn_fence(__ATOMIC_ACQUIRE, "agent");
            asm volatile("s_waitcnt vmcnt(0)" ::: "memory");
        }
    }
    __syncthreads();
}
namespace pg8 {
#define PG8_LAS __attribute__((address_space(3)))
typedef unsigned short bf16_t;
typedef short bf16x8 __attribute__((ext_vector_type(8)));
typedef float f32x4 __attribute__((ext_vector_type(4)));
typedef unsigned u32x4 __attribute__((ext_vector_type(4)));
constexpr int BM = 256, BK = 64, HALF = 128, HTB = HALF * BK * 2  , STAGE_BYTES = 8 * HTB, NXCD = 8, WGM = 8;

__host__ __device__ __forceinline__ int lds_byte(int r, int c) { const int st = (r >> 4) * 2 + (c >> 5), rr = r & 15, cc = c & 31, ob = rr * 64 + cc * 2; return st * 1024 + (ob ^ (((ob >> 9) & 1) << 5)); }
__host__ __device__ __forceinline__ void stage_rc(int b, int& R, int& C) { const int st = b / 1024, sb = b % 1024, swz = sb ^ (((sb >> 9) & 1) << 5); R = (st >> 1) * 16 + swz / 64; C = (st & 1) * 32 + (swz % 64) / 2; }
__host__ __device__ __forceinline__ int perm32(int rho) { const int n = rho >> 4, i = rho & 15; return 8 * (i >> 2) + 4 * n + (i & 3); }

struct Unit { int pm, pn; };
struct Gemm { const bf16_t* A; const bf16_t* Bt; int M, N, K; };

struct StaticOrder {
    int nM, nN, nwg, G, c;
    __host__ __device__ void init(int M, int N, int G_, int c_) { nM = M / BM; nN = N / BM; nwg = nM * nN; G = G_; c = c_; }
    __host__ __device__ bool next(int i, Unit& u) const {
        const long L = (long)i * G + c; if (L >= nwg) return false;
        int wgid = (int)L; { const int q = nwg / NXCD, r = nwg % NXCD, xcd = wgid % NXCD, off = wgid / NXCD; wgid = (xcd < r ? xcd * (q + 1) : r * (q + 1) + (xcd - r) * q) + off; }
        const int nig = WGM * nN, gid = wgid / nig, fm = gid * WGM, gsz = (nM - fm) < WGM ? (nM - fm) : WGM;
        u.pm = fm + ((wgid % nig) % gsz); u.pn = (wgid % nig) / gsz; return true;
    }
    __device__ __forceinline__ void a_ready(const Unit&) const {}
    __device__ __forceinline__ void done(const Unit&) const {}
};

__device__ __forceinline__ unsigned cvt_pk_bf16(float lo, float hi) { unsigned r; asm volatile("v_cvt_pk_bf16_f32 %0, %1, %2" : "=v"(r) : "v"(lo), "v"(hi)); return r; }

struct EpiInProj {
    static constexpr bool PERM = true, AFTER_DRAIN = false;
    bf16_t* O; int ldc; const float* bias; float* gates;
    __device__ __forceinline__ void operator()(const f32x4 (&acc)[2][2][4][2], const Unit& u, int wr, int wc, int fr, int fq) const {
        const int row0 = u.pm * BM + wr * 64 + fr; const int col0 = u.pn * BM + wc * 32 + 8 * fq;
        f32x4 bv[2][2];
#pragma unroll
        for (int bj = 0; bj < 2; ++bj)
#pragma unroll
            for (int n = 0; n < 2; ++n) bv[bj][n] = *(const f32x4*)(bias + col0 + bj * HALF + 4 * n);
        const bool gate_lane = (u.pn == 21) && (wc == 0) && (fq < 2);
#pragma unroll
        for (int ai = 0; ai < 2; ++ai)
#pragma unroll
            for (int m = 0; m < 4; ++m) { const int row = row0 + ai * HALF + m * 16; bf16_t* rowp = O + (size_t)row * ldc + col0;
#pragma unroll
                for (int bj = 0; bj < 2; ++bj) { const f32x4 v0 = acc[ai][bj][m][0] + bv[bj][0], v1 = acc[ai][bj][m][1] + bv[bj][1];
                    u32x4 w; w.x = cvt_pk_bf16(v0[0], v0[1]); w.y = cvt_pk_bf16(v0[2], v0[3]); w.z = cvt_pk_bf16(v1[0], v1[1]); w.w = cvt_pk_bf16(v1[2], v1[3]);
                    *(u32x4*)(rowp + bj * HALF) = w;
                    if (bj == 0 && gate_lane) { float* gp = gates + (size_t)row * 16 + 8 * fq; *(f32x4*)gp = v0; *(f32x4*)(gp + 4) = v1; } } }
    }
};
struct EpiResGate {
    static constexpr bool PERM = false, AFTER_DRAIN = false;
    const float* base; float* out; int ldc; const float* g; int ldg;
    __device__ __forceinline__ void operator()(const f32x4 (&acc)[2][2][4][2], const Unit& u, int wr, int wc, int fr, int fq) const {
        const int col0 = u.pn * BM + wc * 32 + 4 * fq; const int b = (u.pm * BM) >> 12;
        f32x4 gv[2][2];
#pragma unroll
        for (int bj = 0; bj < 2; ++bj)
#pragma unroll
            for (int n = 0; n < 2; ++n) gv[bj][n] = *(const f32x4*)(g + (size_t)b * ldg + col0 + bj * HALF + n * 16);
#pragma unroll
        for (int ai = 0; ai < 2; ++ai) {
            f32x4 bs[4][2][2];
#pragma unroll
            for (int m = 0; m < 4; ++m) { const int r = u.pm * BM + ai * HALF + wr * 64 + m * 16 + fr; const size_t off = (size_t)r * ldc + col0;
#pragma unroll
                for (int bj = 0; bj < 2; ++bj)
#pragma unroll
                    for (int n = 0; n < 2; ++n) bs[m][bj][n] = *(const f32x4*)(base + off + bj * HALF + n * 16); }
#pragma unroll
            for (int m = 0; m < 4; ++m) { const int r = u.pm * BM + ai * HALF + wr * 64 + m * 16 + fr; const size_t off = (size_t)r * ldc + col0;
#pragma unroll
                for (int bj = 0; bj < 2; ++bj)
#pragma unroll
                    for (int n = 0; n < 2; ++n) *(f32x4*)(out + off + bj * HALF + n * 16) = bs[m][bj][n] + gv[bj][n] * acc[ai][bj][m][n]; }
        }
    }
};
struct EpiSwiGLU {
    static constexpr bool PERM = true, AFTER_DRAIN = false;
    bf16_t* O; int ldc;
    __device__ __forceinline__ float silu(float x) const { return x * __builtin_amdgcn_rcpf(1.0f + __expf(-x)); }
    __device__ __forceinline__ void operator()(const f32x4 (&acc)[2][2][4][2], const Unit& u, int wr, int wc, int fr, int fq) const {
        const int row0 = u.pm * BM + wr * 64 + fr; const int col0 = u.pn * HALF + wc * 32 + 8 * fq;
#pragma unroll
        for (int ai = 0; ai < 2; ++ai)
#pragma unroll
            for (int m = 0; m < 4; ++m) { const int row = row0 + ai * HALF + m * 16;
                const f32x4 a0 = acc[ai][0][m][0], a1 = acc[ai][0][m][1], b0 = acc[ai][1][m][0], b1 = acc[ai][1][m][1];
                u32x4 w;
                w.x = cvt_pk_bf16(silu(a0[0]) * b0[0], silu(a0[1]) * b0[1]); w.y = cvt_pk_bf16(silu(a0[2]) * b0[2], silu(a0[3]) * b0[3]);
                w.z = cvt_pk_bf16(silu(a1[0]) * b1[0], silu(a1[1]) * b1[1]); w.w = cvt_pk_bf16(silu(a1[2]) * b1[2], silu(a1[3]) * b1[3]);
                *(u32x4*)(O + (size_t)row * ldc + col0) = w; }
    }
};

template <class Epi, class Sched, bool ALIGN_EPI = false, bool SP2 = false>
__device__ __forceinline__ void gemm_phase(PG8_LAS unsigned char* lds, const Gemm g, const Sched& S, const Epi& E) {
    const int tid = lt(), wid = __builtin_amdgcn_readfirstlane(tid >> 6), lane = tid & 63, wr = wid >> 2, wc = wid & 3, fr = lane & 15, fq = lane >> 4;
    const int K = g.K, nt = K / BK;
    unsigned voffA[2], voffB[2];
#pragma unroll
    for (int i = 0; i < 2; ++i) { int R, C; stage_rc(tid * 16 + i * 8192, R, C); const int Rb = Epi::PERM ? ((R & ~31) + perm32(R & 31)) : R;
        voffA[i] = (unsigned)(R * K + C) * 2u; voffB[i] = (unsigned)(Rb * K + C) * 2u; }
    const size_t kstep = (size_t)(BK * 2);
    const size_t hstep = (size_t)HALF * K * 2;
    const size_t tstep = 2 * hstep;
    const unsigned ldsw = (unsigned)wid * 1024u;
    const int aoff = lds_byte(wr * 64 + fr, fq * 8), boff = lds_byte(wc * 32 + fr, fq * 8);
#define PG8_SA(b, h) (((b) * 2 + (h)) * HTB)
#define PG8_SB(b, h) ((4 + (b) * 2 + (h)) * HTB)
#define PG8_STAGE(bufoff, gbase, voff) do { _Pragma("unroll") for (int _i = 0; _i < 2; ++_i) \
        __builtin_amdgcn_global_load_lds((const unsigned*)((const char*)(gbase) + (voff)[_i]), (PG8_LAS unsigned*)(lds + (bufoff) + ldsw + _i * 8192), 16, 0, 0); } while (0)
#define PG8_LDA(dst, b, h) do { _Pragma("unroll") for (int m = 0; m < 4; ++m) _Pragma("unroll") for (int k = 0; k < 2; ++k) dst[m][k] = *(const PG8_LAS bf16x8*)(lds + PG8_SA(b, h) + aoff + m * 2048 + k * 1024); } while (0)
#define PG8_LDB(dst, b, h) do { _Pragma("unroll") for (int n = 0; n < 2; ++n) _Pragma("unroll") for (int k = 0; k < 2; ++k) dst[n][k] = *(const PG8_LAS bf16x8*)(lds + PG8_SB(b, h) + boff + n * 2048 + k * 1024); } while (0)
#define PG8_MMA(ai, bj, At, Bt) do { __builtin_amdgcn_s_setprio(1); _Pragma("unroll") for (int m = 0; m < 4; ++m) _Pragma("unroll") for (int n = 0; n < 2; ++n) _Pragma("unroll") for (int k = 0; k < 2; ++k) \
        acc[ai][bj][m][n] = __builtin_amdgcn_mfma_f32_16x16x32_bf16(Bt[n][k], At[m][k], acc[ai][bj][m][n], 0, 0, 0); __builtin_amdgcn_s_setprio(0); } while (0)
#define PG8_WAIT_V(n) asm volatile("s_waitcnt vmcnt(" #n ")" ::: "memory")
#define PG8_WAIT_L(n) asm volatile("s_waitcnt lgkmcnt(" #n ")" ::: "memory")
#define PG8_BAR __builtin_amdgcn_s_barrier()
#define PG8_SCHED __builtin_amdgcn_sched_barrier(0)
    Unit cur, nxt; int ui = 0;
    if (!S.next(0, cur)) return;
    f32x4 acc[2][2][4][2];
#pragma unroll
    for (int a = 0; a < 2; ++a)
#pragma unroll
        for (int b = 0; b < 2; ++b)
#pragma unroll
            for (int m = 0; m < 4; ++m)
#pragma unroll
                for (int n = 0; n < 2; ++n) acc[a][b][m][n] = (f32x4){0.f, 0.f, 0.f, 0.f};
    bf16x8 At[4][2], B0[2][2], B1[2][2];
    const char* cA = (const char*)g.A + (size_t)cur.pm * tstep; const char* cB = (const char*)g.Bt + (size_t)cur.pn * tstep;
    S.a_ready(cur);
    if constexpr (SP2) {
        PG8_STAGE(PG8_SB(0, 0), cB, voffB); PG8_STAGE(PG8_SB(0, 1), cB + hstep, voffB); PG8_STAGE(PG8_SA(0, 0), cA, voffA); PG8_STAGE(PG8_SA(0, 1), cA + hstep, voffA);
        if (wr == 1) PG8_BAR;
        PG8_WAIT_V(2); PG8_BAR;
        PG8_STAGE(PG8_SB(1, 0), cB + kstep, voffB); PG8_STAGE(PG8_SA(1, 0), cA + kstep, voffA); PG8_STAGE(PG8_SB(1, 1), cB + hstep + kstep, voffB);
        PG8_WAIT_V(6); PG8_BAR;
    } else {
        PG8_STAGE(PG8_SB(0, 0), cB, voffB); PG8_STAGE(PG8_SA(0, 0), cA, voffA); PG8_STAGE(PG8_SB(0, 1), cB + hstep, voffB); PG8_STAGE(PG8_SA(0, 1), cA + hstep, voffA);
        if (wr == 1) PG8_BAR;
        PG8_WAIT_V(4); PG8_BAR;
        PG8_STAGE(PG8_SB(1, 0), cB + kstep, voffB); PG8_STAGE(PG8_SA(1, 0), cA + kstep, voffA); PG8_STAGE(PG8_SB(1, 1), cB + hstep + kstep, voffB);
        PG8_WAIT_V(6); PG8_BAR;
    }
    for (;;) {
        const bool has_next = S.next(ui + 1, nxt);
        const char* nA = has_next ? (const char*)g.A + (size_t)nxt.pm * tstep : cA; const char* nB = has_next ? (const char*)g.Bt + (size_t)nxt.pn * tstep : cB;
        for (int t = 0; t < nt; t += 2) {
            const bool last = (t == nt - 2);
            const char* a1 = cA + (size_t)(t + 1) * kstep;
            const char* a2 = last ? nA : cA + (size_t)(t + 2) * kstep; const char* b2 = last ? nB : cB + (size_t)(t + 2) * kstep;
            const char* a3 = a2 + kstep; const char* b3 = b2 + kstep;
            if (last && has_next) S.a_ready(nxt);
            if constexpr (SP2) {
            PG8_LDB(B0, 0, 0); PG8_LDB(B1, 0, 1); PG8_SCHED; PG8_LDA(At, 0, 0); PG8_STAGE(PG8_SA(1, 1), a1 + hstep, voffA);
            PG8_WAIT_V(8); PG8_WAIT_L(0); PG8_BAR; PG8_MMA(0, 0, At, B0); PG8_MMA(0, 1, At, B1); PG8_BAR; PG8_SCHED;
            PG8_LDA(At, 0, 1); PG8_STAGE(PG8_SB(0, 0), b2, voffB); PG8_STAGE(PG8_SB(0, 1), b2 + hstep, voffB); PG8_STAGE(PG8_SA(0, 0), a2, voffA);
            PG8_WAIT_V(8); PG8_WAIT_L(0); PG8_BAR; PG8_MMA(1, 0, At, B0); PG8_MMA(1, 1, At, B1); PG8_BAR; PG8_SCHED;
            PG8_LDB(B0, 1, 0); PG8_LDB(B1, 1, 1); PG8_SCHED; PG8_LDA(At, 1, 0); PG8_STAGE(PG8_SA(0, 1), a2 + hstep, voffA);
            PG8_WAIT_V(8); PG8_WAIT_L(0); PG8_BAR; PG8_MMA(0, 0, At, B0); PG8_MMA(0, 1, At, B1); PG8_BAR; PG8_SCHED;
            PG8_LDA(At, 1, 1); PG8_STAGE(PG8_SB(1, 0), b3, voffB); PG8_STAGE(PG8_SB(1, 1), b3 + hstep, voffB); PG8_STAGE(PG8_SA(1, 0), a3, voffA);
            PG8_WAIT_V(8); PG8_WAIT_L(0); PG8_BAR; PG8_MMA(1, 0, At, B0); PG8_MMA(1, 1, At, B1); PG8_BAR; PG8_SCHED;
            } else {
            PG8_LDB(B0, 0, 0); PG8_SCHED; PG8_LDA(At, 0, 0); PG8_STAGE(PG8_SA(1, 1), a1 + hstep, voffA);
            PG8_WAIT_L(8); PG8_BAR; PG8_WAIT_L(0); PG8_MMA(0, 0, At, B0); PG8_BAR; PG8_SCHED;
            PG8_LDB(B1, 0, 1); PG8_STAGE(PG8_SB(0, 0), b2, voffB);
            PG8_BAR; PG8_WAIT_L(0); PG8_MMA(0, 1, At, B1); PG8_BAR;
            PG8_LDA(At, 0, 1); PG8_STAGE(PG8_SA(0, 0), a2, voffA);
            PG8_BAR; PG8_WAIT_L(0); PG8_MMA(1, 0, At, B0); PG8_BAR; PG8_SCHED;
            PG8_STAGE(PG8_SB(0, 1), b2 + hstep, voffB);
            PG8_WAIT_V(6); PG8_BAR; PG8_MMA(1, 1, At, B1); PG8_BAR;
            PG8_LDB(B0, 1, 0); PG8_SCHED; PG8_LDA(At, 1, 0); PG8_STAGE(PG8_SA(0, 1), a2 + hstep, voffA);
            PG8_WAIT_L(8); PG8_BAR; PG8_WAIT_L(0); PG8_MMA(0, 0, At, B0); PG8_BAR; PG8_SCHED;
            PG8_LDB(B1, 1, 1); PG8_STAGE(PG8_SB(1, 0), b3, voffB);
            PG8_BAR; PG8_WAIT_L(0); PG8_MMA(0, 1, At, B1); PG8_BAR;
            PG8_LDA(At, 1, 1); PG8_STAGE(PG8_SA(1, 0), a3, voffA);
            PG8_BAR; PG8_WAIT_L(0); PG8_MMA(1, 0, At, B0); PG8_BAR; PG8_SCHED;
            PG8_STAGE(PG8_SB(1, 1), b3 + hstep, voffB);
            PG8_WAIT_V(6); PG8_BAR; PG8_MMA(1, 1, At, B1); PG8_BAR;
            }
        }
        if constexpr (ALIGN_EPI) { if (wr == 0) PG8_BAR; }
        if constexpr (!Epi::AFTER_DRAIN) { E(acc, cur, wr, wc, fr, fq); S.done(cur); }
        if (!has_next) break;
#pragma unroll
        for (int a = 0; a < 2; ++a)
#pragma unroll
            for (int b = 0; b < 2; ++b)
#pragma unroll
                for (int m = 0; m < 4; ++m)
#pragma unroll
                    for (int n = 0; n < 2; ++n) acc[a][b][m][n] = (f32x4){0.f, 0.f, 0.f, 0.f};
        cur = nxt; cA = nA; cB = nB; ++ui;
        if constexpr (ALIGN_EPI) { if (wr == 1) PG8_BAR; }
    }
    PG8_WAIT_V(0);
    if constexpr (!ALIGN_EPI) { if (wr == 0) PG8_BAR; }
    PG8_BAR;
    if constexpr (Epi::AFTER_DRAIN) { E.fused(acc, cur, wr, wc, fr, fq, lds, wid, lane); S.done(cur); }
#undef PG8_SA
#undef PG8_SB
#undef PG8_STAGE
#undef PG8_LDA
#undef PG8_LDB
#undef PG8_MMA
#undef PG8_WAIT_V
#undef PG8_WAIT_L
#undef PG8_BAR
#undef PG8_SCHED
}
}
namespace attn_body {
using bf16=__hip_bfloat16;
using bf16x8=__attribute__((ext_vector_type(8)))short;
using s16x4=__attribute__((ext_vector_type(4)))short;
using f32x16=__attribute__((ext_vector_type(16)))float;
using u32x4=__attribute__((ext_vector_type(4)))unsigned;
constexpr int BATCH=4,NHEAD=8,SEQ=4096,D=64,QP=512,KP=128,VP=128,OP=2048,GQ=4;
constexpr int NW=8,QBLK=32,QB=QBLK*NW,KVBLK=64,NQB=SEQ/QB;
constexpr int ATTN_UNIT_ROWS=QB;
__device__ __forceinline__ int crow(int r,int hi){return (r&3)+8*(r>>2)+4*hi;}
#define SBAR() __builtin_amdgcn_sched_barrier(0)
__device__ __forceinline__ void cmask(f32x16&p0,f32x16&p1,int jb,int qrel,int hi){
  const float NEG=-INFINITY; int kb=64*jb+4*hi;
  #pragma unroll
  for(int r=0;r<16;++r){int kv=kb+(r&3)+8*(r>>2); if(kv>qrel)p0[r]=NEG; if(kv+32>qrel)p1[r]=NEG;}
}

constexpr int NSLOT=3, SLOTB=8192;
constexpr int LDS_K=0, LDS_V=NSLOT*SLOTB, LDS_WS=2*NSLOT*SLOTB, LDS_OST=LDS_WS+NW*64*4, LDS_BYTES=LDS_OST+NW*4096;
constexpr float C2=0.125f*1.4426950408889634f;
__device__ __forceinline__ void glds16(const void*gsrc,unsigned lds_dst){unsigned keep;
  asm volatile("s_mov_b32 %0, m0\n\ts_mov_b32 m0, %2\n\ts_nop 0\n\tglobal_load_lds_dwordx4 %1, off\n\ts_mov_b32 m0, %0":"=&s"(keep):"v"(gsrc),"s"(lds_dst):"memory");}
__device__ __forceinline__ float max3f(float a,float b,float c){float r;asm("v_max3_f32 %0, %1, %2, %3":"=v"(r):"v"(a),"v"(b),"v"(c));return r;}
__device__ __forceinline__ float max2f(float a,float b){float r;asm("v_max_f32_e32 %0, %1, %2":"=v"(r):"v"(a),"v"(b));return r;}
__device__ __forceinline__ float fadd_s(float a,float b){float r;asm("v_add_f32_e32 %0, %1, %2":"=v"(r):"v"(a),"v"(b));return r;}
__device__ __forceinline__ float fsub_s(float a,float b){float r;asm("v_sub_f32_e32 %0, %1, %2":"=v"(r):"v"(a),"v"(b));return r;}
typedef float f32x2_t __attribute__((ext_vector_type(2))); typedef __bf16 bf16x2_t __attribute__((ext_vector_type(2)));
__device__ __forceinline__ unsigned cvtpk_s(float lo,float hi){f32x2_t v={lo,hi};bf16x2_t b=__builtin_convertvector(v,bf16x2_t);return __builtin_bit_cast(unsigned,b);}
#define WAIT_BAR(N) asm volatile("s_waitcnt vmcnt(" #N ") lgkmcnt(0)\n\ts_barrier":::"memory")

__device__ __forceinline__ void qkt(f32x16&p0,f32x16&p1,const char*Kslot,const bf16x8*qr,const f32x16&negm,int r32,int hi){
  const char*kb=Kslot+hi*1024+r32*16;
  #pragma unroll
  for(int d0=0;d0<4;++d0){
    const bf16x8 b0=*reinterpret_cast<const bf16x8*>(kb+d0*2048);
    const bf16x8 b1=*reinterpret_cast<const bf16x8*>(kb+d0*2048+512);
    if(d0==0){p0=__builtin_amdgcn_mfma_f32_32x32x16_bf16(b0,qr[0],negm,0,0,0);p1=__builtin_amdgcn_mfma_f32_32x32x16_bf16(b1,qr[0],negm,0,0,0);}
    else{p0=__builtin_amdgcn_mfma_f32_32x32x16_bf16(b0,qr[d0],p0,0,0,0);p1=__builtin_amdgcn_mfma_f32_32x32x16_bf16(b1,qr[d0],p1,0,0,0);}}
}
typedef __attribute__((address_space(3))) const char* lds_cptr;
typedef short v4i16_t __attribute__((ext_vector_type(4)));
__device__ __forceinline__ void kload8(bf16x8*kf,lds_cptr kp){
  kf[0]=*(const __attribute__((address_space(3))) bf16x8*)(kp);      kf[1]=*(const __attribute__((address_space(3))) bf16x8*)(kp+512);
  kf[2]=*(const __attribute__((address_space(3))) bf16x8*)(kp+2048); kf[3]=*(const __attribute__((address_space(3))) bf16x8*)(kp+2560);
  kf[4]=*(const __attribute__((address_space(3))) bf16x8*)(kp+4096); kf[5]=*(const __attribute__((address_space(3))) bf16x8*)(kp+4608);
  kf[6]=*(const __attribute__((address_space(3))) bf16x8*)(kp+6144); kf[7]=*(const __attribute__((address_space(3))) bf16x8*)(kp+6656);
}
__device__ __forceinline__ void kload2(bf16x8*kf,lds_cptr kp,int j){ kf[2*j]=*(const __attribute__((address_space(3))) bf16x8*)(kp+j*2048); kf[2*j+1]=*(const __attribute__((address_space(3))) bf16x8*)(kp+j*2048+512); }
__device__ __forceinline__ s16x4 vtr(lds_cptr p){ return __builtin_bit_cast(s16x4,__builtin_amdgcn_ds_read_tr16_b64_v4i16((__attribute__((address_space(3))) v4i16_t*)p)); }
__device__ __forceinline__ float rowmax(const f32x16&p0,const f32x16&p1){
  float a=max3f(p0[0],p0[1],p1[0]),b=max3f(p0[2],p0[3],p1[1]);a=max3f(a,p1[2],p1[3]);
  #pragma unroll
  for(int r=4;r<16;r+=4){a=max3f(a,p0[r],p0[r+1]);b=max3f(b,p0[r+2],p0[r+3]);a=max3f(a,p1[r],p1[r+1]);b=max3f(b,p1[r+2],p1[r+3]);}
  const float m=max2f(a,b);
  auto rr=__builtin_amdgcn_permlane32_swap(__float_as_uint(m),__float_as_uint(m),false,false);
  return max2f(__uint_as_float(rr[0]),__uint_as_float(rr[1]));
}
__device__ __forceinline__ void pv(f32x16*o,int vb,bf16x8 pa0,bf16x8 pa1,bf16x8 pa2,bf16x8 pa3){
  #pragma unroll
  for(int d0=0;d0<2;++d0){s16x4 lo[4],hi[4];
    #pragma unroll
    for(int ks=0;ks<4;++ks){
      asm volatile("ds_read_b64_tr_b16 %0,%1 offset:%c2":"=&v"(lo[ks]):"v"(vb),"i"(d0*4096+ks*1024):"memory");
      asm volatile("ds_read_b64_tr_b16 %0,%1 offset:%c2":"=&v"(hi[ks]):"v"(vb),"i"(d0*4096+ks*1024+512):"memory");}
    asm volatile("s_waitcnt lgkmcnt(0)":::"memory");SBAR();
    #define PK(k) (bf16x8){lo[k][0],lo[k][1],lo[k][2],lo[k][3],hi[k][0],hi[k][1],hi[k][2],hi[k][3]}
    o[d0]=__builtin_amdgcn_mfma_f32_32x32x16_bf16(pa0,PK(0),o[d0],0,0,0);
    o[d0]=__builtin_amdgcn_mfma_f32_32x32x16_bf16(pa1,PK(1),o[d0],0,0,0);
    o[d0]=__builtin_amdgcn_mfma_f32_32x32x16_bf16(pa2,PK(2),o[d0],0,0,0);
    o[d0]=__builtin_amdgcn_mfma_f32_32x32x16_bf16(pa3,PK(3),o[d0],0,0,0);
    #undef PK
  }
}

#ifndef ATTN_STORE16
#define ATTN_STORE16(p,v) (*(u32x4*)(p)=(v))
#endif
template<int THRL> __device__ __forceinline__ void attn_unit(int b,int h,int qb,const bf16*Q,const bf16*__restrict__ K,const bf16*__restrict__ V,bf16*O,char*shm){
  const int tid=lt(),lane=tid&63,r32=lane&31,hi=lane>>5; const int wid=__builtin_amdgcn_readfirstlane(tid>>6);
  const long rowbase=(long)b*SEQ; const int q0=qb*QB;
  const bf16*Qw=Q+(rowbase+q0+wid*QBLK)*QP+h*D;
  const bf16*Kh=K+rowbase*KP+(h/GQ)*D,*Vh=V+rowbase*VP+(h/GQ)*D;
  const unsigned lds0=(unsigned)(uintptr_t)shm;
  float*wsf=(float*)(shm+LDS_WS)+wid*64;
  const bf16*ksrc=Kh+(long)lane*KP+wid*8;
  const bf16*vsrc=Vh+(long)(16*(wid&3)+(lane>>2))*VP+(wid>>2)*32+(lane&3)*8;
  const unsigned kdst=lds0+LDS_K+wid*1024, vdst=lds0+LDS_V+wid*1024;
  #define DMA_K(t,slot) glds16(ksrc+(long)(t)*KVBLK*KP,(unsigned)__builtin_amdgcn_readfirstlane(kdst+(slot)))
  #define DMA_V(t,slot) glds16(vsrc+(long)(t)*KVBLK*VP,(unsigned)__builtin_amdgcn_readfirstlane(vdst+(slot)))
  const int vb0=(int)(lds0+LDS_V)+((lane>>4)&1)*32+(lane&3)*8+(4*hi+((lane&15)>>2))*64;
  const char*Kbase=shm+LDS_K; bf16x8 kf[8];
  const lds_cptr shm3=(lds_cptr)shm; const lds_cptr kp0=shm3+LDS_K+hi*1024+r32*16; const lds_cptr vp0=shm3+LDS_V+((lane>>4)&1)*32+(lane&3)*8+(4*hi+((lane&15)>>2))*64;
  const int NT=SEQ/KVBLK;
  DMA_K(0,0);DMA_V(0,0);DMA_K(1,SLOTB);
  bf16x8 qr[4];
  #pragma unroll
  for(int d0=0;d0<4;++d0)qr[d0]=*reinterpret_cast<const bf16x8*>(&Qw[(long)r32*QP+d0*16+hi*8]);
  float mhat=0.f,l_reg=0.f;f32x16 o[2];o[0]=f32x16{};o[1]=f32x16{};f32x16 negm=f32x16{};asm volatile("":"+v"(negm));
  const int qrel=wid*QBLK+r32;
  #define CMASK(P0,P1,t) do{}while(0)
  bool resc=false;
  #define START(P0,P1) do{ const float rm=rowmax(P0,P1); resc=false; \
    { const float dl=rm; mhat=fadd_s(mhat,dl); \
      _Pragma("unroll") for(int r=0;r<16;++r){P0[r]=fsub_s(P0[r],dl);P1[r]=fsub_s(P1[r],dl);} \
      _Pragma("unroll") for(int r=0;r<16;++r)negm[r]=-mhat; asm volatile("":"+v"(negm)); } \
    _Pragma("unroll") for(int r=0;r<16;++r)P0[r]=__builtin_amdgcn_exp2f(P0[r]); }while(0)
  #define RESC() do{ if(resc){ asm volatile("s_waitcnt lgkmcnt(0)":::"memory"); \
      _Pragma("unroll") for(int d_=0;d_<2;++d_) _Pragma("unroll") for(int r=0;r<16;++r)o[d_][r]*=wsf[crow(r,hi)]; } }while(0)
  f32x16 pA0,pA1,pB0,pB1;
  int sl_prev=0,sl_cur=0,sl_next=SLOTB;
  #define ROT() do{sl_prev=sl_cur;sl_cur=sl_next;sl_next=(sl_next==(NSLOT-1)*SLOTB)?0:sl_next+SLOTB;}while(0)
  DMA_K(2,2*SLOTB);
  WAIT_BAR(3);
  qkt(pA0,pA1,Kbase,qr,negm,r32,hi);asm volatile("s_nop 15\n\ts_nop 7":"+v"(pA0),"+v"(pA1));CMASK(pA0,pA1,0);
  START(pA0,pA1);
  _Pragma("unroll") for(int r=0;r<16;++r)pA1[r]=__builtin_amdgcn_exp2f(pA1[r]);
  WAIT_BAR(0);
  DMA_K(3,0);DMA_V(1,SLOTB);
  ROT();
  kload8(kf,kp0+sl_cur);
  WAIT_BAR(2);
  s16x4 vlo[8],vhi[8]; u32x4 pw0,pw1,pw2,pw3;
  #define PKW(P,B) cvtpk_s(P[B],P[B+1])
  #define PAF(k) __builtin_bit_cast(bf16x8,pw##k)
  #define VFR(i) (bf16x8){vlo[i][0],vlo[i][1],vlo[i][2],vlo[i][3],vhi[i][0],vhi[i][1],vhi[i][2],vhi[i][3]}
  #define PIN(x) asm volatile("":"+v"(x))
  #define MX3(a,b,c) __builtin_fmaxf(__builtin_fmaxf((a),(b)),(c))
  #define GAPA(MF,A0,A1,A2,A3,W0,W1,PW) do{ MF; sacc+=A0; sacc+=A1; sacc+=A2; sacc+=A3; PIN(sacc); W0; W1; PIN(PW); SBAR(); }while(0)
  #define EX(v) __builtin_amdgcn_exp2f(v)
  #define GAPB(MF,X,B) do{ MF; X[B]=EX(X[B]); X[B+1]=EX(X[B+1]); X[B+2]=EX(X[B+2]); X[B+3]=EX(X[B+3]); PIN(X); SBAR(); }while(0)
  #define VRD(i) do{ vlo[i]=vtr(vp_+(((i)>>2)*4096+((i)&3)*1024)); vhi[i]=vtr(vp_+(((i)>>2)*4096+((i)&3)*1024+512)); }while(0)
  #define KRD(G,j) do{ if(G){ kload2(kf,kp0+sl_next,j); SBAR(); } }while(0)
  #define STEP(C0,C1,P0,P1,t,GK,GV,GL) do{ SBAR(); \
    const lds_cptr vp_=vp0+sl_prev; \
    VRD(0); SBAR(); float sacc=(P0[0]+P0[1]); \
    GAPA(C0=__builtin_amdgcn_mfma_f32_32x32x16_bf16(kf[0],qr[0],negm,0,0,0), P0[2],P0[3],P0[4],P0[5],     pw0[0]=PKW(P0,0), pw0[1]=PKW(P0,2), pw0); \
    VRD(4); SBAR(); GAPA(C1=__builtin_amdgcn_mfma_f32_32x32x16_bf16(kf[1],qr[0],negm,0,0,0), P0[6],P0[7],P0[8],P0[9],     pw0[2]=PKW(P0,4), pw0[3]=PKW(P0,6), pw0); \
    VRD(1); SBAR(); GAPA(C0=__builtin_amdgcn_mfma_f32_32x32x16_bf16(kf[2],qr[1],C0,0,0,0),   P0[10],P0[11],P0[12],P0[13], pw1[0]=PKW(P0,8), pw1[1]=PKW(P0,10), pw1); \
    VRD(5); SBAR(); GAPA(C1=__builtin_amdgcn_mfma_f32_32x32x16_bf16(kf[3],qr[1],C1,0,0,0),   P0[14],P0[15],P1[0],P1[1],   pw1[2]=PKW(P0,12),pw1[3]=PKW(P0,14), pw1); \
    VRD(2); SBAR(); GAPA(C0=__builtin_amdgcn_mfma_f32_32x32x16_bf16(kf[4],qr[2],C0,0,0,0),   P1[2],P1[3],P1[4],P1[5],     pw2[0]=PKW(P1,0), pw2[1]=PKW(P1,2), pw2); \
    VRD(6); SBAR(); GAPA(C1=__builtin_amdgcn_mfma_f32_32x32x16_bf16(kf[5],qr[2],C1,0,0,0),   P1[6],P1[7],P1[8],P1[9],     pw2[2]=PKW(P1,4), pw2[3]=PKW(P1,6), pw2); \
    VRD(3); SBAR(); GAPA(C0=__builtin_amdgcn_mfma_f32_32x32x16_bf16(kf[6],qr[3],C0,0,0,0),   P1[10],P1[11],P1[12],P1[13], pw3[0]=PKW(P1,8), pw3[1]=PKW(P1,10), pw3); \
    VRD(7); SBAR(); GAPA(C1=__builtin_amdgcn_mfma_f32_32x32x16_bf16(kf[7],qr[3],C1,0,0,0),   P1[14],P1[15],0.f,0.f,       pw3[2]=PKW(P1,12),pw3[3]=PKW(P1,14), pw3); \
    l_reg+=sacc; \
    if(GK){DMA_K((t)+3,sl_cur);} if(GV){DMA_V((t)+1,sl_next);} \
    CMASK(C0,C1,t); \
    { float a=MX3(C0[0],C0[1],C1[0]),b=MX3(C0[2],C0[3],C1[1]); a=MX3(a,C1[2],C1[3]); \
      _Pragma("unroll") for(int r=4;r<16;r+=4){a=MX3(a,C0[r],C0[r+1]);b=MX3(b,C0[r+2],C0[r+3]);a=MX3(a,C1[r],C1[r+1]);b=MX3(b,C1[r+2],C1[r+3]);} \
      float rm=__builtin_fmaxf(a,b); { auto rr=__builtin_amdgcn_permlane32_swap(__float_as_uint(rm),__float_as_uint(rm),false,false); rm=__builtin_fmaxf(__uint_as_float(rr[0]),__uint_as_float(rr[1])); } \
      resc=false; \
      if(__builtin_expect(__any(rm>(float)THRL),0)){ const float dl=__builtin_fmaxf(rm,0.f); mhat+=dl; \
        _Pragma("unroll") for(int r=0;r<16;++r){C0[r]-=dl;C1[r]-=dl;} \
        _Pragma("unroll") for(int r=0;r<16;++r)negm[r]=-mhat; asm volatile("":"+v"(negm)); \
        const float f=__builtin_amdgcn_exp2f(-dl); l_reg*=f; if(hi==0)wsf[r32]=f; resc=true; } } \
    SBAR(); \
    GAPB(o[0]=__builtin_amdgcn_mfma_f32_32x32x16_bf16(PAF(0),VFR(0),o[0],0,0,0), C0,0); \
    GAPB(o[1]=__builtin_amdgcn_mfma_f32_32x32x16_bf16(PAF(0),VFR(4),o[1],0,0,0), C0,4); \
    KRD(GL,0); GAPB(o[0]=__builtin_amdgcn_mfma_f32_32x32x16_bf16(PAF(1),VFR(1),o[0],0,0,0), C0,8); \
    KRD(GL,1); GAPB(o[1]=__builtin_amdgcn_mfma_f32_32x32x16_bf16(PAF(1),VFR(5),o[1],0,0,0), C0,12); \
    KRD(GL,2); GAPB(o[0]=__builtin_amdgcn_mfma_f32_32x32x16_bf16(PAF(2),VFR(2),o[0],0,0,0), C1,0); \
    KRD(GL,3); GAPB(o[1]=__builtin_amdgcn_mfma_f32_32x32x16_bf16(PAF(2),VFR(6),o[1],0,0,0), C1,4); \
    GAPB(o[0]=__builtin_amdgcn_mfma_f32_32x32x16_bf16(PAF(3),VFR(3),o[0],0,0,0), C1,8); \
    GAPB(o[1]=__builtin_amdgcn_mfma_f32_32x32x16_bf16(PAF(3),VFR(7),o[1],0,0,0), C1,12); \
    }while(0)
  int t=1;
  #undef CMASK
  #define CMASK(P0,P1,t) do{}while(0)
  for(;t+5<NT;t+=2){
    STEP(pB0,pB1,pA0,pA1,t,true,true,true);     WAIT_BAR(2); RESC(); ROT();
    STEP(pA0,pA1,pB0,pB1,t+1,true,true,true);   WAIT_BAR(2); RESC(); ROT();
  }
  #undef CMASK
  #define CMASK(P0,P1,t) do{}while(0)
  #define ENDW(tt) do{ if((tt)+3<NT){WAIT_BAR(2);} else if((tt)+2<NT){WAIT_BAR(1);} else {WAIT_BAR(0);} }while(0)
  for(;t+1<NT;t+=2){
    STEP(pB0,pB1,pA0,pA1,t,(t+3<NT),(t+1<NT),(t+1<NT));       ENDW(t);   RESC(); ROT();
    STEP(pA0,pA1,pB0,pB1,t+1,(t+4<NT),(t+2<NT),(t+2<NT));     ENDW(t+1); RESC(); ROT();
  }
  STEP(pB0,pB1,pA0,pA1,NT-1,false,false,false); RESC();
  { float sacc=pB0[0]+pB0[1]; _Pragma("unroll") for(int r=2;r<16;++r)sacc+=pB0[r]; _Pragma("unroll") for(int r=0;r<16;++r)sacc+=pB1[r]; l_reg+=sacc;
    pw0=(u32x4){PKW(pB0,0),PKW(pB0,2),PKW(pB0,4),PKW(pB0,6)};pw1=(u32x4){PKW(pB0,8),PKW(pB0,10),PKW(pB0,12),PKW(pB0,14)};pw2=(u32x4){PKW(pB1,0),PKW(pB1,2),PKW(pB1,4),PKW(pB1,6)};pw3=(u32x4){PKW(pB1,8),PKW(pB1,10),PKW(pB1,12),PKW(pB1,14)};
    SBAR(); pv(o,vb0+sl_cur,PAF(0),PAF(1),PAF(2),PAF(3)); }
  #undef PKW
  #undef PAF
  #undef VFR
  #undef PIN
  #undef MX3
  #undef GAPA
  #undef GAPB
  #undef EX
  #undef VRD
  #undef KRD
  #undef STEP
  #undef ENDW
  {auto rr=__builtin_amdgcn_permlane32_swap(__float_as_uint(l_reg),__float_as_uint(l_reg),false,false);l_reg=__uint_as_float(rr[0])+__uint_as_float(rr[1]);}
  if(hi==0)wsf[32+r32]=l_reg;asm volatile("s_waitcnt lgkmcnt(0)":::"memory");
  float rli[16];
  #pragma unroll
  for(int r=0;r<16;++r)rli[r]=__builtin_amdgcn_rcpf(wsf[32+crow(r,hi)]);
  bf16*Ow=O+(rowbase+q0+wid*QBLK)*OP+h*D;
  { bf16*stg=(bf16*)(shm+LDS_OST)+wid*2048;
    #pragma unroll
    for(int r=0;r<16;++r){const int orow=crow(r,hi);
      #pragma unroll
      for(int d0=0;d0<2;++d0)stg[orow*64+d0*32+r32]=__float2bfloat16(o[d0][r]*rli[r]);}
    asm volatile("s_waitcnt lgkmcnt(0)":::"memory");
    #pragma unroll
    for(int i=0;i<4;++i){const int row=i*8+(lane>>3),ch=lane&7; const u32x4 v=*(const u32x4*)(stg+row*64+ch*8); ATTN_STORE16(Ow+(long)row*OP+ch*8,v);} }
  asm volatile("s_waitcnt lgkmcnt(0)\n\ts_barrier":::"memory");
  #undef DMA_K
  #undef DMA_V
  #undef CMASK
  #undef START
  #undef RESC
  #undef ROT
}
#undef SBAR
#undef WAIT_BAR
}
#ifndef MK_PROBE
#define MK_PROBE 0
#endif
#ifndef MK_PTYPE
#define MK_PTYPE 0xff
#endif

struct Args { const float* in[33]; float* out; unsigned char* ws; int ph_lo, ph_hi; };
enum { I_X = 0, I_C, I_WIN, I_BIN, I_WOUT, I_NMG, I_NFG, I_ADAW, I_ADAB, I_LCW, I_LCB, I_LWA, I_LBA, I_LWX, I_LBX, I_LLAM, I_QG, I_KG,
       I_HCW, I_HCB, I_HW1, I_HB1, I_HW2, I_HB2, I_HW3, I_HSF, I_HDEC, I_HSKIP, I_MLG, I_F1, I_F3, I_F2, I_FG };

struct Frame {
    unsigned char* lds; unsigned char* ws; const float* const* in; float* out;
    int tid, lane, wave, G;
};
#define MFMA32(a, b, c) __builtin_amdgcn_mfma_f32_32x32x16_bf16((a), (b), (c), 0, 0, 0)
#define MFMA16(a, b, c) __builtin_amdgcn_mfma_f32_16x16x32_bf16((a), (b), (c), 0, 0, 0)

__device__ __forceinline__ int next_item(unsigned* ctr, unsigned char* lds) {
    volatile unsigned* slot = (volatile unsigned*)(lds + SLOT_OFF);
    __syncthreads();
    if (threadIdx.x == 0) *slot = atomicAdd(ctr, 1u);
    __syncthreads();
    return (int)*slot;
}

__device__ __forceinline__ void transpose_item(const float* W, int K, int N, bf16* WT, int mode, float* scr, int item, int lane) {
    const int nblk = (N + 63) / 64, kb = item / nblk, nb = item % nblk, k0 = 64 * kb, n0 = 64 * nb;
    const int nl0 = 4 * (lane & 15); const bool nok = (n0 + nl0) < N;
    f32x4 v[16];
#pragma unroll
    for (int i = 0; i < 16; ++i) { const int kk = 4 * i + (lane >> 4); v[i] = nok ? *(const f32x4*)(W + (size_t)(k0 + kk) * N + n0 + nl0) : (f32x4){0.f, 0.f, 0.f, 0.f}; }
#pragma unroll
    for (int i = 0; i < 16; ++i) { const int kk = 4 * i + (lane >> 4); float* d = scr + kk * 65 + nl0; d[0] = v[i].x; d[1] = v[i].y; d[2] = v[i].z; d[3] = v[i].w; }
    LDS_WAIT();
    const int c = lane & 7;
#pragma unroll
    for (int j = 0; j < 8; ++j) { const int nl = (lane >> 3) + 8 * j; const int n = n0 + nl; const float* sp = scr + (8 * c) * 65 + nl;
        u32x4 o; o.x = pk2(sp[0 * 65], sp[1 * 65]); o.y = pk2(sp[2 * 65], sp[3 * 65]); o.z = pk2(sp[4 * 65], sp[5 * 65]); o.w = pk2(sp[6 * 65], sp[7 * 65]);
        const int dr = (mode == 0) ? n : ((n >> 7) * 256 + (n & 127) + (mode == 2 ? 128 : 0));
        if (n < N) *(u32x4*)(WT + (size_t)dr * K + k0 + 8 * c) = o; }
    LDS_WAIT();
}

__device__ __forceinline__ void p0_prologue(Frame& F) {
    const int tid = F.tid, lane = F.lane, wave = F.wave;
    const long gt = (long)blockIdx.x * 512 + tid, GT = (long)F.G * 512;
    {
        float* ca = (float*)F.lds;
        float* part = (float*)(F.lds + 32768);
        bool have = false;
        for (int it = blockIdx.x; it < 192; it += F.G) {
            if (!have) { for (int i = tid; i < 8192; i += 512) { const float c = F.in[I_C][i]; ca[i] = c * sigmoidf_(c); } have = true; }
            __syncthreads();
            const int layer = it / 96, col0 = (it % 96) * 128;
            const float* W = F.in[I_ADAW] + (size_t)layer * 2048 * 12288 + col0 + 2 * lane;
            float a00 = 0, a01 = 0, a10 = 0, a11 = 0, a20 = 0, a21 = 0, a30 = 0, a31 = 0;
            const int kb = wave * 256;
#pragma unroll 16
            for (int k = kb; k < kb + 256; ++k) { const f32x2 w = *(const f32x2*)(W + (size_t)k * 12288);
                const float c0 = ca[k], c1 = ca[2048 + k], c2 = ca[4096 + k], c3 = ca[6144 + k];
                a00 += c0 * w.x; a01 += c0 * w.y; a10 += c1 * w.x; a11 += c1 * w.y; a20 += c2 * w.x; a21 += c2 * w.y; a30 += c3 * w.x; a31 += c3 * w.y; }
            float* pp = part + (wave * 4) * 128 + 2 * lane;
            pp[0] = a00; pp[1] = a01; pp[128] = a10; pp[129] = a11; pp[256] = a20; pp[257] = a21; pp[384] = a30; pp[385] = a31;
            __syncthreads();
            { const int b = tid >> 7, col = tid & 127; float s = F.in[I_ADAB][layer * 12288 + col0 + col];
#pragma unroll
              for (int w = 0; w < 8; ++w) s += part[(w * 4 + b) * 128 + col];
              ((float*)(F.ws + WS_MOD))[(layer * 4 + b) * 12288 + col0 + col] = s; }
        }
        __syncthreads();
    }
    {
        bf16* lw = (bf16*)(F.ws + WS_LRUW);
        for (long e = gt; e < 262144; e += GT) { const int k = e & 63, j = (e >> 6) & 63, gate = (e >> 12) & 1, blk = (e >> 13) & 7, dir = (e >> 16) & 1, l = (int)(e >> 17);
            const float* src = gate ? F.in[I_LWX] : F.in[I_LWA];
            lw[e] = (bf16)f2bf(src[((((size_t)(l * 2 + dir) * 8 + blk) * 64 + k) * 64) + j]); }
        float* bp = (float*)(F.ws + WS_BINP);
        for (long e = gt; e < 2 * DINP; e += GT) { const int l = (int)(e / DINP), n = (int)(e % DINP); bp[e] = n < DIN ? F.in[I_BIN][l * DIN + n] : 0.f; }
        for (long e = gt; e < 2L * 240 * 256; e += GT) { const int l = (int)(e / (240 * 256)); const long r = e % (240 * 256);
            *(u32x4*)(F.ws + WS_WIN + (size_t)l * DINP * DM * 2 + (size_t)DIN * DM * 2 + r * 16) = (u32x4){0u, 0u, 0u, 0u}; }
    }
    {
        float* feat = (float*)F.lds; float* h1 = (float*)(F.lds + 2048); float* h2 = (float*)(F.lds + 6144); float* w1s = (float*)(F.lds + 10240); float* w2s = (float*)(F.lds + 14848);
        for (int it = blockIdx.x; it < 512; it += F.G) {
            const int l = it >> 8, pb = it & 255;
            __syncthreads();
            for (int i = tid; i < 17 * 64; i += 512) w1s[i] = F.in[I_HW1][l * 17 * 64 + i];
#pragma unroll
            for (int i = 0; i < 8; ++i) w2s[tid + 512 * i] = F.in[I_HW2][l * 4096 + tid + 512 * i];
            if (tid < 272) { const int p = tid / 17, f = tid % 17; const float pos = (float)(16 * pb + p); float val;
                if (f == 0) val = pos / 4095.0f;
                else { const int bi = (f - 1) & 7; const float band = 1e-4f + (float)bi * ((7.0f - 1e-4f) / 7.0f); const float ang = (6.283185307179586f * pos / 4096.0f) * band;
                       val = (f <= 8) ? cos_rad(ang) : -sin_rad(ang); }
                feat[p * 17 + f] = val; }
            __syncthreads();
            for (int idx = tid; idx < 1024; idx += 512) { const int p = idx >> 6, j = idx & 63; float s = F.in[I_HB1][l * 64 + j];
#pragma unroll
                for (int f = 0; f < 17; ++f) s += feat[p * 17 + f] * w1s[f * 64 + j];
                h1[idx] = sin_rad(F.in[I_HSF][l * 64 + j] * s); }
            __syncthreads();
            for (int idx = tid; idx < 1024; idx += 512) { const int p = idx >> 6, j = idx & 63; float s = F.in[I_HB2][l * 64 + j];
#pragma unroll 16
                for (int i = 0; i < 64; ++i) s += h1[p * 64 + i] * w2s[i * 64 + j];
                h2[idx] = sin_rad(F.in[I_HSF][l * 64 + j] * s); }
            __syncthreads();
            float acc[4][16];
#pragma unroll
            for (int q = 0; q < 4; ++q)
#pragma unroll
                for (int p = 0; p < 16; ++p) acc[q][p] = 0.f;
            const float* w3 = F.in[I_HW3] + (size_t)l * 64 * 2048 + tid;
#pragma unroll 8
            for (int i = 0; i < 64; ++i) { const float w0 = w3[i * 2048], w1 = w3[i * 2048 + 512], w2 = w3[i * 2048 + 1024], w3v = w3[i * 2048 + 1536];
#pragma unroll
                for (int p = 0; p < 16; ++p) { const float hv = h2[p * 64 + i]; acc[0][p] += hv * w0; acc[1][p] += hv * w1; acc[2][p] += hv * w2; acc[3][p] += hv * w3v; } }
#pragma unroll
            for (int q = 0; q < 4; ++q) { const int j = tid + 512 * q; const int o = j >> 10, dir = (j >> 9) & 1, wch = j & 511;
                const float dec = fabsf(F.in[I_HDEC][l * 2048 + j]);
                bf16* base = (bf16*)(F.ws + WS_HYFT) + ((size_t)((l * 2 + o) * 512 + wch)) * 8192;
                float ss = 0.f; float vv[16];
#pragma unroll
                for (int p = 0; p < 16; ++p) { const int pos = 16 * pb + p; const float t = (float)pos / 4095.0f; vv[p] = acc[q][p] * __expf(-t * dec); ss += vv[p] * vv[p]; }
                if (dir == 0) { bf16* fp = base + 4080 - 16 * pb;
                    *(u32x4*)fp = (u32x4){pk2(vv[15], vv[14]), pk2(vv[13], vv[12]), pk2(vv[11], vv[10]), pk2(vv[9], vv[8])};
                    *(u32x4*)(fp + 8) = (u32x4){pk2(vv[7], vv[6]), pk2(vv[5], vv[4]), pk2(vv[3], vv[2]), pk2(vv[1], vv[0])}; }
                else { bf16* bp = base + 4095 + 16 * pb;
                    if (pb > 0) bp[0] = (bf16)f2bf(vv[0]);
                    *(u32x4*)(bp + 1) = (u32x4){pk2(vv[1], vv[2]), pk2(vv[3], vv[4]), pk2(vv[5], vv[6]), pk2(vv[7], vv[8])};
                    *(u32x2*)(bp + 9) = (u32x2){pk2(vv[9], vv[10]), pk2(vv[11], vv[12])};
                    *(unsigned*)(bp + 13) = pk2(vv[13], vv[14]);
                    bp[15] = (bf16)f2bf(vv[15]);
                    if (pb == 0) base[8191] = 0; }
                ((float*)(F.ws + WS_HYPART))[(size_t)(l * 256 + pb) * 2048 + j] = ss; }
        }
        __syncthreads();
    }
    {
        float* scr = (float*)(F.lds + wave * 16640);
        unsigned* tctr = (unsigned*)(F.ws + WS_CTL) + 64 * 30;
        constexpr int I_IN = 32 * 85, I_OUT = 32 * 32, I_W1 = 32 * 88, I_W2 = 88 * 32, PER_L = I_IN + I_OUT + 2 * I_W1 + I_W2;
        for (;;) {
            unsigned base = 0u; if (lane == 0) base = atomicAdd(tctr, 4u);
            base = (unsigned)__builtin_amdgcn_readfirstlane((int)base);
            if (base >= (unsigned)(2 * PER_L)) break;
#pragma unroll 1
            for (int q = 0; q < 4; ++q) { const int it = (int)base + q; if (it >= 2 * PER_L) break;
                const int l = it / PER_L; int r = it % PER_L;
                if (r < I_IN) { transpose_item(F.in[I_WIN] + (size_t)l * DM * DIN, DM, DIN, (bf16*)(F.ws + WS_WIN) + (size_t)l * DINP * DM, 0, scr, r, lane); continue; } r -= I_IN;
                if (r < I_OUT) { transpose_item(F.in[I_WOUT] + (size_t)l * DM * DM, DM, DM, (bf16*)(F.ws + WS_WOUT) + (size_t)l * DM * DM, 0, scr, r, lane); continue; } r -= I_OUT;
                if (r < I_W1) { transpose_item(F.in[I_F1] + (size_t)l * DM * DFF, DM, DFF, (bf16*)(F.ws + WS_W13) + (size_t)l * 2 * DFF * DM, 1, scr, r, lane); continue; } r -= I_W1;
                if (r < I_W1) { transpose_item(F.in[I_F3] + (size_t)l * DM * DFF, DM, DFF, (bf16*)(F.ws + WS_W13) + (size_t)l * 2 * DFF * DM, 2, scr, r, lane); continue; } r -= I_W1;
                transpose_item(F.in[I_F2] + (size_t)l * DFF * DM, DFF, DM, (bf16*)(F.ws + WS_W2) + (size_t)l * DM * DFF, 0, scr, r, lane); }
        }
    }
}

__device__ __forceinline__ void norm_phase(Frame& F, const float* xin, const float* g, const float* sh, const float* sc, bf16* xn) {
    const int gw = blockIdx.x * 8 + F.wave, NGW = F.G * 8, lane = F.lane;
    f32x4 vn[8];
    if (gw < MTOK) { const f32x4* xr0 = (const f32x4*)(xin + (size_t)gw * DM) + lane;
#pragma unroll
        for (int j = 0; j < 8; ++j) vn[j] = xr0[64 * j]; }
    for (int m = gw; m < MTOK; m += NGW) {
        const int b = m >> 12;
        f32x4 v[8]; float ss = 0.f;
#pragma unroll
        for (int j = 0; j < 8; ++j) { v[j] = vn[j]; ss += (v[j].x * v[j].x + v[j].y * v[j].y) + (v[j].z * v[j].z + v[j].w * v[j].w); }
        if (m + NGW < MTOK) { const f32x4* xr1 = (const f32x4*)(xin + (size_t)(m + NGW) * DM) + lane;
#pragma unroll
            for (int j = 0; j < 8; ++j) vn[j] = xr1[64 * j]; }
        const float rstd = rsqrtf(wave_sum(ss) * (1.0f / DM) + EPS);
        f32x4 gvv[8], scvv[8], shvv[8];
#pragma unroll
        for (int j = 0; j < 8; ++j) { const int col = 4 * (lane + 64 * j);
            gvv[j] = *(const f32x4*)(g + col); scvv[j] = *(const f32x4*)(sc + (size_t)b * 12288 + col); shvv[j] = *(const f32x4*)(sh + (size_t)b * 12288 + col); }
#pragma unroll
        for (int j = 0; j < 8; ++j) { const int col = 4 * (lane + 64 * j);
            const f32x4 gv = gvv[j], scv = scvv[j], shv = shvv[j];
            const f32x4 o = (v[j] * rstd) * gv * (scv + 1.0f) + shv;
            u32x2 w; w.x = pk2(o.x, o.y); w.y = pk2(o.z, o.w);
            *(u32x2*)(xn + (size_t)m * DM + col) = w; }
    }
}
__device__ __forceinline__ void final_norm_phase(Frame& F, float* x, const float* g) {
    const int gw = blockIdx.x * 8 + F.wave, NGW = F.G * 8, lane = F.lane;
    f32x4 vn[8];
    if (gw < MTOK) { const f32x4* xr0 = (const f32x4*)(x + (size_t)gw * DM) + lane;
#pragma unroll
        for (int j = 0; j < 8; ++j) vn[j] = xr0[64 * j]; }
    for (int m = gw; m < MTOK; m += NGW) {
        f32x4* xr = (f32x4*)(x + (size_t)m * DM) + lane;
        f32x4 v[8]; float ss = 0.f;
#pragma unroll
        for (int j = 0; j < 8; ++j) { v[j] = vn[j]; ss += (v[j].x * v[j].x + v[j].y * v[j].y) + (v[j].z * v[j].z + v[j].w * v[j].w); }
        if (m + NGW < MTOK) { const f32x4* xr1 = (const f32x4*)(x + (size_t)(m + NGW) * DM) + lane;
#pragma unroll
            for (int j = 0; j < 8; ++j) vn[j] = xr1[64 * j]; }
        const float rstd = rsqrtf(wave_sum(ss) * (1.0f / DM) + EPS);
        f32x4 gvv[8];
#pragma unroll
        for (int j = 0; j < 8; ++j) gvv[j] = *(const f32x4*)(g + 4 * (lane + 64 * j));
#pragma unroll
        for (int j = 0; j < 8; ++j) xr[64 * j] = (v[j] * rstd) * gvv[j];
    }
}
__device__ __forceinline__ void hy_scale_reduce(Frame& F) {
    const long gt = (long)blockIdx.x * 512 + F.tid;
    if (gt < 2048) { const int l = (int)(gt >> 10), o = (int)(gt >> 9) & 1, w = (int)gt & 511; const float* pp = (const float*)(F.ws + WS_HYPART) + (size_t)l * 256 * 2048 + o * 1024 + w;
        float s = 0.f; for (int pb = 0; pb < 256; ++pb) s += pp[(size_t)pb * 2048] + pp[(size_t)pb * 2048 + 512];
        ((float*)(F.ws + WS_HYSC))[gt] = rsqrtf(s + EPS); }
}

__device__ __forceinline__ void attn_prep_item(Frame& F, int l, int it) {
    const bf16* proj = (const bf16*)(F.ws + WS_PROJ); bf16* qb = (bf16*)(F.ws + WS_QB); bf16* kb = (bf16*)(F.ws + WS_KB);
#pragma unroll 1
    for (int pi = F.tid; pi < 768; pi += 512) {
        const int tok = pi / 12, hd = pi % 12; const int row = it * 64 + tok; const int pos = row & 4095;
        const bf16* src = proj + (size_t)row * DINP + (hd < 8 ? C_BQ + hd * 64 : (hd < 10 ? C_BK + (hd - 8) * 64 : C_BV + (hd - 10) * 64));
        u32x4 raw[8];
#pragma unroll
        for (int i = 0; i < 8; ++i) raw[i] = *(const u32x4*)(src + 8 * i);
        if (hd >= 10) {
            bf16* vd = (bf16*)(F.ws + WS_VB) + (size_t)row * 128 + (hd - 10) * 64;
#pragma unroll
            for (int i = 0; i < 8; ++i) *(u32x4*)(vd + 8 * i) = raw[i];
            continue; }
        float x[64]; float ss = 0.f;
#pragma unroll
        for (int i = 0; i < 8; ++i) { const unsigned w4[4] = {raw[i].x, raw[i].y, raw[i].z, raw[i].w};
#pragma unroll
            for (int e = 0; e < 4; ++e) { x[8 * i + 2 * e] = bflo(w4[e]); x[8 * i + 2 * e + 1] = bfhi(w4[e]); } }
#pragma unroll
        for (int i = 0; i < 64; ++i) ss += x[i] * x[i];
        const float r = rsqrtf(ss * (1.0f / 64.0f) + EPS);
        const float* g = (hd < 8 ? F.in[I_QG] : F.in[I_KG]) + l * 64;
        const float osc = (hd < 8) ? (0.125f * 1.4426950408889634f) : 1.0f;
#pragma unroll
        for (int i = 0; i < 64; ++i) x[i] = x[i] * r * g[i];
        float o[64];
#pragma unroll
        for (int seg = 0; seg < 2; ++seg) { const float p = seg ? (float)(pos & 63) : (float)(pos >> 6);
#pragma unroll
            for (int i = 0; i < 16; ++i) { const float inv = exp2f(-(float)i * (13.287712379549449f / 16.0f)); const float ang = p * inv; const float cs = cos_rad(ang), sn = sin_rad(ang);
                const float x1 = x[32 * seg + i], x2 = x[32 * seg + 16 + i];
                o[32 * seg + i] = (x1 * cs - x2 * sn) * osc; o[32 * seg + 16 + i] = (x2 * cs + x1 * sn) * osc; } }
        bf16* dst = (hd < 8) ? qb + (size_t)row * 512 + hd * 64 : kb + (size_t)row * 128 + (hd - 8) * 64;
#pragma unroll
        for (int i = 0; i < 8; ++i) *(u32x4*)(dst + 8 * i) = (u32x4){pk2(o[8 * i], o[8 * i + 1]), pk2(o[8 * i + 2], o[8 * i + 3]), pk2(o[8 * i + 4], o[8 * i + 5]), pk2(o[8 * i + 6], o[8 * i + 7])};
    }
}

__device__ __forceinline__ void hy_prep_item(Frame& F, int l, int it) {
    const bf16* proj = (const bf16*)(F.ws + WS_PROJ); bf16* ht = (bf16*)(F.ws + WS_HT);
    const int b = it / 192, rem = it % 192, tt = rem / 24, ct = rem % 24, t0 = tt * 512, c0 = ct * 64, tid = F.tid;
    float* raw = (float*)F.lds;
    u32x4 v[9];
#pragma unroll
    for (int j = 0; j < 9; ++j) { const int idx = tid + 512 * j; const int t = t0 - 1 + (idx >> 3);
        v[j] = (u32x4){0u, 0u, 0u, 0u};
        if (idx < 4112 && t >= 0 && t < SEQ) v[j] = *(const u32x4*)(proj + (size_t)(b * SEQ + t) * DINP + C_CU + c0 + (idx & 7) * 8); }
#pragma unroll
    for (int j = 0; j < 9; ++j) { const int idx = tid + 512 * j; if (idx < 4112) { float* d = raw + (idx >> 3) * 65 + (idx & 7) * 8; const unsigned w4[4] = {v[j].x, v[j].y, v[j].z, v[j].w};
#pragma unroll
        for (int e = 0; e < 4; ++e) { d[2 * e] = bflo(w4[e]); d[2 * e + 1] = bfhi(w4[e]); } } }
    __syncthreads();
    { const int ch = tid >> 3, seg = tid & 7; const int c = c0 + ch;
      const float w0 = F.in[I_HCW][(l * 3 + 0) * 1536 + c], w1 = F.in[I_HCW][(l * 3 + 1) * 1536 + c], w2 = F.in[I_HCW][(l * 3 + 2) * 1536 + c], cb = F.in[I_HCB][l * 1536 + c];
#pragma unroll
      for (int sb = 0; sb < 4; ++sb) { const int ts = 16 * (8 * sb + seg);
          unsigned pk[8];
#pragma unroll
          for (int e = 0; e < 16; e += 2) { const int tr = ts + e + 1;
              const float o0 = cb + w0 * raw[(tr - 1) * 65 + ch] + w1 * raw[tr * 65 + ch] + w2 * raw[(tr + 1) * 65 + ch];
              const float o1 = cb + w0 * raw[tr * 65 + ch] + w1 * raw[(tr + 1) * 65 + ch] + w2 * raw[(tr + 2) * 65 + ch];
              pk[e >> 1] = pk2(o0, o1); }
          u32x4* dst = (u32x4*)(ht + ((size_t)(b * 1536 + c)) * SEQ + t0 + ts);
          dst[0] = (u32x4){pk[0], pk[1], pk[2], pk[3]}; dst[1] = (u32x4){pk[4], pk[5], pk[6], pk[7]}; } }
}

__device__ __forceinline__ void hy_conv_item(Frame& F, int l, int order, int cp) {
    const int tid = F.tid, lane = F.lane, w = F.wave, r32 = lane & 31, hi = lane >> 5;
    unsigned* RVc = (unsigned*)F.lds;
    bf16* U = (bf16*)(F.lds + 65536);
    const int c0 = 2 * cp;
    { const unsigned* src = (const unsigned*)((const bf16*)(F.ws + WS_HYFT) + ((size_t)((l * 2 + order) * 512 + c0)) * 8192);
#pragma unroll
      for (int i0 = 0; i0 < 2048; i0 += 512) { const int i = tid + i0; const int cc = i >> 10, j4 = (i & 1023) * 4;
          const u32x4 a = *(const u32x4*)(src + cc * 4096 + j4); const unsigned nx = (j4 + 4 < 4096) ? src[cc * 4096 + j4 + 4] : 0u;
          *(u32x4*)(RVc + (cc * 2 + 0) * 4096 + j4) = a;
          *(u32x4*)(RVc + (cc * 2 + 1) * 4096 + j4) = (u32x4){__builtin_amdgcn_alignbit(a.y, a.x, 16), __builtin_amdgcn_alignbit(a.z, a.y, 16), __builtin_amdgcn_alignbit(a.w, a.z, 16), __builtin_amdgcn_alignbit(nx, a.w, 16)}; }
      u32x4 uv[8];
#pragma unroll
      for (int q = 0; q < 8; ++q) { const int i = tid + 512 * q; const int cc = i >> 11, b = (i >> 9) & 3, off = i & 511;
          const bf16* sp = (order == 0) ? (const bf16*)(F.ws + WS_HT) + ((size_t)(b * 1536 + c0 + cc)) * SEQ : (const bf16*)(F.ws + WS_Z1T) + ((size_t)(b * 512 + c0 + cc)) * SEQ;
          uv[q] = ((const u32x4*)sp)[off]; }
#pragma unroll
      for (int q = 0; q < 8; ++q) { const int i = tid + 512 * q; const int rowi = i >> 9, off = i & 511;
          *(u32x4*)(U + rowi * 4608 + 8 * off + (off >> 3) * 8) = uv[q]; } }
    if (tid < 32) ((unsigned*)(F.lds + 65536 + 73728))[tid] = 0u;
    __syncthreads();
    const int cc = w >> 2, b = w & 3, c = c0 + cc;
    bf16* Uc = U + (cc * 4 + b) * 4608;
    f32x16 acc[2][2];
#pragma unroll
    for (int a = 0; a < 2; ++a)
#pragma unroll
        for (int q = 0; q < 2; ++q)
#pragma unroll
            for (int r = 0; r < 16; ++r) acc[a][q][r] = 0.f;
    const unsigned lds_rv = (unsigned)(uintptr_t)(RVc + cc * 2 * 4096);
#define HY_RD(DST, ADDR, O) do { asm volatile("ds_read2_b32 %0, %1 offset0:%2 offset1:%3" : "=v"((DST)[0]) : "v"(ADDR), "i"(O), "i"((O) + 1)); \
                                 asm volatile("ds_read2_b32 %0, %1 offset0:%2 offset1:%3" : "=v"((DST)[1]) : "v"(ADDR), "i"((O) + 2), "i"((O) + 3)); } while (0)
#define HY_LDB(DST, DD) do { const int ip0_ = r32 - (DD), ip1_ = 32 + r32 - (DD); const bool ok0_ = (ip0_ >= 0) && (ip0_ < 64), ok1_ = (ip1_ >= 0) && (ip1_ < 64); \
        const bf16* p0_ = ok0_ ? (Uc + 72 * ip0_ + 8 * hi) : ZR; const bf16* p1_ = ok1_ ? (Uc + 72 * ip1_ + 8 * hi) : ZR;        \
        _Pragma("unroll") for (int ks = 0; ks < 4; ++ks) { (DST)[ks][0] = *(const bf16x8*)(p0_ + 16 * ks); (DST)[ks][1] = *(const bf16x8*)(p1_ + 16 * ks); } } while (0)
    u32x2 W[6][2], nW[4][2]; bf16x8 B[4][2], nB[4][2];
    const bf16* ZR = (const bf16*)(F.lds + 65536 + 73728);
    unsigned aaddr;
    { const int s1 = 4095 - (64 * (-63) + 32 + r32 - 8 * hi); aaddr = lds_rv + (unsigned)(s1 & 1) * 16384u + (unsigned)(s1 >> 1) * 4u; }
    HY_RD(W[0], aaddr, 40); HY_RD(W[1], aaddr, 32); HY_RD(W[2], aaddr, 24); HY_RD(W[3], aaddr, 16); HY_RD(W[4], aaddr, 8); HY_RD(W[5], aaddr, 0);
    HY_LDB(B, -63);
#pragma unroll
    for (int i = 0; i < 4; ++i) { nW[i][0] = (u32x2){0u, 0u}; nW[i][1] = (u32x2){0u, 0u}; }
#pragma unroll
    for (int ks = 0; ks < 4; ++ks) { nB[ks][0] = (bf16x8){0, 0, 0, 0, 0, 0, 0, 0}; nB[ks][1] = (bf16x8){0, 0, 0, 0, 0, 0, 0, 0}; }
    asm volatile("s_waitcnt lgkmcnt(0)" : "+v"(W[0][0]), "+v"(W[0][1]), "+v"(W[1][0]), "+v"(W[1][1]), "+v"(W[2][0]), "+v"(W[2][1]), "+v"(W[3][0]), "+v"(W[3][1]), "+v"(W[4][0]), "+v"(W[4][1]), "+v"(W[5][0]), "+v"(W[5][1]),
                                            "+v"(B[0][0]), "+v"(B[0][1]), "+v"(B[1][0]), "+v"(B[1][1]), "+v"(B[2][0]), "+v"(B[2][1]), "+v"(B[3][0]), "+v"(B[3][1]) :: "memory");
#pragma unroll 1
    for (int D = -63; D <= 63; ++D) {
        const bool v0 = (D <= 31), v1 = (D >= -31);
        const unsigned an = aaddr - 128u;
        if (D < 63) { HY_RD(nW[0], an, 24); HY_RD(nW[1], an, 16); HY_RD(nW[2], an, 8); HY_RD(nW[3], an, 0); HY_LDB(nB, D + 1); }
        __builtin_amdgcn_sched_barrier(0);
#pragma unroll
        for (int ks = 0; ks < 4; ++ks) {
            const bf16x8 a0 = __builtin_bit_cast(bf16x8, (u32x4){W[3 - ks][0].x, W[3 - ks][0].y, W[3 - ks][1].x, W[3 - ks][1].y});
            const bf16x8 a1 = __builtin_bit_cast(bf16x8, (u32x4){W[5 - ks][0].x, W[5 - ks][0].y, W[5 - ks][1].x, W[5 - ks][1].y});
            if (v0) { acc[0][0] = MFMA32(a0, B[ks][0], acc[0][0]); acc[1][0] = MFMA32(a1, B[ks][0], acc[1][0]); }
            if (v1) { acc[0][1] = MFMA32(a0, B[ks][1], acc[0][1]); acc[1][1] = MFMA32(a1, B[ks][1], acc[1][1]); } }
        __builtin_amdgcn_sched_barrier(0);
        asm volatile("s_waitcnt lgkmcnt(0)" : "+v"(nW[0][0]), "+v"(nW[0][1]), "+v"(nW[1][0]), "+v"(nW[1][1]), "+v"(nW[2][0]), "+v"(nW[2][1]), "+v"(nW[3][0]), "+v"(nW[3][1]),
                                                "+v"(nB[0][0]), "+v"(nB[0][1]), "+v"(nB[1][0]), "+v"(nB[1][1]), "+v"(nB[2][0]), "+v"(nB[2][1]), "+v"(nB[3][0]), "+v"(nB[3][1]) :: "memory");
        W[0][0] = W[4][0]; W[0][1] = W[4][1]; W[1][0] = W[5][0]; W[1][1] = W[5][1];
#pragma unroll
        for (int i = 0; i < 4; ++i) { W[2 + i][0] = nW[i][0]; W[2 + i][1] = nW[i][1]; }
#pragma unroll
        for (int ks = 0; ks < 4; ++ks) { B[ks][0] = nB[ks][0]; B[ks][1] = nB[ks][1]; }
        aaddr = an;
    }
#undef HY_RD
#undef HY_LDB
    const float scale = ((const float*)(F.ws + WS_HYSC))[(l * 2 + order) * 512 + c], sk = F.in[I_HSKIP][(l * 2 + order) * 512 + c];
#pragma unroll
    for (int jt = 0; jt < 2; ++jt)
#pragma unroll
        for (int itl = 0; itl < 2; ++itl)
            { float uu[16];
#pragma unroll
              for (int r = 0; r < 16; ++r) uu[r] = bf2f(Uc[72 * (32 * itl + r32) + 32 * jt + crow(r, hi)]);
#pragma unroll
              for (int r = 0; r < 16; ++r) Uc[72 * (32 * itl + r32) + 32 * jt + crow(r, hi)] = (bf16)f2bf(acc[jt][itl][r] * scale + sk * uu[r]); }
    LDS_WAIT();
    const bf16* gate = (const bf16*)(F.ws + WS_HT) + ((size_t)(b * 1536 + (order == 0 ? 512 : 1024) + c)) * SEQ;
    bf16* zdst = (bf16*)(F.ws + WS_Z1T) + ((size_t)(b * 512 + c)) * SEQ;
    u32x4 gvs[8];
#pragma unroll
    for (int q = 0; q < 8; ++q) gvs[q] = *(const u32x4*)(gate + 8 * lane + 512 * q);
#pragma unroll
    for (int q = 0; q < 8; ++q) { const int t = 8 * lane + 512 * q;
        const u32x4 uv = *(const u32x4*)(Uc + t + (t >> 6) * 8); const u32x4 gv = gvs[q];
        *(u32x4*)(zdst + t) = (u32x4){pk2(bflo(uv.x) * bflo(gv.x), bfhi(uv.x) * bfhi(gv.x)), pk2(bflo(uv.y) * bflo(gv.y), bfhi(uv.y) * bfhi(gv.y)),
                                      pk2(bflo(uv.z) * bflo(gv.z), bfhi(uv.z) * bfhi(gv.z)), pk2(bflo(uv.w) * bflo(gv.w), bfhi(uv.w) * bfhi(gv.w))}; }
}
__device__ __forceinline__ void hy_out_phase(Frame& F) {
    bf16* tile = (bf16*)F.lds;
    const int tid = F.tid;
    for (int it = blockIdx.x; it < 1024; it += F.G) {
        const int b = it >> 8, cb = (it >> 5) & 7, tb = it & 31;
        __syncthreads();
#pragma unroll
        for (int j = 0; j < 2; ++j) { const int idx = tid + 512 * j; const int ch = idx >> 4, t8 = (idx & 15) * 8;
            *(u32x4*)(tile + ch * 136 + t8) = *(const u32x4*)((const bf16*)(F.ws + WS_Z1T) + ((size_t)(b * 512 + 64 * cb + ch)) * SEQ + 128 * tb + t8); }
        __syncthreads();
#pragma unroll
        for (int j = 0; j < 2; ++j) { const int idx = tid + 512 * j; const int t = idx >> 3, c8 = (idx & 7) * 8; unsigned pk[4];
#pragma unroll
            for (int e = 0; e < 4; ++e) pk[e] = (unsigned)tile[(c8 + 2 * e) * 136 + t] | ((unsigned)tile[(c8 + 2 * e + 1) * 136 + t] << 16);
            *(u32x4*)((bf16*)(F.ws + WS_Y) + ((size_t)(b * SEQ + 128 * tb + t)) * DM + 1024 + 64 * cb + c8) = (u32x4){pk[0], pk[1], pk[2], pk[3]}; }
    }
    __syncthreads();
}

__device__ __forceinline__ float gelu_tanh(float x) { const float z = 0.7978845608028654f * (x + 0.044715f * x * x * x); const float t = 1.0f - 2.0f * __builtin_amdgcn_rcpf(__expf(2.0f * z) + 1.0f); return 0.5f * x * (1.0f + t); }
template <int STAGE> __device__ __forceinline__ void lru_item(Frame& F, int l, int it) {
    const bf16* proj = (const bf16*)(F.ws + WS_PROJ); bf16* Y = (bf16*)(F.ws + WS_Y);
    const int tid = F.tid, lane = F.lane, w = F.wave, r16 = lane & 15, q = lane >> 4;
    const int b = it >> 6, chunk = it & 63, t0 = chunk * 64;
    bf16* XC = (bf16*)F.lds;
    bf16* HFL = (bf16*)(F.lds + 66560);
    { const int c8 = (tid & 63) * 8, run = tid >> 6;
      u32x4 rw[11];
#pragma unroll
      for (int j = 0; j < 11; ++j) { const int tt = t0 + 8 * run - 2 + j; rw[j] = (u32x4){0u, 0u, 0u, 0u};
          if (tt >= 0 && tt < SEQ) rw[j] = *(const u32x4*)(proj + (size_t)(b * SEQ + tt) * DINP + C_AX + c8); }
      float wv[4][8], bv8[8];
#pragma unroll
      for (int e = 0; e < 8; ++e) { bv8[e] = F.in[I_LCB][l * 512 + c8 + e];
#pragma unroll
          for (int jj = 0; jj < 4; ++jj) wv[jj][e] = F.in[I_LCW][(l * 4 + jj) * 512 + c8 + e]; }
#pragma unroll
      for (int tk = 0; tk < 8; ++tk) { float o[8];
#pragma unroll
          for (int e = 0; e < 8; ++e) o[e] = bv8[e];
#pragma unroll
          for (int jj = 0; jj < 4; ++jj) { const u32x4 r4 = rw[tk + jj]; const unsigned w4[4] = {r4.x, r4.y, r4.z, r4.w};
#pragma unroll
              for (int e = 0; e < 4; ++e) { o[2 * e] += wv[jj][2 * e] * bflo(w4[e]); o[2 * e + 1] += wv[jj][2 * e + 1] * bfhi(w4[e]); } }
          *(u32x4*)(XC + (8 * run + tk) * 520 + c8) = (u32x4){pk2(o[0], o[1]), pk2(o[2], o[3]), pk2(o[4], o[5]), pk2(o[6], o[7])}; } }
    __syncthreads();
    const int blk = w;
    f32x2* sums = (f32x2*)(F.ws + WS_LRUS);
#pragma unroll 1
    for (int dir = 0; dir < 2; ++dir) {
        bf16x8 Bw[2][4][2]; float bav[4], bxv[4], lamc[4], hc[4], Ap[4];
#pragma unroll
        for (int nt = 0; nt < 4; ++nt) { const int ch = 64 * blk + 16 * nt + r16;
            bav[nt] = F.in[I_LBA][(l * 2 + dir) * 512 + ch]; bxv[nt] = F.in[I_LBX][(l * 2 + dir) * 512 + ch];
            lamc[nt] = -8.0f * log1pf(__expf(-F.in[I_LLAM][(l * 2 + dir) * 512 + ch])); hc[nt] = 0.f; Ap[nt] = 1.f;
#pragma unroll
            for (int gate = 0; gate < 2; ++gate)
#pragma unroll
                for (int ks = 0; ks < 2; ++ks)
                    Bw[gate][nt][ks] = *(const bf16x8*)((const bf16*)(F.ws + WS_LRUW) + ((((size_t)(l * 2 + dir) * 8 + blk) * 2 + gate) * 64 + 16 * nt + r16) * 64 + 32 * ks + 8 * q); }
        if (STAGE == 2) {
            const int cbeg = dir ? chunk + 1 : 0, cend = dir ? 64 : chunk;
#pragma unroll 1
            for (int ci = cbeg; ci < cend; ci += 8) { f32x2 sv[8][4];
#pragma unroll
                for (int u = 0; u < 8; ++u) { const int cu = ci + u; const int cj = dir ? (cend - 1 - (cu - cbeg)) : cu;
#pragma unroll
                    for (int nt = 0; nt < 4; ++nt) sv[u][nt] = (cu < cend) ? sums[((size_t)(b * 64 + cj) * 2 + dir) * 512 + 64 * blk + 16 * nt + r16] : (f32x2){1.f, 0.f}; }
#pragma unroll
                for (int u = 0; u < 8; ++u)
#pragma unroll
                    for (int nt = 0; nt < 4; ++nt) hc[nt] = sv[u][nt].x * hc[nt] + sv[u][nt].y; }
        }
        const int myi = dir ? 3 - q : q;
#pragma unroll 1
        for (int mi = 0; mi < 4; ++mi) { const int mt = dir ? 3 - mi : mi;
            bf16x8 af[2];
#pragma unroll
            for (int ks = 0; ks < 2; ++ks) af[ks] = *(const bf16x8*)(XC + (16 * mt + r16) * 520 + 64 * blk + 32 * ks + 8 * q);
            unsigned short gaw[4][4];
            if (STAGE == 2 && dir == 1) {
#pragma unroll
                for (int nt = 0; nt < 4; ++nt)
#pragma unroll
                    for (int r = 0; r < 4; ++r) gaw[nt][r] = proj[((size_t)b * SEQ + t0 + 16 * mt + 4 * q + r) * DINP + C_AG + 64 * blk + 16 * nt + r16]; }
#pragma unroll
            for (int nt = 0; nt < 4; ++nt) {
                f32x4 ga = (f32x4){0.f, 0.f, 0.f, 0.f}, gx = (f32x4){0.f, 0.f, 0.f, 0.f};
                ga = MFMA16(af[0], Bw[0][nt][0], ga); ga = MFMA16(af[1], Bw[0][nt][1], ga);
                gx = MFMA16(af[0], Bw[1][nt][0], gx); gx = MFMA16(af[1], Bw[1][nt][1], gx);
                float a_[4], u_[4];
#pragma unroll
                for (int r = 0; r < 4; ++r) { const int tok = 16 * mt + 4 * q + r;
                    const float rg = sigmoidf_(ga[r] + bav[nt]), ig = sigmoidf_(gx[r] + bxv[nt]);
                    const float la = lamc[nt] * rg; a_[r] = __expf(la); const float mult = __builtin_amdgcn_sqrtf(fmaxf(1.0f - a_[r] * a_[r], 0.f));
                    u_[r] = mult * ig * bf2f(XC[tok * 520 + 64 * blk + 16 * nt + r16]); }
                float ap[4], up[4];
#pragma unroll
                for (int i = 0; i < 4; ++i) { ap[i] = dir ? a_[3 - i] : a_[i]; up[i] = dir ? u_[3 - i] : u_[i]; }
                const float A = (ap[0] * ap[1]) * (ap[2] * ap[3]); const float U = ((up[0] * ap[1] + up[1]) * ap[2] + up[2]) * ap[3] + up[3];
                float h = hc[nt], hin = 0.f, aprod = 1.f;
#pragma unroll
                for (int i = 0; i < 4; ++i) { const int qs = dir ? 3 - i : i; const float Aq = shl_(A, r16 + 16 * qs), Uq = shl_(U, r16 + 16 * qs);
                    hin = (myi == i) ? h : hin; h = Aq * h + Uq; aprod *= Aq; }
                hc[nt] = h; Ap[nt] *= aprod;
                if (STAGE == 2) {
                    float hh = hin;
#pragma unroll
                    for (int i = 0; i < 4; ++i) { hh = ap[i] * hh + up[i];
                        const int r = dir ? 3 - i : i; const int tok = 16 * mt + 4 * q + r; const int ch = 64 * blk + 16 * nt + r16;
                        if (dir == 0) HFL[tok * 512 + ch] = (bf16)f2bf(hh);
                        else { const size_t row = (size_t)b * SEQ + t0 + tok; const float gav = bf2f(dir ? (i == 0 ? gaw[nt][3] : i == 1 ? gaw[nt][2] : i == 2 ? gaw[nt][1] : gaw[nt][0]) : 0);
                               Y[row * DM + ch] = (bf16)f2bf(gelu_tanh(gav) * (bf2f(HFL[tok * 512 + ch]) + hh)); } }
                }
            }
        }
        if (STAGE == 1) { if (q == 0) {
#pragma unroll
            for (int nt = 0; nt < 4; ++nt) sums[((size_t)(b * 64 + chunk) * 2 + dir) * 512 + 64 * blk + 16 * nt + r16] = (f32x2){Ap[nt], hc[nt]}; } }
        LDS_WAIT();
    }
}

__device__ __forceinline__ void ml_gates(Frame& F, float* G, int b, int h, int n) {
    const int tid = F.tid;
    __syncthreads();
    if (tid < 128) { const float* g = (const float*)(F.ws + WS_GATES) + ((size_t)b * SEQ + 128 * n + tid) * 16;
        G[tid] = g[h]; G[128 + tid] = logsigmoidf_(g[4 + h]); G[256 + tid] = g[8 + h]; G[384 + tid] = logsigmoidf_(g[12 + h]); }
    __syncthreads();
    if (tid < 256) { const int p0 = tid & 127; const bool sfx = tid >= 128; const float* src = G + (sfx ? 384 : 128); float s = 0.f;
#pragma unroll 16
        for (int p = 0; p < 128; ++p) { const float v = src[p]; s += (sfx ? (p >= p0) : (p <= p0)) ? v : 0.f; }
        G[(sfx ? 640 : 512) + p0] = s; }
    __syncthreads();
}
template <bool WITH_K> __device__ __forceinline__ void ml_load_T(Frame& F, bf16* VT, bf16* KTf, bf16* KTb, const float* Ef, const float* Eb, int b, int h, int n) {
    const bf16* proj = (const bf16*)(F.ws + WS_PROJ);
#pragma unroll
    for (int qq = 0; qq < 4; ++qq) { const int chunk = F.tid + 512 * qq; const int p = chunk & 127, cc = chunk >> 7; const size_t row = (size_t)b * SEQ + 128 * n + p;
        const u32x4 vv = *(const u32x4*)(proj + row * DINP + C_DV + 128 * h + 8 * cc);
        const unsigned vw[4] = {vv.x, vv.y, vv.z, vv.w};
#pragma unroll
        for (int e = 0; e < 4; ++e) { VT[(8 * cc + 2 * e) * 136 + p] = (bf16)(vw[e] & 0xffffu); VT[(8 * cc + 2 * e + 1) * 136 + p] = (bf16)(vw[e] >> 16); }
        if (WITH_K) { const u32x4 kv = *(const u32x4*)(proj + row * DINP + C_DK + 128 * h + 8 * cc); const unsigned kw[4] = {kv.x, kv.y, kv.z, kv.w}; const float ef = Ef[p], eb = Eb[p];
#pragma unroll
            for (int e = 0; e < 4; ++e) { const float k0 = bflo(kw[e]), k1 = bfhi(kw[e]);
                KTf[(8 * cc + 2 * e) * 136 + p] = (bf16)f2bf(k0 * ef); KTf[(8 * cc + 2 * e + 1) * 136 + p] = (bf16)f2bf(k1 * ef);
                KTb[(8 * cc + 2 * e) * 136 + p] = (bf16)f2bf(k0 * eb); KTb[(8 * cc + 2 * e + 1) * 136 + p] = (bf16)f2bf(k1 * eb); } } }
}
__device__ __forceinline__ void ml1_item(Frame& F, int it) {
    const int tid = F.tid, lane = F.lane, w = F.wave, r32 = lane & 31, hi = lane >> 5;
    const int b = it >> 7, h = (it >> 5) & 3, n = it & 31;
    bf16* VT = (bf16*)F.lds; bf16* KTf = (bf16*)(F.lds + 34816); bf16* KTb = (bf16*)(F.lds + 69632); float* G = (float*)(F.lds + 104448);
    ml_gates(F, G, b, h, n);
    float* Wd = G + 768; float* Ed = G + 1024; float* MX = G + 1280;
    if (tid < 256) { const int d = tid >> 7, p = tid & 127; Wd[tid] = d == 0 ? (G[512 + 127] - G[512 + p] + G[p]) : (G[640] - G[640 + p] + G[256 + p]); }
    __syncthreads();
    if (tid < 256) { const int d = tid >> 7, p = tid & 127; float mx = -INFINITY;
#pragma unroll 16
        for (int pp = 0; pp < 128; ++pp) mx = fmaxf(mx, Wd[d * 128 + pp]); Ed[tid] = __expf(Wd[tid] - mx); if (p == 0) MX[d] = mx; }
    __syncthreads();
    ml_load_T<true>(F, VT, KTf, KTb, Ed, Ed + 128, b, h, n);
    __syncthreads();
    const int d = w >> 2, vb = w & 3; const bf16* KT = d ? KTb : KTf;
    f32x16 acc[4];
#pragma unroll
    for (int kt = 0; kt < 4; ++kt)
#pragma unroll
        for (int r = 0; r < 16; ++r) acc[kt][r] = 0.f;
#pragma unroll
    for (int ps = 0; ps < 8; ++ps) { const bf16x8 a = *(const bf16x8*)(VT + (32 * vb + r32) * 136 + 16 * ps + 8 * hi);
#pragma unroll
        for (int kt = 0; kt < 4; ++kt) { const bf16x8 bb = *(const bf16x8*)(KT + (32 * kt + r32) * 136 + 16 * ps + 8 * hi); acc[kt] = MFMA32(a, bb, acc[kt]); } }
    const int idx = ((b * 4 + h) * 2 + d) * 32 + (d ? 31 - n : n);
    float* dst = (float*)(F.ws + WS_MLDC) + (size_t)idx * 16384;
#pragma unroll
    for (int kt = 0; kt < 4; ++kt)
#pragma unroll
        for (int r = 0; r < 16; ++r) dst[(32 * vb + crow(r, hi)) * 128 + 32 * kt + r32] = acc[kt][r];
    if (tid < 256) { const int dd = tid >> 7, k = tid & 127; const bf16* K2 = dd ? KTb : KTf; float s = 0.f; for (int p = 0; p < 128; ++p) s += bf2f(K2[k * 136 + p]);
        const int idx2 = ((b * 4 + h) * 2 + dd) * 32 + (dd ? 31 - n : n);
        ((float*)(F.ws + WS_MLDN))[(size_t)idx2 * 128 + k] = s;
        if (k == 0) { float* sc = (float*)(F.ws + WS_MLSC) + (size_t)idx2 * 4; sc[0] = MX[dd]; sc[1] = dd ? G[640] : G[512 + 127]; } }
}
__device__ __forceinline__ void ml2_item(Frame& F, int it) {
    const int tid = F.tid, bhd = it >> 3, part = it & 7, e0 = part * 2048 + tid * 4;
    const float* sc = (const float*)(F.ws + WS_MLSC); float* scw = (float*)(F.ws + WS_MLSC);
    const bool nthr = (part == 0) && (tid < 32);
    float m = 0.f; f32x4 C = (f32x4){0.f, 0.f, 0.f, 0.f}, nv = (f32x4){0.f, 0.f, 0.f, 0.f};
#pragma unroll 1
    for (int cb = 0; cb < 32; cb += 8) {
        float mlo[8], btv[8]; f32x4 dcv[8], dnv[8];
#pragma unroll
        for (int j = 0; j < 8; ++j) { const size_t idx = (size_t)bhd * 32 + cb + j; mlo[j] = sc[idx * 4]; btv[j] = sc[idx * 4 + 1];
            dcv[j] = *(const f32x4*)((const float*)(F.ws + WS_MLDC) + idx * 16384 + e0);
            dnv[j] = nthr ? *(const f32x4*)((const float*)(F.ws + WS_MLDN) + idx * 128 + 4 * tid) : (f32x4){0.f, 0.f, 0.f, 0.f}; }
#pragma unroll
        for (int j = 0; j < 8; ++j) { const size_t idx = (size_t)bhd * 32 + cb + j; const float mloc = mlo[j], bt = btv[j];
            const float mnew = fmaxf(bt + m, mloc), dec = __expf(bt + m - mnew), gn = __expf(mloc - mnew);
            *(u32x2*)((bf16*)(F.ws + WS_MLCT) + idx * 16384 + e0) = (u32x2){pk2(C.x, C.y), pk2(C.z, C.w)};
            if (nthr) *(f32x4*)((float*)(F.ws + WS_MLNP) + idx * 128 + 4 * tid) = nv;
            if (part == 0 && tid == 0) scw[idx * 4 + 2] = m;
            C = C * dec + dcv[j] * gn; nv = nv * dec + dnv[j] * gn;
            m = mnew; }
    }
}
__device__ __forceinline__ void ml3_item(Frame& F, int l, int it) {
    const bf16* proj = (const bf16*)(F.ws + WS_PROJ);
    const int tid = F.tid, lane = F.lane, w = F.wave, r32 = lane & 31, hi = lane >> 5;
    const int b = it >> 7, h = (it >> 5) & 3, n = it & 31;
    bf16* VT = (bf16*)F.lds; bf16* KN = (bf16*)(F.lds + 34816); float* HF = (float*)(F.lds + 69632); float* G = (float*)(F.lds + 135680); float* INV = (float*)(F.lds + 143872);
    ml_gates(F, G, b, h, n);
    const int idx_f = ((b * 4 + h) * 2 + 0) * 32 + n, idx_b = ((b * 4 + h) * 2 + 1) * 32 + (31 - n);
    const float mpf = ((const float*)(F.ws + WS_MLSC))[(size_t)idx_f * 4 + 2], mpb = ((const float*)(F.ws + WS_MLSC))[(size_t)idx_b * 4 + 2];
    if (tid < 128) { G[7 * 128 + tid] = G[tid] - G[512 + tid]; G[11 * 128 + tid] = G[256 + tid] - G[640 + tid]; }
    __syncthreads();
    if (tid < 128) { const int p = tid; float pm = -INFINITY;
#pragma unroll 16
        for (int s = 0; s < 128; ++s) { const float v = G[7 * 128 + s]; pm = fmaxf(pm, (s <= p) ? v : -INFINITY); }
        const float bl = G[512 + p], mint = bl + mpf, mt = fmaxf(mint, bl + pm); G[8 * 128 + p] = __expf(mint - mt); G[6 * 128 + p] = bl - mt; G[9 * 128 + p] = mt; }
    else if (tid < 256) { const int p = tid - 128; float pm = -INFINITY;
#pragma unroll 16
        for (int s = 0; s < 128; ++s) { const float v = G[11 * 128 + s]; pm = fmaxf(pm, (s >= p) ? v : -INFINITY); }
        const float bl = G[640 + p], mint = bl + mpb, mt = fmaxf(mint, bl + pm); G[12 * 128 + p] = __expf(mint - mt); G[10 * 128 + p] = bl - mt; G[13 * 128 + p] = mt; }
    else if (tid < 384) { const int k = tid - 256; G[14 * 128 + k] = ((const float*)(F.ws + WS_MLNP))[(size_t)idx_f * 128 + k]; }
    else { const int k = tid - 384; G[15 * 128 + k] = ((const float*)(F.ws + WS_MLNP))[(size_t)idx_b * 128 + k]; }
    ml_load_T<false>(F, VT, nullptr, nullptr, nullptr, nullptr, b, h, n);
    { u32x4 kv[4];
#pragma unroll
      for (int qq = 0; qq < 4; ++qq) { const int chunk = tid + 512 * qq; const int p = chunk >> 4, cc = chunk & 15; kv[qq] = *(const u32x4*)(proj + ((size_t)b * SEQ + 128 * n + p) * DINP + C_DK + 128 * h + 8 * cc); }
#pragma unroll
      for (int qq = 0; qq < 4; ++qq) { const int chunk = tid + 512 * qq; const int p = chunk >> 4, cc = chunk & 15; *(u32x4*)(KN + p * 136 + 8 * cc) = kv[qq]; } }
    __syncthreads();
    const int lb = w & 3, vh = w >> 2, ll = 32 * lb + r32;
    const float SCALE = 0.08838834764831845f;
    bf16x8 qf[8];
    { const bf16* qp = proj + ((size_t)b * SEQ + 128 * n + ll) * DINP + C_DQ + 128 * h + 8 * hi;
#pragma unroll
      for (int ks = 0; ks < 8; ++ks) qf[ks] = *(const bf16x8*)(qp + 16 * ks); }
#pragma unroll 1
    for (int d = 0; d < 2; ++d) {
        const int idx = d ? idx_b : idx_f;
        const float* RT = G + (d ? 10 : 6) * 128; const float* CF = G + (d ? 11 : 7) * 128; const float* EI = G + (d ? 12 : 8) * 128; const float* MT = G + (d ? 13 : 9) * 128; const float* NP = G + (d ? 15 : 14) * 128;
        const float rt = RT[ll], ei = EI[ll], mt = MT[ll];
        f32x16 O[2];
#pragma unroll
        for (int vt = 0; vt < 2; ++vt)
#pragma unroll
            for (int r = 0; r < 16; ++r) O[vt][r] = 0.f;
        float dsum = 0.f;
        const int st_lo = d ? lb : 0, st_hi = d ? 3 : lb;
#pragma unroll 1
        for (int st = st_lo; st <= st_hi; ++st) {
            f32x16 sacc;
#pragma unroll
            for (int r = 0; r < 16; ++r) sacc[r] = 0.f;
            const bf16* kp = KN + (32 * st + r32) * 136 + 8 * hi;
#pragma unroll
            for (int ks = 0; ks < 8; ++ks) { const bf16x8 kf = *(const bf16x8*)(kp + 16 * ks); sacc = MFMA32(kf, qf[ks], sacc); }
            float P[16];
#pragma unroll
            for (int r = 0; r < 16; ++r) { const int s_ = 32 * st + crow(r, hi); const bool ok = d ? (s_ >= ll) : (s_ <= ll);
                const float pv = ok ? sacc[r] * SCALE * __expf(rt + CF[s_]) : 0.f; P[r] = pv; dsum += pv; }
#pragma unroll
            for (int half = 0; half < 2; ++half) {
                const u32x4 pw = (u32x4){pk2(P[8 * half + 0], P[8 * half + 1]), pk2(P[8 * half + 2], P[8 * half + 3]), pk2(P[8 * half + 4], P[8 * half + 5]), pk2(P[8 * half + 6], P[8 * half + 7])};
                const bf16x8 pa = __builtin_bit_cast(bf16x8, pw);
#pragma unroll
                for (int vt = 0; vt < 2; ++vt) { const bf16* vp = VT + (32 * (2 * vh + vt) + r32) * 136 + 32 * st + 16 * half + 4 * hi;
                    const u32x2 lo = *(const u32x2*)vp, hi2 = *(const u32x2*)(vp + 8);
                    const bf16x8 bv = __builtin_bit_cast(bf16x8, (u32x4){lo.x, lo.y, hi2.x, hi2.y});
                    O[vt] = MFMA32(pa, bv, O[vt]); } } }
        const float qs = ei * SCALE; float dq = 0.f;
#pragma unroll
        for (int ks = 0; ks < 8; ++ks) { const u32x4 qw = __builtin_bit_cast(u32x4, qf[ks]); const unsigned qq[4] = {qw.x, qw.y, qw.z, qw.w}; float qv[8];
#pragma unroll
            for (int e = 0; e < 4; ++e) { qv[2 * e] = bflo(qq[e]); qv[2 * e + 1] = bfhi(qq[e]); }
#pragma unroll
            for (int e = 0; e < 8; ++e) dq += qv[e] * NP[16 * ks + 8 * hi + e];
            const u32x4 sw = (u32x4){pk2(qv[0] * qs, qv[1] * qs), pk2(qv[2] * qs, qv[3] * qs), pk2(qv[4] * qs, qv[5] * qs), pk2(qv[6] * qs, qv[7] * qs)};
            const bf16x8 qp2 = __builtin_bit_cast(bf16x8, sw);
#pragma unroll
            for (int vt = 0; vt < 2; ++vt) { const bf16x8 cf = *(const bf16x8*)((const bf16*)(F.ws + WS_MLCT) + (size_t)idx * 16384 + (32 * (2 * vh + vt) + r32) * 128 + 16 * ks + 8 * hi);
                O[vt] = MFMA32(qp2, cf, O[vt]); } }
        dsum += shx(dsum, 32); dq += shx(dq, 32);
        const float den = dsum + qs * dq;
        const float inv = 1.0f / fmaxf(fabsf(den), __expf(-mt));
        asm volatile("" ::: "memory");
        INV[w * 32 + r32] = inv;
        LDS_WAIT();
#pragma unroll
        for (int vt = 0; vt < 2; ++vt)
#pragma unroll
            for (int r = 0; r < 16; ++r) { float* hp = HF + (32 * lb + crow(r, hi)) * 129 + 32 * (2 * vh + vt) + r32; const float hv_ = O[vt][r] * INV[w * 32 + crow(r, hi)];
                *hp = d ? (*hp + hv_) : hv_; }
        LDS_WAIT();
    }
    __syncthreads();
    { const int p = tid >> 2, part = tid & 3; const size_t row = (size_t)b * SEQ + 128 * n + p;
      float hv[32]; float ss = 0.f;
#pragma unroll
      for (int e = 0; e < 32; ++e) { hv[e] = HF[p * 129 + 32 * part + e]; ss += hv[e] * hv[e]; }
      ss += shx(ss, 1); ss += shx(ss, 2);
      const float rstd = rsqrtf(ss * (1.0f / 128.0f) + EPS);
      const bf16* op = proj + row * DINP + C_DO + 128 * h + 32 * part; const float* gp = F.in[I_MLG] + l * 512 + 128 * h + 32 * part;
      bf16* yp = (bf16*)(F.ws + WS_Y) + row * DM + 1536 + 128 * h + 32 * part;
#pragma unroll
      for (int e8 = 0; e8 < 4; ++e8) { const u32x4 ov = *(const u32x4*)(op + 8 * e8); const unsigned ow[4] = {ov.x, ov.y, ov.z, ov.w}; unsigned pk[4];
#pragma unroll
          for (int e = 0; e < 4; ++e) { const float y0 = hv[8 * e8 + 2 * e] * rstd * gp[8 * e8 + 2 * e] * sigmoidf_(bflo(ow[e])); const float y1 = hv[8 * e8 + 2 * e + 1] * rstd * gp[8 * e8 + 2 * e + 1] * sigmoidf_(bfhi(ow[e])); pk[e] = pk2(y0, y1); }
          *(u32x4*)(yp + 8 * e8) = (u32x4){pk[0], pk[1], pk[2], pk[3]}; } }
}

__device__ __forceinline__ void mixer_phase(Frame& F0, int l, int stage, int rep) {
    unsigned* ctr = (unsigned*)(F0.ws + WS_CTL) + 64 * (1 + (l * 3 + stage) * 2 + rep);
    const int nitems = (stage == 0) ? 1792 : 1024;
    for (;;) {
        const int it = next_item(ctr, F0.lds);
        if (it >= nitems) break;
        Frame F = F0;
        { unsigned zoff = 0u; asm volatile("" : "+s"(zoff)); F.ws = F0.ws + zoff; F.out = F0.out + zoff; F.in = F0.in + zoff; F.tid = lt(); F.lane = F.tid & 63; F.wave = __builtin_amdgcn_readfirstlane(F.tid >> 6); }
#if MK_PROBE
        if (rep == 1) { int ty; if (stage == 0) ty = it < 512 ? 4 : (it < 768 ? 3 : 5); else ty = it < 256 ? 1 : (it < 512 ? 2 : ((stage == 1 && it < 768) ? 3 : 4));
            if (!((MK_PTYPE >> ty) & 1)) continue; }
#endif
        if (stage == 0) {
            if (it < 512) ml1_item(F, it);
            else if (it < 768) lru_item<1>(F, l, it - 512);
            else if (it < 1536) hy_prep_item(F, l, it - 768);
            else attn_prep_item(F, l, it - 1536);
        } else {
            if (it < 256) hy_conv_item(F, l, stage - 1, it);
            else if (it < 512) {
                volatile unsigned* slot = (volatile unsigned*)(F.lds + SLOT_OFF);
                if (F.tid == 0) { unsigned* actr = (unsigned*)(F.ws + WS_CTL) + 64 * (32 + (l * 2 + (stage - 1)) * 8); const unsigned x0 = xb_xcc_id() & 7u; unsigned unit = 0u;
                    for (unsigned k = 0; k < 8; ++k) { const unsigned x = (x0 + k) & 7u; if (__hip_atomic_load(actr + 64 * x, __ATOMIC_RELAXED, __HIP_MEMORY_SCOPE_AGENT) >= 32u) continue;
                        const unsigned a = atomicAdd(actr + 64 * x, 1u); if (a < 32u) { unit = x * 32u + a; break; } }
                    slot[1] = unit; }
                __syncthreads();
                const int un = (int)slot[1]; const int x = un >> 5, a = un & 31; const int b_ = x >> 1, h_ = (x & 1) * 4 + (a >> 3), qb = (a & 7) + (stage == 2 ? 8 : 0);
                attn_body::attn_unit<8>(b_, h_, qb, (const attn_body::bf16*)(F.ws + WS_QB), (const attn_body::bf16*)(F.ws + WS_KB),
                                        (const attn_body::bf16*)(F.ws + WS_VB), (attn_body::bf16*)(F.ws + WS_Y) + 512, (char*)F.lds); }
            else if (stage == 1) { if (it < 768) lru_item<2>(F, l, it - 512); else ml2_item(F, it - 768); }
            else ml3_item(F, l, it - 512);
        }
    }
    __syncthreads();
}

constexpr int N_PHASES = 22;
__global__ void __launch_bounds__(512, 2) fwd_kernel(Args args) {
    extern __shared__ __attribute__((aligned(16))) unsigned char lds[];
    cg::grid_group grid = cg::this_grid();
    volatile LAS unsigned* xst = (volatile LAS unsigned*)((LAS unsigned char*)lds + SLOT_OFF + 16);
    if (threadIdx.x == 0) { xst[0] = 0u; xst[1] = 0u; }
    __syncthreads();
    const XcdBarrier xbar = xcd_barrier_post((unsigned*)(args.ws + WS_CTL) + 4096, xst);
    Frame F0; F0.lds = lds; F0.ws = args.ws; F0.in = args.in; F0.out = args.out;
    F0.tid = threadIdx.x; F0.lane = F0.tid & 63; F0.wave = __builtin_amdgcn_readfirstlane(F0.tid >> 6); F0.G = gridDim.x;
    int ph = args.ph_lo, rep = 0;
#if (MK_PROBE & 8)
#pragma unroll 1
    for (int i = 0; i < 40; ++i) grid.sync();
#endif
#pragma unroll 1
    while (ph < args.ph_hi) {
        Frame F = F0;
        { unsigned zoff = 0u; asm volatile("" : "+s"(zoff)); F.ws = F0.ws + zoff; F.out = F0.out + zoff; F.in = F0.in + zoff; F.tid = lt(); F.lane = F.tid & 63; F.wave = __builtin_amdgcn_readfirstlane(F.tid >> 6); }
        if (ph == 0) p0_prologue(F);
        else if (ph == N_PHASES - 1) final_norm_phase(F, F.out, F.in[I_FG]);
        else {
            const int l = (ph - 1) / 10, k = (ph - 1) % 10;
            const float* mod = (const float*)(F.ws + WS_MOD) + (size_t)l * 4 * 12288;
            if (k == 0 || k == 7) {
                if (ph == 1) hy_scale_reduce(F);
                const float* xin = (ph == 1) ? F.in[I_X] : F.out;
                if (k == 0) norm_phase(F, xin, F.in[I_NMG] + l * DM, mod + 0 * DM, mod + 1 * DM, (bf16*)(F.ws + WS_XN));
                else norm_phase(F, xin, F.in[I_NFG] + l * DM, mod + 3 * DM, mod + 4 * DM, (bf16*)(F.ws + WS_XN));
            } else if (k == 1) {
                pg8::Gemm g{(const pg8::bf16_t*)(F.ws + WS_XN), (const pg8::bf16_t*)(F.ws + WS_WIN) + (size_t)l * DINP * DM, MTOK, DINP, DM};
                pg8::StaticOrder S; S.init(MTOK, DINP, F.G, (int)blockIdx.x);
                pg8::EpiInProj E{(pg8::bf16_t*)(F.ws + WS_PROJ), DINP, (const float*)(F.ws + WS_BINP) + l * DINP, (float*)(F.ws + WS_GATES)};
                pg8::gemm_phase<pg8::EpiInProj, pg8::StaticOrder, true, true>((LAS unsigned char*)lds, g, S, E);
            } else if (k >= 2 && k <= 4) {
                mixer_phase(F, l, k - 2, rep);
            } else if (k == 5) {
                hy_out_phase(F);
            } else if (k == 6) {
                pg8::Gemm g{(const pg8::bf16_t*)(F.ws + WS_Y), (const pg8::bf16_t*)(F.ws + WS_WOUT) + (size_t)l * DM * DM, MTOK, DM, DM};
                pg8::StaticOrder S; S.init(MTOK, DM, F.G, (int)blockIdx.x);
                pg8::EpiResGate E{(l == 0) ? F.in[I_X] : (const float*)F.out, F.out, DM, mod + 2 * DM, 12288};
                pg8::gemm_phase<pg8::EpiResGate, pg8::StaticOrder, true, true>((LAS unsigned char*)lds, g, S, E);
            } else if (k == 8) {
                pg8::Gemm g{(const pg8::bf16_t*)(F.ws + WS_XN), (const pg8::bf16_t*)(F.ws + WS_W13) + (size_t)l * 2 * DFF * DM, MTOK, 2 * DFF, DM};
                pg8::StaticOrder S; S.init(MTOK, 2 * DFF, F.G, (int)blockIdx.x);
                pg8::EpiSwiGLU E{(pg8::bf16_t*)(F.ws + WS_PROJ), DFF};
                pg8::gemm_phase<pg8::EpiSwiGLU, pg8::StaticOrder, true, true>((LAS unsigned char*)lds, g, S, E);
            } else {
                pg8::Gemm g{(const pg8::bf16_t*)(F.ws + WS_PROJ), (const pg8::bf16_t*)(F.ws + WS_W2) + (size_t)l * DM * DFF, MTOK, DM, DFF};
                pg8::StaticOrder S; S.init(MTOK, DM, F.G, (int)blockIdx.x);
                pg8::EpiResGate E{(const float*)F.out, F.out, DM, mod + 5 * DM, 12288};
                pg8::gemm_phase<pg8::EpiResGate, pg8::StaticOrder, true, true>((LAS unsigned char*)lds, g, S, E);
            }
        }
        bool again = false;
#if MK_PROBE
        if (rep == 0) { const int kk = (ph == 0 || ph == N_PHASES - 1) ? -1 : (ph - 1) % 10;
          if ((MK_PROBE & 1) && kk >= 2 && kk <= 4) again = true;
          if ((MK_PROBE & 16) && kk == 2) again = true;
          if ((MK_PROBE & 64) && ph == 0) again = true;
          if ((MK_PROBE & 128) && (kk == 0 || kk == 7)) again = true;
          if ((MK_PROBE & 32) && kk == 3) again = true;
          if ((MK_PROBE & 2) && (kk == 1 || kk == 8)) again = true;
          if ((MK_PROBE & 4) && (kk == 0 || kk == 7 || ph == 0)) again = true; }
#endif
        if (again) rep = 1; else { rep = 0; ++ph; }
        if (ph < args.ph_hi) { if (ph == 1 && rep == 0) grid.sync(); else xcd_barrier(xbar); }
    }
}

#ifndef MK_N_LAUNCHES
#define MK_N_LAUNCHES 1
#endif
extern "C" void kernel_launch(void* const* d_in, const int* in_sizes, int n_in, void* d_out, int out_size, void* d_ws, size_t ws_size, hipStream_t stream) {
    static int grid = 0;
    if (grid == 0) {
        if (n_in != 33 || out_size != MTOK * DM || ws_size < WS_END) { fprintf(stderr, "kernel_launch: unexpected shapes (n_in %d, out %d, ws %zu < %zu)\n", n_in, out_size, ws_size, (size_t)WS_END); grid = -1; return; }
        int dev = 0, cus = 0, per_cu = 0;
        (void)hipGetDevice(&dev); (void)hipDeviceGetAttribute(&cus, hipDeviceAttributeMultiprocessorCount, dev);
        if (hipFuncSetAttribute((const void*)fwd_kernel, hipFuncAttributeMaxDynamicSharedMemorySize, LDS_BYTES) != hipSuccess) { fprintf(stderr, "kernel_launch: hipFuncSetAttribute failed\n"); grid = -1; return; }
        if (hipOccupancyMaxActiveBlocksPerMultiprocessor(&per_cu, (const void*)fwd_kernel, 512, LDS_BYTES) != hipSuccess || per_cu < 1) per_cu = 1;
        (void)hipGetLastError();
        grid = cus * per_cu;
        fprintf(stderr, "kernel_launch: grid %d (cus %d x %d), ws %zu\n", grid, cus, per_cu, ws_size);
    }
    if (grid < 0) return;
    (void)hipMemsetAsync((char*)d_ws + WS_CTL, 0, CTL_BYTES, stream);
    Args a{};
    for (int i = 0; i < 33; ++i) a.in[i] = (const float*)d_in[i];
    a.out = (float*)d_out; a.ws = (unsigned char*)d_ws;
    if (MK_N_LAUNCHES == 1) {
        a.ph_lo = 0; a.ph_hi = N_PHASES;
        void* kargs[] = {&a};
        const hipError_t e = hipLaunchCooperativeKernel((const void*)fwd_kernel, dim3(grid), dim3(512), kargs, LDS_BYTES, stream);
        if (e != hipSuccess) fprintf(stderr, "kernel_launch: cooperative launch failed: %s (grid %d)\n", hipGetErrorString(e), grid);
    } else {
        for (int ph = 0; ph < N_PHASES; ++ph) { a.ph_lo = ph; a.ph_hi = ph + 1; hipLaunchKernelGGL(fwd_kernel, dim3(grid), dim3(512), LDS_BYTES, stream, a); }
    }
}
```
